# Optimizing an MI355X kernel written in HIP

```python
import jax, jax.numpy as jnp
from jax import lax
import numpy as np

D_MODEL = 1024
BATCH = 2
SEQ = 8192
DEPTH = 2

N_A_LAYERS = DEPTH // 2
N_B_LAYERS = DEPTH - N_A_LAYERS
EPS = 1e-6

HG_EXPAND = 128
HG_HEADS = D_MODEL // HG_EXPAND
HG_DK = D_MODEL // HG_HEADS
HG_DV = D_MODEL // HG_HEADS
HG_CHUNK = 64

DIL_GROUPS = ((128, 1), (512, 4), (2048, 16))
N_GROUPS = len(DIL_GROUPS)
HEAD_DIM = 128
KV_PER_GROUP = 2
Q_PER_KV = 2
Q_WIDTH = N_GROUPS * KV_PER_GROUP * Q_PER_KV * HEAD_DIM
KV_WIDTH = N_GROUPS * KV_PER_GROUP * HEAD_DIM
ATT_OUT_WIDTH = KV_PER_GROUP * Q_PER_KV * HEAD_DIM
ROT_DIM = HEAD_DIM // 4
ROPE_THETA = 500000.0
Q_BLOCK = 128

PEER_HEADS = 8
PEER_TOPK = 16
N_KEYS = 128
N_EXPERTS = N_KEYS * N_KEYS
PEER_DKEY = 256
PEER_CHUNK = 128

kernel_name = "yoco_hgrn2_dilated_attn_peer"


def rmsnorm(x, g):
    xf = x.astype(jnp.float32)
    y = xf * lax.rsqrt(jnp.mean(xf * xf, axis=-1, keepdims=True) + EPS)
    return (y * g.astype(jnp.float32)).astype(x.dtype)


def rope_partial(x, pos):
    half = ROT_DIM // 2
    inv = ROPE_THETA ** (-jnp.arange(half, dtype=jnp.float32) * 2.0 / ROT_DIM)
    ang = pos.astype(jnp.float32)[:, None] * inv[None, :]
    ang = ang.reshape((1, pos.shape[0]) + (1,) * (x.ndim - 3) + (half,))
    cos, sin = jnp.cos(ang), jnp.sin(ang)
    xr = x[..., :ROT_DIM].astype(jnp.float32)
    x1, x2 = xr[..., :half], xr[..., half:]
    rot = jnp.concatenate([x1 * cos - x2 * sin, x2 * cos + x1 * sin], axis=-1)
    return jnp.concatenate([rot.astype(x.dtype), x[..., ROT_DIM:]], axis=-1)


def hgrn2_mixer(h, norm_g, w_in, lb, out_g, w_out):
    B, S, _ = h.shape
    nc = S // HG_CHUNK
    xn = rmsnorm(h, norm_g)
    q, fr, i, g = jnp.split(xn @ w_in, 4, axis=-1)
    q = jax.nn.silu(q.astype(jnp.float32))
    f = lb + (1.0 - lb) * jax.nn.sigmoid(fr.astype(jnp.float32))
    k = 1.0 - f
    logf = jnp.log(f)

    def to_chunks(t, d):
        return t.astype(jnp.float32).reshape(B, nc, HG_CHUNK, HG_HEADS, d).transpose(1, 0, 3, 2, 4)

    qc, kc, gc = to_chunks(q, HG_DK), to_chunks(k, HG_DK), to_chunks(logf, HG_DK)
    vc = to_chunks(i, HG_DV)
    causal = jnp.tril(jnp.ones((HG_CHUNK, HG_CHUNK), dtype=bool))

    def step(state, inp):
        qt, kt, vt, gt = inp
        b = jnp.cumsum(gt, axis=-2)
        inter = jnp.einsum('bhcd,bhde->bhce', qt * jnp.exp(b), state)
        diff = b[:, :, :, None, :] - b[:, :, None, :, :]
        decay = jnp.exp(jnp.where(causal[None, None, :, :, None], diff, -jnp.inf))
        scores = jnp.einsum('bhid,bhijd,bhjd->bhij', qt, decay, kt)
        intra = jnp.einsum('bhij,bhje->bhie', scores, vt)
        b_last = b[:, :, -1:, :]
        new_state = jnp.exp(b_last[:, :, 0, :])[..., None] * state + jnp.einsum(
            'bhjd,bhje->bhde', kt * jnp.exp(b_last - b), vt)
        return new_state, inter + intra

    s0 = jnp.zeros((B, HG_HEADS, HG_DK, HG_DV), jnp.float32)
    _, o = lax.scan(step, s0, (qc, kc, vc, gc))
    o = o.transpose(1, 0, 3, 2, 4).reshape(B, S, HG_HEADS, HG_DV)
    o = rmsnorm(o, out_g) * jax.nn.silu(g.astype(jnp.float32).reshape(B, S, HG_HEADS, HG_DV))
    return o.reshape(B, S, D_MODEL).astype(h.dtype) @ w_out


def shared_kv(h, kv_norm, w_kv, k_norm):
    B, S, _ = h.shape
    pos = jnp.arange(S)
    k, v = jnp.split(rmsnorm(h, kv_norm) @ w_kv, 2, axis=-1)
    k = k.reshape(B, S, N_GROUPS, KV_PER_GROUP, HEAD_DIM)
    v = v.reshape(B, S, N_GROUPS, KV_PER_GROUP, HEAD_DIM)
    k = rope_partial(rmsnorm(k, k_norm), pos)
    return k, v


def dilated_attention(h, k, v, norm_g, w_q, q_norm, w_o):
    B, S, _ = h.shape
    pos = jnp.arange(S)
    q = (rmsnorm(h, norm_g) @ w_q).reshape(B, S, N_GROUPS, KV_PER_GROUP, Q_PER_KV, HEAD_DIM)
    q = rope_partial(rmsnorm(q, q_norm), pos)
    scale = HEAD_DIM ** -0.5

    def block(s0):
        t = s0 + jnp.arange(Q_BLOCK)
        qb = lax.dynamic_slice_in_dim(q, s0, Q_BLOCK, axis=1)
        outs, lses = [], []
        for gi, (w, d) in enumerate(DIL_GROUPS):
            m = jnp.arange(w // d + 1)
            idx = t[:, None] - d * m[None, :]
            valid = idx >= 0
            idxc = jnp.maximum(idx, 0)
            kg = jnp.take(k[:, :, gi], idxc, axis=1)
            vg = jnp.take(v[:, :, gi], idxc, axis=1)
            s = jnp.einsum('bqkrd,bqmkd->bqkrm', qb[:, :, gi], kg).astype(jnp.float32) * scale
            s = jnp.where(valid[None, :, None, None, :], s, -jnp.inf)
            lse = jax.nn.logsumexp(s, axis=-1)
            p = jnp.exp(s - lse[..., None])
            o = jnp.einsum('bqkrm,bqmkd->bqkrd', p.astype(vg.dtype), vg)
            outs.append(o.astype(jnp.float32))
            lses.append(lse)
        alpha = jax.nn.softmax(jnp.stack(lses, axis=0), axis=0)
        comb = jnp.sum(alpha[..., None] * jnp.stack(outs, axis=0), axis=0)
        return comb.astype(h.dtype)

    starts = jnp.arange(S // Q_BLOCK) * Q_BLOCK
    o = lax.map(block, starts)
    o = jnp.moveaxis(o, 0, 1).reshape(B, S, ATT_OUT_WIDTH)
    return o @ w_o


def peer(h, norm_g, w_q, sub_keys, u, v):
    B, S, D = h.shape
    T = B * S
    half = PEER_DKEY // 2
    xn = rmsnorm(h, norm_g).reshape(T, D)
    q = (xn @ w_q).reshape(T, PEER_HEADS, PEER_DKEY)
    s1 = jnp.einsum('thd,nd->thn', q[..., :half], sub_keys[0]).astype(jnp.float32)
    s2 = jnp.einsum('thd,nd->thn', q[..., half:], sub_keys[1]).astype(jnp.float32)
    v1, i1 = lax.top_k(s1, PEER_TOPK)
    v2, i2 = lax.top_k(s2, PEER_TOPK)
    cand = (v1[..., :, None] + v2[..., None, :]).reshape(T, PEER_HEADS, PEER_TOPK * PEER_TOPK)
    cs, ci = lax.top_k(cand, PEER_TOPK)
    e1 = jnp.take_along_axis(i1, ci // PEER_TOPK, axis=-1)
    e2 = jnp.take_along_axis(i2, ci % PEER_TOPK, axis=-1)
    experts = (e1 * N_KEYS + e2).reshape(T, PEER_HEADS * PEER_TOPK)
    gates = jax.nn.softmax(cs, axis=-1).reshape(T, PEER_HEADS * PEER_TOPK)

    def chunk(args):
        xc, ec, gc = args
        uc = jnp.take(u, ec, axis=0)
        z = jnp.einsum('td,ted->te', xc, uc).astype(jnp.float32)
        act = jax.nn.gelu(z) * gc
        vc = jnp.take(v, ec, axis=0)
        return jnp.einsum('te,ted->td', act.astype(vc.dtype), vc)

    nch = T // PEER_CHUNK
    out = lax.map(chunk, (xn.reshape(nch, PEER_CHUNK, D),
                          experts.reshape(nch, PEER_CHUNK, -1),
                          gates.reshape(nch, PEER_CHUNK, -1)))
    return out.reshape(B, S, D).astype(h.dtype)


def setup_inputs(seed: int = 0) -> dict:
    key = jax.random.key(seed)
    ks = jax.random.split(key, 20)
    nrm = jax.random.normal
    D = D_MODEL
    return {
        "x": nrm(ks[0], (BATCH, SEQ, D), jnp.float32),
        "hgrn_norm": 1.0 + 0.02 * nrm(ks[1], (N_A_LAYERS, D), jnp.float32),
        "hgrn_w_in": nrm(ks[2], (N_A_LAYERS, D, 4 * D), jnp.float32) * D ** -0.5,
        "hgrn_lb_logits": 0.1 * nrm(ks[3], (N_A_LAYERS + 1, D), jnp.float32),
        "hgrn_out_norm": 1.0 + 0.02 * nrm(ks[4], (N_A_LAYERS, HG_DV), jnp.float32),
        "hgrn_w_out": nrm(ks[5], (N_A_LAYERS, D, D), jnp.float32) * D ** -0.5,
        "kv_norm": 1.0 + 0.02 * nrm(ks[6], (D,), jnp.float32),
        "w_kv": nrm(ks[7], (D, 2 * KV_WIDTH), jnp.float32) * D ** -0.5,
        "k_norm": 1.0 + 0.02 * nrm(ks[8], (HEAD_DIM,), jnp.float32),
        "attn_norm": 1.0 + 0.02 * nrm(ks[9], (N_B_LAYERS, D), jnp.float32),
        "w_q": nrm(ks[10], (N_B_LAYERS, D, Q_WIDTH), jnp.float32) * D ** -0.5,
        "q_norm": 1.0 + 0.02 * nrm(ks[11], (N_B_LAYERS, HEAD_DIM), jnp.float32),
        "w_o": nrm(ks[12], (N_B_LAYERS, ATT_OUT_WIDTH, D), jnp.float32) * ATT_OUT_WIDTH ** -0.5,
        "ffn_norm": 1.0 + 0.02 * nrm(ks[13], (DEPTH, D), jnp.float32),
        "peer_w_q": nrm(ks[14], (DEPTH, D, PEER_HEADS * PEER_DKEY), jnp.float32) * D ** -0.5,
        "peer_sub_keys": nrm(ks[15], (DEPTH, 2, N_KEYS, PEER_DKEY // 2), jnp.float32) * (PEER_DKEY // 2) ** -0.5,
        "peer_u": nrm(ks[16], (DEPTH, N_EXPERTS, D), jnp.float32) * D ** -0.5,
        "peer_v": nrm(ks[17], (DEPTH, N_EXPERTS, D), jnp.float32) * PEER_HEADS ** -0.5,
    }


def reference(x, hgrn_norm, hgrn_w_in, hgrn_lb_logits, hgrn_out_norm, hgrn_w_out,
              kv_norm, w_kv, k_norm, attn_norm, w_q, q_norm, w_o,
              ffn_norm, peer_w_q, peer_sub_keys, peer_u, peer_v):
    lbs = jnp.cumsum(jax.nn.softmax(hgrn_lb_logits.astype(jnp.float32), axis=0), axis=0)
    h = x
    k_sh, v_sh = None, None
    for layer in range(DEPTH):
        if layer < N_A_LAYERS:
            h = h + hgrn2_mixer(h, hgrn_norm[layer], hgrn_w_in[layer], lbs[layer],
                                hgrn_out_norm[layer], hgrn_w_out[layer]).astype(h.dtype)
        else:
            if layer == N_A_LAYERS:
                k_sh, v_sh = shared_kv(h, kv_norm, w_kv, k_norm)
            j = layer - N_A_LAYERS
            h = h + dilated_attention(h, k_sh, v_sh, attn_norm[j], w_q[j],
                                      q_norm[j], w_o[j]).astype(h.dtype)
        h = h + peer(h, ffn_norm[layer], peer_w_q[layer], peer_sub_keys[layer],
                     peer_u[layer], peer_v[layer]).astype(h.dtype)
    return h
```

```cpp
#include <hip/hip_runtime.h>
#include <hip/hip_cooperative_groups.h>
#include <cstdio>
#include <cstdint>
namespace cg = cooperative_groups;

#ifndef MEGA
#define MEGA 1
#endif

#define DI __device__ __forceinline__
typedef unsigned short u16;
typedef __attribute__((ext_vector_type(8))) short bf16x8;
typedef __attribute__((ext_vector_type(16))) float f32x16;
typedef __attribute__((ext_vector_type(2))) float f32x2;
typedef __attribute__((ext_vector_type(2))) __bf16 bf16x2_t;
typedef __attribute__((ext_vector_type(4))) unsigned u32x4;
typedef __attribute__((ext_vector_type(2))) unsigned u32x2;

#define MFMA32(a, b, c) __builtin_amdgcn_mfma_f32_32x32x16_bf16((a), (b), (c), 0, 0, 0)

constexpr int T_TOK = 16384;
constexpr int DM = 1024;
constexpr int SEQ = 8192;
constexpr float EPS = 1e-6f;
constexpr int NTHREADS = 256;
constexpr int LDS_BYTES = 65536;

constexpr size_t MiB = 1u << 20;
constexpr size_t OFF_LB = 64 * 1024;
constexpr size_t OFF_MISC = 68 * 1024;
constexpr size_t OFF_RSTD0 = 128 * 1024;
constexpr size_t OFF_SS1 = 29 * MiB;
constexpr size_t OFF_RSTD2 = 256 * 1024;
constexpr size_t OFF_SS3 = 30 * MiB;
constexpr size_t OFF_LG = 1 * MiB;
constexpr size_t OFF_ROPE = 2 * MiB;
constexpr size_t OFF_ACH = 3 * MiB;
constexpr size_t OFF_WIN = 4 * MiB;
constexpr size_t OFF_WOUT = 12 * MiB;
constexpr size_t OFF_WPQ0 = 14 * MiB;
constexpr size_t OFF_WKVQ = 18 * MiB;
constexpr size_t OFF_WO = 24 * MiB;
constexpr size_t OFF_WPQ1 = 25 * MiB;
constexpr size_t OFF_UV0 = 32 * MiB;
constexpr size_t OFF_UV1 = 64 * MiB;
constexpr size_t OFF_SC0 = 31 * MiB;
constexpr size_t OFF_SC1 = 31 * MiB + 256 * 1024;
constexpr size_t OFF_HB = 160 * MiB;
constexpr size_t OFF_QG = 192 * MiB;
constexpr size_t OFF_KG = 224 * MiB;
constexpr size_t OFF_LOGF = 256 * MiB;
constexpr size_t OFF_VG = 320 * MiB;
constexpr size_t OFF_GG = 352 * MiB;
constexpr size_t OFF_UT = 384 * MiB;
constexpr size_t OFF_OG = 448 * MiB;
constexpr size_t WS_NEED = 480 * MiB;
constexpr size_t OFF_K = 208 * MiB;
constexpr size_t OFF_V = 232 * MiB;
constexpr size_t OFF_Q = 256 * MiB;
constexpr size_t OFF_OGA = 304 * MiB;
constexpr size_t OFF_AO = 352 * MiB;
constexpr size_t OFF_EX = 368 * MiB;
constexpr size_t OFF_GT = 376 * MiB;
constexpr size_t OFF_ACT = 384 * MiB;
constexpr size_t OFF_SS2 = 30 * MiB + 512 * 1024;
constexpr size_t OFF_HBT = OFF_HB;
constexpr size_t OFF_ZP = 392 * MiB;
constexpr size_t OFF_DUMMY = 512 * 1024;
constexpr size_t OFF_CENSUS = 15 * 1024;

struct Params {
  const float *x, *hgrn_norm, *hgrn_w_in, *hgrn_lb, *hgrn_out_norm, *hgrn_w_out, *kv_norm, *w_kv, *k_norm, *attn_norm, *w_q,
      *q_norm, *w_o, *ffn_norm, *peer_w_q, *peer_sub_keys, *peer_u, *peer_v;
  float* out;
  unsigned char* ws;
};

DI int opaque_tid() { int t = threadIdx.x; asm volatile("" : "+v"(t)); return t; }
DI int crow(int r, int h) { return (r & 3) + 8 * (r >> 2) + 4 * h; }
DI unsigned pack2(float a, float b) {
  f32x2 v = {a, b};
  return __builtin_bit_cast(unsigned, __builtin_convertvector(v, bf16x2_t));
}
DI u16 f2bf(float f) { return (u16)(pack2(f, 0.f) & 0xffffu); }
DI float bf2f(u16 h) { return __uint_as_float(((unsigned)h) << 16); }
DI float bflo(unsigned u) { return __uint_as_float(u << 16); }
DI float bfhi(unsigned u) { return __uint_as_float(u & 0xffff0000u); }
DI float sigmoidf_(float v) { return 1.f / (1.f + __expf(-v)); }
DI float siluf_(float v) { return v / (1.f + __expf(-v)); }
DI float gelu_tanh(float z) {
  const float y = 0.7978845608028654f * (z + 0.044715f * z * z * z);
  const float t = 1.f - 2.f / (1.f + __expf(2.f * y));
  return 0.5f * z * (1.f + t);
}
DI size_t tiledA(int t, int col, int K) {
  return (size_t)(t >> 5) * (32 * (size_t)K) + (size_t)((((col >> 6) * 4 + ((col >> 4) & 3)) * 64 + ((col >> 3) & 1) * 32 + (t & 31)) * 8 + (col & 7));
}
DI int off128(int row, int c) { return row * 128 + ((c ^ ((row >> 1) & 7)) << 4); }
DI int off256(int row, int c) { return row * 256 + ((c ^ (row & 15)) << 4); }
DI int key_of(float f) { int k = __float_as_int(f); k ^= (k >> 31) & 0x7fffffff; return k; }
DI float val_of(int k) { k ^= (k >> 31) & 0x7fffffff; return __int_as_float(k); }
DI float rstd_from_partials(const float* ss, int m) {
  const float4 a = *(const float4*)(ss + (size_t)m * 8), b = *(const float4*)(ss + (size_t)m * 8 + 4);
  const float t = ((a.x + a.y) + (a.z + a.w)) + ((b.x + b.y) + (b.z + b.w));
  return rsqrtf(t * (1.f / 1024.f) + EPS);
}

template <int N>
DI void bitonic_sort_desc(int (&a)[N]) {
#pragma unroll
  for (int k = 2; k <= N; k <<= 1)
#pragma unroll
    for (int j = k >> 1; j > 0; j >>= 1)
#pragma unroll
      for (int i = 0; i < N; ++i) {
        const int l = i ^ j;
        if (l > i) {
          const int hi = max(a[i], a[l]), lo = min(a[i], a[l]);
          if ((i & k) == 0) { a[i] = hi; a[l] = lo; } else { a[i] = lo; a[l] = hi; }
        }
      }
}
DI void merge_top16(int (&a)[16], const int (&b)[16]) {
#pragma unroll
  for (int i = 0; i < 16; ++i) a[i] = max(a[i], b[15 - i]);
#pragma unroll
  for (int j = 8; j > 0; j >>= 1)
#pragma unroll
    for (int i = 0; i < 16; ++i) {
      const int l = i ^ j;
      if (l > i) { const int hi = max(a[i], a[l]), lo = min(a[i], a[l]); a[i] = hi; a[l] = lo; }
    }
}
#define TOPK_INSERT(a, xk) do { int _x = (xk); _Pragma("unroll") for (int _j = 0; _j < 16; ++_j) { int _t = max(a[_j], _x); _x = min(a[_j], _x); a[_j] = _t; } } while (0)

constexpr int N_TR = 1024 + 256 + 384 + 384 + 128;
constexpr int N_CP = 1024;
constexpr int N_UV = 8192;
constexpr int N_X = 512;
constexpr int N_ROPE = 512;
constexpr int N_MISC = 64;
constexpr int N_P0 = N_TR + N_CP + N_X + N_ROPE + N_MISC;

DI void p0_transpose_tile(const float* src, int N, const float* gain, u16* dst, int ld, int rowoff, int kt, int ntile, float* tile) {
  const int tid = opaque_tid();
  const int k0 = kt * 64, n0 = ntile * 64;
#pragma unroll
  for (int i = 0; i < 4; ++i) {
    const int k = i * 16 + (tid >> 4), n = (tid & 15) * 4;
    float4 v = *(const float4*)(src + (size_t)(k0 + k) * N + n0 + n);
    if (gain) { const float gk = gain[k0 + k]; v.x *= gk; v.y *= gk; v.z *= gk; v.w *= gk; }
    tile[k * 65 + n] = v.x; tile[k * 65 + n + 1] = v.y; tile[k * 65 + n + 2] = v.z; tile[k * 65 + n + 3] = v.w;
  }
  __syncthreads();
  {
    const int n = tid >> 2, kq = (tid & 3) * 16;
    unsigned pk[8];
#pragma unroll
    for (int i = 0; i < 8; ++i) pk[i] = pack2(tile[(kq + 2 * i) * 65 + n], tile[(kq + 2 * i + 1) * 65 + n]);
    uint4* d = (uint4*)(dst + (size_t)(rowoff + n0 + n) * ld + k0 + kq);
    d[0] = make_uint4(pk[0], pk[1], pk[2], pk[3]);
    d[1] = make_uint4(pk[4], pk[5], pk[6], pk[7]);
  }
  __syncthreads();
}

DI void p0_prep(const Params& p, unsigned char* lds) {
  const int tid = opaque_tid(), lane = tid & 63, w = tid >> 6;
  unsigned char* ws = p.ws;
  for (int item = blockIdx.x; item < N_P0; item += gridDim.x) {
    int it = item;
    if (it < N_TR) {
      float* tile = (float*)lds;
      if (it < 1024) p0_transpose_tile(p.hgrn_w_in, 4096, p.hgrn_norm, (u16*)(ws + OFF_WIN), 1024, 0, it / 64, it % 64, tile);
      else if (it < 1280) { it -= 1024; p0_transpose_tile(p.hgrn_w_out, 1024, nullptr, (u16*)(ws + OFF_WOUT), 1024, 0, it / 16, it % 16, tile); }
      else if (it < 1664) { it -= 1280; p0_transpose_tile(p.w_kv, 1536, p.kv_norm, (u16*)(ws + OFF_WKVQ), 1024, 0, it / 24, it % 24, tile); }
      else if (it < 2048) { it -= 1664; p0_transpose_tile(p.w_q, 1536, p.attn_norm, (u16*)(ws + OFF_WKVQ), 1024, 1536, it / 24, it % 24, tile); }
      else { it -= 2048; p0_transpose_tile(p.w_o, 1024, nullptr, (u16*)(ws + OFF_WO), 512, 0, it / 16, it % 16, tile); }
      continue;
    }
    it -= N_TR;
    if (it < N_CP) {
      const int l = it >> 9, rem = it & 511, h = rem >> 6, wsel = (rem >> 5) & 1, nh = (rem >> 4) & 1;
      const int c0 = (rem & 15) * 64;
      float* Ws = (float*)lds;
      float* Ks = (float*)(lds + 64 * 65 * 4);
      const float* keys = p.peer_sub_keys + ((size_t)(l * 2 + wsel) * 128 + nh * 64) * 128;
      const float* Wp = p.peer_w_q + (size_t)l * 1024 * 2048 + (size_t)c0 * 2048 + h * 256 + wsel * 128;
      const int ci = w & 1, ni = w >> 1, r31 = lane & 31, kh = lane >> 5;
      f32x16 acc;
#pragma unroll
      for (int r = 0; r < 16; ++r) acc[r] = 0.f;
      for (int ps = 0; ps < 2; ++ps) {
#pragma unroll 4
        for (int i = 0; i < 16; ++i) {
          const int idx = tid + 256 * i, rr = idx >> 6, d = idx & 63;
          Ws[rr * 65 + d] = Wp[(size_t)rr * 2048 + ps * 64 + d] * p.ffn_norm[l * 1024 + c0 + rr];
          Ks[rr * 65 + d] = keys[rr * 128 + ps * 64 + d];
        }
        __syncthreads();
#pragma unroll 8
        for (int s2 = 0; s2 < 32; ++s2)
          acc = __builtin_amdgcn_mfma_f32_32x32x2f32(Ws[(ci * 32 + r31) * 65 + 2 * s2 + kh], Ks[(ni * 32 + r31) * 65 + 2 * s2 + kh], acc, 0, 0, 0);
        __syncthreads();
      }
      u16* dst = (u16*)(ws + (l ? OFF_WPQ1 : OFF_WPQ0)) + (size_t)(h * 256 + wsel * 128 + nh * 64 + ni * 32 + r31) * 1024 + c0 + ci * 32;
#pragma unroll
      for (int g = 0; g < 4; ++g) *(uint2*)(dst + 8 * g + 4 * kh) = make_uint2(pack2(acc[4 * g], acc[4 * g + 1]), pack2(acc[4 * g + 2], acc[4 * g + 3]));
      continue;
    }
    it -= N_CP;
    if (it < N_X) {
      float* xt = (float*)lds;
      const int t0 = it * 32;
      u16* dst = (u16*)(ws + OFF_HB) + (size_t)it * 32768;
      float ssr[8];
#pragma unroll
      for (int i = 0; i < 8; ++i) ssr[i] = 0.f;
      typedef float v4f __attribute__((ext_vector_type(4)));
      v4f xa[8], xb[8];
#define X_LOAD(R, CH) do { _Pragma("unroll") for (int i = 0; i < 8; ++i) R[i] = *(const v4f*)(p.x + (size_t)(t0 + w + 4 * i) * 1024 + (CH) * 256 + lane * 4); } while (0)
#define X_CHUNK(R, CH) do { \
        _Pragma("unroll") for (int i = 0; i < 8; ++i) { ssr[i] += R[i][0] * R[i][0] + R[i][1] * R[i][1] + R[i][2] * R[i][2] + R[i][3] * R[i][3]; *(v4f*)(xt + (w + 4 * i) * 260 + lane * 4) = R[i]; } \
        __syncthreads(); \
        _Pragma("unroll") for (int sl = 0; sl < 4; ++sl) {     \
          const int slot = w * 4 + sl, l31 = lane & 31, hf = lane >> 5; \
          const float4 v0 = *(const float4*)(xt + l31 * 260 + slot * 16 + hf * 8), v1 = *(const float4*)(xt + l31 * 260 + slot * 16 + hf * 8 + 4); \
          *(uint4*)(dst + (size_t)(((CH) * 16 + slot) * 64 + lane) * 8) = make_uint4(pack2(v0.x, v0.y), pack2(v0.z, v0.w), pack2(v1.x, v1.y), pack2(v1.z, v1.w)); } \
        __syncthreads(); } while (0)
      X_LOAD(xa, 0);
      X_LOAD(xb, 1);
      X_CHUNK(xa, 0);
      X_LOAD(xa, 2);
      X_CHUNK(xb, 1);
      X_LOAD(xb, 3);
      X_CHUNK(xa, 2);
      X_CHUNK(xb, 3);
#undef X_LOAD
#undef X_CHUNK
#pragma unroll
      for (int i = 0; i < 8; ++i) {
        float ss = ssr[i];
#pragma unroll
        for (int o = 32; o >= 1; o >>= 1) ss += __shfl_xor(ss, o);
        if (lane == 0) ((float*)(ws + OFF_RSTD0))[t0 + w + 4 * i] = rsqrtf(ss * (1.f / 1024.f) + EPS);
      }
      continue;
    }
    it -= N_X;
    if (it < N_ROPE) {
      const int idx = it * 256 + tid; const int pos = idx >> 4, i = idx & 15;
      const float inv = powf(500000.f, -(float)i * (1.f / 16.f));
      const float ang = (float)pos * inv;
      float s, c; sincosf(ang, &s, &c);
      ((float2*)(ws + OFF_ROPE))[idx] = make_float2(c, s);
      continue;
    }
    it -= N_ROPE;
    {
      const int idx = it * 256 + tid;
      if (idx < 1024) {
        const float l0 = p.hgrn_lb[idx], l1 = p.hgrn_lb[1024 + idx];
        ((float*)(ws + OFF_LB))[idx] = 1.f / (1.f + __expf(l1 - l0));
      }
      if (idx == 0) {
        float mq = 0.f, mk = 0.f;
        for (int i = 0; i < 128; ++i) { mq = fmaxf(mq, fabsf(p.q_norm[i])); mk = fmaxf(mk, fabsf(p.k_norm[i])); }
        ((float*)(ws + OFF_MISC))[0] = 11.313708499f * mq * mk;
      }
    }
  }
}

DI void peer_tables(const Params& p, int l, int ibeg, int iend) {
  const int tid = opaque_tid(), lane = tid & 63, w = tid >> 6;
  unsigned char* ws = p.ws;
  for (int i = ibeg; i < iend; ++i) {
    const int e = (int)(blockIdx.x * 4 + w) + (int)(gridDim.x * 4) * i;
    if (e >= 16384) break;
    const float* su = p.peer_u + ((size_t)l * 16384 + e) * 1024 + lane * 4;
    const float* sv = p.peer_v + ((size_t)l * 16384 + e) * 1024 + lane * 4;
    const float* g = p.ffn_norm + l * 1024 + lane * 4;
    float uu[16], vv[16];
#pragma unroll
    for (int k = 0; k < 4; ++k) {
      const float4 a = *(const float4*)(su + 256 * k); const float4 gg = *(const float4*)(g + 256 * k); const float4 bq = *(const float4*)(sv + 256 * k);
      uu[4 * k] = a.x * gg.x; uu[4 * k + 1] = a.y * gg.y; uu[4 * k + 2] = a.z * gg.z; uu[4 * k + 3] = a.w * gg.w;
      vv[4 * k] = bq.x; vv[4 * k + 1] = bq.y; vv[4 * k + 2] = bq.z; vv[4 * k + 3] = bq.w;
    }
    float mu = 0.f, mv = 0.f;
#pragma unroll
    for (int k = 0; k < 16; ++k) { mu = fmaxf(mu, fabsf(uu[k])); mv = fmaxf(mv, fabsf(vv[k])); }
#pragma unroll
    for (int o = 32; o >= 1; o >>= 1) { mu = fmaxf(mu, __shfl_xor(mu, o)); mv = fmaxf(mv, __shfl_xor(mv, o)); }
    const float scu = mu > 0.f ? mu * (1.f / 448.f) : 1.f, scv = mv > 0.f ? mv * (1.f / 448.f) : 1.f;
    const float iu = 1.f / scu, iv = 1.f / scv;
    unsigned char* base = ws + (l ? OFF_UV1 : OFF_UV0);
#pragma unroll
    for (int k = 0; k < 4; ++k) {
      int pk = 0;
      pk = __builtin_amdgcn_cvt_pk_fp8_f32(uu[4 * k] * iu, uu[4 * k + 1] * iu, pk, false);
      pk = __builtin_amdgcn_cvt_pk_fp8_f32(uu[4 * k + 2] * iu, uu[4 * k + 3] * iu, pk, true);
      int pv = 0;
      pv = __builtin_amdgcn_cvt_pk_fp8_f32(vv[4 * k] * iv, vv[4 * k + 1] * iv, pv, false);
      pv = __builtin_amdgcn_cvt_pk_fp8_f32(vv[4 * k + 2] * iv, vv[4 * k + 3] * iv, pv, true);
      const size_t off = ((size_t)(2 * k + (lane >> 5)) * 16384 + e) * 128 + (lane & 31) * 4;
      *(int*)(base + off) = pk;
      *(int*)(base + 16 * MiB + off) = pv;
    }
    if (lane == 0) ((float2*)(ws + (l ? OFF_SC1 : OFF_SC0)))[e] = make_float2(scu, scv);
  }
}

template <class Epi, int SIDE = 0, bool PAIR = false>
DI void gemm_phase(const Params& p, const u16* __restrict__ A, int lda, const u16* __restrict__ Bt, int ldb, int MT, int NT, int nk, Epi& epi, unsigned char* lds) {
  const int ntl = 0;
  const int nrw = (16384 + (int)gridDim.x * 4 - 1) / ((int)gridDim.x * 4);
  int seq = 0;
  const bool side_first = SIDE && (blockIdx.x * 2 >= gridDim.x);
  if (side_first) peer_tables(p, SIDE - 1, 0, nrw);
  const int Gx = (int)gridDim.x, bxx = (int)blockIdx.x;
  const bool two = Gx >= 2;
  const int Gl = two ? (Gx + 1) >> 1 : Gx;
  const bool upper = two && bxx >= Gl;
  const int NU = PAIR ? NT / 2 : NT;
  const int NH = two ? (upper ? NU - (NU >> 1) : (NU >> 1)) : NU;
  const int ubase = upper ? (NU >> 1) : 0;
  const int ustride = upper ? Gx - Gl : Gl;
  for (int u = upper ? bxx - Gl : bxx; u < MT * NH; u += ustride)
  for (int sub = 0; sub < (PAIR ? 2 : 1); ++sub) {
    const int mt = u / NH, unit = (u - mt * NH) + ubase;
    const int tid = opaque_tid(), lane = tid & 63, w = tid >> 6, l31 = lane & 31, half = lane >> 5;
    const int goffB0 = (tid >> 3) * ldb + (tid & 7) * 8;
    const int loffB0 = off128(tid >> 3, tid & 7);
    const int goffA = w * 32 * lda + lane * 8;
    const int lrowF = l31 * 128, lxF = (half ^ ((l31 >> 1) & 7)) << 4;
    const int nt = PAIR ? 2 * unit + sub : unit;
    const int m0 = mt * 128, n0 = nt * 128;
    f32x16 acc[4];
#pragma unroll
    for (int i = 0; i < 4; ++i)
#pragma unroll
      for (int r = 0; r < 16; ++r) acc[i][r] = 0.f;
    const u16* Ab = A + (size_t)m0 * lda + goffA;
    const u16* Bb = Bt + (size_t)n0 * ldb;
    bf16x8 aR[2][4];
    u32x4 bR[4][4];
#define LOAD_A(slot, ks) do { _Pragma("unroll") for (int kk = 0; kk < 4; ++kk) aR[slot][kk] = *(const bf16x8*)(Ab + ((ks) * 4 + kk) * 512); } while (0)
#define LOAD_B(slot, ks) do { _Pragma("unroll") for (int j = 0; j < 4; ++j) bR[slot][j] = *(const u32x4*)(Bb + goffB0 + j * 32 * ldb + (ks) * 64); } while (0)
#define STORE_B(slot, buf) do { _Pragma("unroll") for (int j = 0; j < 4; ++j) *(u32x4*)(lds + (buf) * 16384 + loffB0 + j * 4096) = bR[slot][j]; } while (0)
#define GEMM_STEP(ks, sa, sb) do { \
      const unsigned char* base_ = lds + ((sa) & 1) * 16384; \
      _Pragma("unroll") for (int kk = 0; kk < 4; ++kk) { \
        _Pragma("unroll") for (int n4 = 0; n4 < 4; ++n4) { \
          const bf16x8 wf = *(const bf16x8*)(base_ + n4 * 4096 + lrowF + (lxF ^ (kk << 5))); \
          acc[n4] = MFMA32(wf, aR[(sa) & 1][kk], acc[n4]); } } \
      if ((ks) + 2 < nk) LOAD_A((sa) & 1, (ks) + 2); \
      if ((ks) + 1 < nk) STORE_B(sb, (sb) & 1); \
      if ((ks) + 5 < nk) LOAD_B(sb, (ks) + 5); \
      __syncthreads(); } while (0)
    LOAD_B(0, 0); LOAD_B(1, 1); LOAD_B(2, 2); LOAD_B(3, 3);
    LOAD_A(0, 0); LOAD_A(1, 1);
    STORE_B(0, 0);
    LOAD_B(0, 4);
    __syncthreads();
#pragma unroll 1
    for (int ks = 0; ks < nk; ks += 4) {
      GEMM_STEP(ks, 0, 1);
      GEMM_STEP(ks + 1, 1, 2);
      GEMM_STEP(ks + 2, 2, 3);
      GEMM_STEP(ks + 3, 3, 0);
    }
    epi(acc, m0 + w * 32 + l31, n0, half);
    ++seq;
  }
  if (SIDE && !side_first) peer_tables(p, SIDE - 1, 0, nrw);
  (void)ntl; (void)seq;
#undef LOAD_A
#undef LOAD_B
#undef STORE_B
#undef GEMM_STEP
}

struct EpiNull {
  DI void operator()(f32x16 (&acc)[4], int m, int n0, int half) const {
#pragma unroll
    for (int i = 0; i < 4; ++i)
#pragma unroll
      for (int r = 0; r < 16; ++r) asm volatile("" :: "v"(acc[i][r]));
  }
};
struct EpiHgrnIn {
  const float* rstd; const float* lb; u16 *Qg, *Vg, *Gg; _Float16* LOGF;
  DI void operator()(f32x16 (&acc)[4], int m, int n0, int half) const {
    const float rs = rstd[m];
    const int sec = n0 >> 10, colb = n0 & 1023;
    const int pos = m & (SEQ - 1);
    const size_t tb0 = ((size_t)(((m >> 13) * 8 + (colb >> 7)) * 128 + (pos >> 6))) * 8192 + (size_t)(pos & 63) * 4;
#pragma unroll
    for (int n4 = 0; n4 < 4; ++n4)
#pragma unroll
      for (int g = 0; g < 4; ++g) {
        const int dl = n4 * 32 + 8 * g + 4 * half;
        const size_t to = tb0 + (size_t)(dl >> 2) * 256;
        float v[4];
#pragma unroll
        for (int j = 0; j < 4; ++j) v[j] = acc[n4][4 * g + j] * rs;
        if (sec == 0) {
          *(uint2*)(Qg + to) = make_uint2(pack2(siluf_(v[0]), siluf_(v[1])), pack2(siluf_(v[2]), siluf_(v[3])));
        } else if (sec == 1) {
          const float4 lbv = *(const float4*)(lb + colb + dl);
          const float lbs[4] = {lbv.x, lbv.y, lbv.z, lbv.w};
          typedef _Float16 h4 __attribute__((ext_vector_type(4)));
          h4 lf;
#pragma unroll
          for (int j = 0; j < 4; ++j) lf[j] = (_Float16)__logf(lbs[j] + (1.f - lbs[j]) * sigmoidf_(v[j]));
          *(h4*)(LOGF + to) = lf;
        } else if (sec == 2) {
          *(uint2*)(Vg + to) = make_uint2(pack2(v[0], v[1]), pack2(v[2], v[3]));
        } else {
          *(uint2*)(Gg + (size_t)m * 1024 + colb + dl) = make_uint2(pack2(siluf_(v[0]), siluf_(v[1])), pack2(siluf_(v[2]), siluf_(v[3])));
        }
      }
  }
};

template <bool RES_TILED>
struct EpiResidual {
  const float* res; u16* hbt; float* ss;
  DI void operator()(f32x16 (&acc)[4], int m, int n0, int half) const {
    float s = 0.f;
#pragma unroll
    for (int n4 = 0; n4 < 4; ++n4)
#pragma unroll
      for (int g = 0; g < 4; ++g) {
        const int col = n0 + n4 * 32 + 8 * g + 4 * half;
        u16* dst = hbt + tiledA(m, col, 1024);
        float r0, r1, r2, r3;
        if (RES_TILED) { const uint2 rv = *(const uint2*)dst; r0 = bflo(rv.x); r1 = bfhi(rv.x); r2 = bflo(rv.y); r3 = bfhi(rv.y); }
        else { const float4 rv = *(const float4*)(res + (size_t)m * 1024 + col); r0 = rv.x; r1 = rv.y; r2 = rv.z; r3 = rv.w; }
        const float v0 = acc[n4][4 * g] + r0, v1 = acc[n4][4 * g + 1] + r1, v2 = acc[n4][4 * g + 2] + r2, v3 = acc[n4][4 * g + 3] + r3;
        *(uint2*)dst = make_uint2(pack2(v0, v1), pack2(v2, v3));
        s += v0 * v0 + v1 * v1 + v2 * v2 + v3 * v3;
      }
    s += __shfl_xor(s, 32);
    if (half == 0) ss[(size_t)m * 8 + (n0 >> 7)] = s;
  }
};

struct EpiTopk {
  const float* ss; int* EX; float* GT; unsigned char* sel_lds;
  DI void operator()(f32x16 (&acc)[4], int m, int n0, int half) {
    const float rs = rstd_from_partials(ss, m);
    int k0[16], k1[16];
#pragma unroll
    for (int r = 0; r < 16; ++r) {
      k0[r] = (key_of(acc[0][r] * rs) & ~0x7f) | (crow(r, half));
      k1[r] = (key_of(acc[1][r] * rs) & ~0x7f) | (32 + crow(r, half));
    }
    bitonic_sort_desc<16>(k0);
    __builtin_amdgcn_sched_barrier(0);
    bitonic_sort_desc<16>(k1);
    merge_top16(k0, k1);
    __builtin_amdgcn_sched_barrier(0);
#pragma unroll
    for (int r = 0; r < 16; ++r) k1[r] = (key_of(acc[2][r] * rs) & ~0x7f) | (64 + crow(r, half));
    bitonic_sort_desc<16>(k1);
    merge_top16(k0, k1);
    __builtin_amdgcn_sched_barrier(0);
#pragma unroll
    for (int r = 0; r < 16; ++r) k1[r] = (key_of(acc[3][r] * rs) & ~0x7f) | (96 + crow(r, half));
    bitonic_sort_desc<16>(k1);
    merge_top16(k0, k1);
    __builtin_amdgcn_sched_barrier(0);
    int b[16];
#pragma unroll
    for (int j = 0; j < 16; ++j) b[j] = __shfl_xor(k0[j], 32);
    merge_top16(k0, b);
    volatile int* stash = (volatile int*)(sel_lds + 2048 + (threadIdx.x & 63) * 64);
    if (((n0 >> 7) & 1) == 0) {
#pragma unroll
      for (int j = 0; j < 16; ++j) stash[j] = k0[j];
      return;
    }
    int kprev[16];
#pragma unroll
    for (int j = 0; j < 16; ++j) kprev[j] = stash[j];
#define F1(i) val_of(kprev[i] & ~0x7f)
#define F2(j) val_of(k0[j] & ~0x7f)
    int a[16];
#pragma unroll
    for (int j = 0; j < 16; ++j) a[j] = (int)0x80000000;
#define SEL_PAIR(IA, JA, IB, JB) do { const int ka_ = (key_of(F1(IA) + F2(JA)) & ~0xff) | ((IA) * 16 + (JA)), kb_ = (key_of(F1(IB) + F2(JB)) & ~0xff) | ((IB) * 16 + (JB)); \
      const int kk_ = half ? kb_ : ka_; TOPK_INSERT(a, kk_); } while (0)
      SEL_PAIR(0, 0, 0, 1);
      SEL_PAIR(0, 2, 0, 3);
      SEL_PAIR(0, 4, 0, 5);
      SEL_PAIR(0, 6, 0, 7);
      SEL_PAIR(0, 8, 0, 9);
      SEL_PAIR(0, 10, 0, 11);
      SEL_PAIR(0, 12, 0, 13);
      SEL_PAIR(0, 14, 0, 15);
      SEL_PAIR(1, 0, 1, 1);
      SEL_PAIR(1, 2, 1, 3);
      SEL_PAIR(1, 4, 1, 5);
      SEL_PAIR(1, 6, 1, 7);
      SEL_PAIR(2, 0, 2, 1);
      SEL_PAIR(2, 2, 2, 3);
      SEL_PAIR(2, 4, 3, 0);
      SEL_PAIR(3, 1, 3, 2);
      SEL_PAIR(3, 3, 4, 0);
      SEL_PAIR(4, 1, 4, 2);
      SEL_PAIR(5, 0, 5, 1);
      SEL_PAIR(6, 0, 6, 1);
      SEL_PAIR(7, 0, 7, 1);
      SEL_PAIR(8, 0, 9, 0);
      SEL_PAIR(10, 0, 11, 0);
      SEL_PAIR(12, 0, 13, 0);
      SEL_PAIR(14, 0, 15, 0);
#undef SEL_PAIR
#undef F1
#undef F2
#pragma unroll
    for (int j = 0; j < 16; ++j) b[j] = __shfl_xor(a[j], 32);
    merge_top16(a, b);
    unsigned char* my = sel_lds + (m & 31) * 36;
    {
      unsigned pk4[4];
#pragma unroll
      for (int q = 0; q < 4; ++q) {
        const int s0 = half ? k0[4 * q] : kprev[4 * q], s1 = half ? k0[4 * q + 1] : kprev[4 * q + 1], s2 = half ? k0[4 * q + 2] : kprev[4 * q + 2], s3 = half ? k0[4 * q + 3] : kprev[4 * q + 3];
        pk4[q] = (unsigned)(s0 & 0x7f) | ((unsigned)(s1 & 0x7f) << 8) | ((unsigned)(s2 & 0x7f) << 16) | ((unsigned)(s3 & 0x7f) << 24);
      }
#pragma unroll
      for (int q = 0; q < 4; ++q) *(volatile unsigned*)(my + half * 16 + 4 * q) = pk4[q];
    }
    asm volatile("s_waitcnt lgkmcnt(0)" ::: "memory");
    float cs[16];
    float sum = 0.f;
    const float mx = val_of(a[0] & ~0xff);
#pragma unroll
    for (int k = 0; k < 16; ++k) { cs[k] = __expf(val_of(a[k] & ~0xff) - mx); sum += cs[k]; }
    const float inv = 1.f / sum;
    const int hcol = (n0 >> 8) * 16;
    if (half == 0) {
      int eo[16];
#pragma unroll
      for (int k = 0; k < 16; ++k) { const int ij = a[k] & 0xff; eo[k] = (int)((volatile unsigned char*)my)[ij >> 4] * 128 + (int)((volatile unsigned char*)my)[16 + (ij & 15)]; }
      int4* de = (int4*)(EX + (size_t)m * 128 + hcol);
#pragma unroll
      for (int q = 0; q < 4; ++q) de[q] = make_int4(eo[4 * q], eo[4 * q + 1], eo[4 * q + 2], eo[4 * q + 3]);
    } else {
      float4* dg = (float4*)(GT + (size_t)m * 128 + hcol);
#pragma unroll
      for (int q = 0; q < 4; ++q) dg[q] = make_float4(cs[4 * q] * inv, cs[4 * q + 1] * inv, cs[4 * q + 2] * inv, cs[4 * q + 3] * inv);
    }
  }
};

struct EpiKVQ {
  const float* ss; const float *k_norm, *q_norm; const float2* rope; u16 *Kb, *Vb, *Qb;
  DI void operator()(f32x16 (&acc)[4], int m, int n0, int half) const {
    const float rs = rstd_from_partials(ss, m);
    u16* dst; const float* gain = nullptr;
    if (n0 < 768) { dst = Kb + (size_t)m * 768 + n0; gain = k_norm; }
    else if (n0 < 1536) { dst = Vb + (size_t)m * 768 + (n0 - 768); }
    else { dst = Qb + (size_t)m * 1536 + (n0 - 1536); gain = q_norm; }
#pragma unroll
    for (int n4 = 0; n4 < 4; ++n4)
#pragma unroll
      for (int r = 0; r < 16; ++r) acc[n4][r] *= rs;
    if (gain) {
      float s = 0.f;
#pragma unroll
      for (int n4 = 0; n4 < 4; ++n4)
#pragma unroll
        for (int r = 0; r < 16; ++r) s += acc[n4][r] * acc[n4][r];
      s += __shfl_xor(s, 32);
      const float rn = rsqrtf(s * (1.f / 128.f) + EPS);
#pragma unroll
      for (int n4 = 0; n4 < 4; ++n4)
#pragma unroll
        for (int g = 0; g < 4; ++g) {
          const float4 gv = *(const float4*)(gain + n4 * 32 + 8 * g + 4 * half);
          acc[n4][4 * g] *= rn * gv.x; acc[n4][4 * g + 1] *= rn * gv.y; acc[n4][4 * g + 2] *= rn * gv.z; acc[n4][4 * g + 3] *= rn * gv.w;
        }
      const int pos = m & (SEQ - 1);
#pragma unroll
      for (int r = 0; r < 8; ++r) {
        const float2 cs = rope[pos * 16 + crow(r, half)];
        const float x1 = acc[0][r], x2 = acc[0][r + 8];
        acc[0][r] = x1 * cs.x - x2 * cs.y;
        acc[0][r + 8] = x2 * cs.x + x1 * cs.y;
      }
    }
#pragma unroll
    for (int n4 = 0; n4 < 4; ++n4)
#pragma unroll
      for (int g = 0; g < 4; ++g)
        *(uint2*)(dst + n4 * 32 + 8 * g + 4 * half) = make_uint2(pack2(acc[n4][4 * g], acc[n4][4 * g + 1]), pack2(acc[n4][4 * g + 2], acc[n4][4 * g + 3]));
  }
};

DI void gla_g1(const Params& p, unsigned char* lds) {
  const int tid = opaque_tid(), lane = tid & 63, w = tid >> 6, l31 = lane & 31, half = lane >> 5;
  unsigned char* ws = p.ws;
  const _Float16* LOGF = (const _Float16*)(ws + OFF_LOGF);
  const u16* Vg = (const u16*)(ws + OFF_VG);
  u16* UT = (u16*)(ws + OFF_UT);
  float* ACH = (float*)(ws + OFF_ACH);
  unsigned char* KT = lds;
  unsigned char* VT = lds + 16384;
  float* tot = (float*)(lds + 32768);
  for (int item = blockIdx.x; item < 2048; item += gridDim.x) {
    const int bh = item >> 7, c = item & 127, b = bh >> 3, h = bh & 7;
    (void)b; (void)h;
    const int dg = tid & 31, jr = tid >> 5, d0 = dg * 4;
    const size_t tb = (size_t)item * 8192 + (size_t)(dg * 64 + jr * 8) * 4;
    float lfv[8][4], bl[8][4];
    {
      typedef _Float16 h8 __attribute__((ext_vector_type(8)));
      float run[4] = {0.f, 0.f, 0.f, 0.f};
#pragma unroll
      for (int q = 0; q < 4; ++q) {
        const h8 lf = *(const h8*)(LOGF + tb + 8 * q);
#pragma unroll
        for (int i = 0; i < 8; ++i) { const int jj = 2 * q + (i >> 2), dd = i & 3; lfv[jj][dd] = (float)lf[i]; run[dd] += lfv[jj][dd]; bl[jj][dd] = run[dd]; }
      }
      *(float4*)(tot + jr * 128 + d0) = make_float4(run[0], run[1], run[2], run[3]);
    }
    __syncthreads();
    float pre[4] = {0.f, 0.f, 0.f, 0.f}, blast[4] = {0.f, 0.f, 0.f, 0.f};
#pragma unroll
    for (int r = 0; r < 8; ++r) {
      const float4 tv = *(const float4*)(tot + r * 128 + d0);
      const float m_ = (r < jr) ? 1.f : 0.f;
      pre[0] += m_ * tv.x; pre[1] += m_ * tv.y; pre[2] += m_ * tv.z; pre[3] += m_ * tv.w;
      blast[0] += tv.x; blast[1] += tv.y; blast[2] += tv.z; blast[3] += tv.w;
    }
#pragma unroll
    for (int dd = 0; dd < 4; ++dd) {
      unsigned pk[4];
#pragma unroll
      for (int i = 0; i < 4; ++i)
        pk[i] = pack2((1.f - __expf(lfv[2 * i][dd])) * __expf(blast[dd] - (bl[2 * i][dd] + pre[dd])), (1.f - __expf(lfv[2 * i + 1][dd])) * __expf(blast[dd] - (bl[2 * i + 1][dd] + pre[dd])));
      *(uint4*)(KT + off128(d0 + dd, jr)) = make_uint4(pk[0], pk[1], pk[2], pk[3]);
    }
    {
      uint4 vq[4];
#pragma unroll
      for (int q = 0; q < 4; ++q) vq[q] = *(const uint4*)(Vg + tb + 8 * q);
      *(uint4*)(VT + off128(d0 + 0, jr)) = make_uint4((vq[0].x & 0xffffu) | (vq[0].z << 16), (vq[1].x & 0xffffu) | (vq[1].z << 16), (vq[2].x & 0xffffu) | (vq[2].z << 16), (vq[3].x & 0xffffu) | (vq[3].z << 16));
      *(uint4*)(VT + off128(d0 + 1, jr)) = make_uint4((vq[0].x >> 16) | (vq[0].z & 0xffff0000u), (vq[1].x >> 16) | (vq[1].z & 0xffff0000u), (vq[2].x >> 16) | (vq[2].z & 0xffff0000u), (vq[3].x >> 16) | (vq[3].z & 0xffff0000u));
      *(uint4*)(VT + off128(d0 + 2, jr)) = make_uint4((vq[0].y & 0xffffu) | (vq[0].w << 16), (vq[1].y & 0xffffu) | (vq[1].w << 16), (vq[2].y & 0xffffu) | (vq[2].w << 16), (vq[3].y & 0xffffu) | (vq[3].w << 16));
      *(uint4*)(VT + off128(d0 + 3, jr)) = make_uint4((vq[0].y >> 16) | (vq[0].w & 0xffff0000u), (vq[1].y >> 16) | (vq[1].w & 0xffff0000u), (vq[2].y >> 16) | (vq[2].w & 0xffff0000u), (vq[3].y >> 16) | (vq[3].w & 0xffff0000u));
    }
    if (jr == 0) *(float4*)(ACH + item * 128 + d0) = make_float4(__expf(blast[0]), __expf(blast[1]), __expf(blast[2]), __expf(blast[3]));
    __syncthreads();
    f32x16 acc[4];
#pragma unroll
    for (int i = 0; i < 4; ++i)
#pragma unroll
      for (int r = 0; r < 16; ++r) acc[i][r] = 0.f;
#pragma unroll
    for (int s = 0; s < 4; ++s) {
      const bf16x8 af = *(const bf16x8*)(KT + off128(w * 32 + l31, 2 * s + half));
#pragma unroll
      for (int et = 0; et < 4; ++et) {
        const bf16x8 bfr = *(const bf16x8*)(VT + off128(et * 32 + l31, 2 * s + half));
        acc[et] = MFMA32(af, bfr, acc[et]);
      }
    }
#pragma unroll
    for (int et = 0; et < 4; ++et)
#pragma unroll
      for (int g = 0; g < 4; ++g) {
        const int e = et * 32 + l31, d0 = w * 32 + 8 * g + 4 * half;
        *(uint2*)(UT + ((size_t)item * 128 + e) * 128 + d0) = make_uint2(pack2(acc[et][4 * g], acc[et][4 * g + 1]), pack2(acc[et][4 * g + 2], acc[et][4 * g + 3]));
      }
    __syncthreads();
  }
}

DI void gla_g2(const Params& p) {
  const int tid = opaque_tid();
  unsigned char* ws = p.ws;
  u16* UT = (u16*)(ws + OFF_UT);
  const float* ACH = (const float*)(ws + OFF_ACH);
  for (int u = blockIdx.x; u < 1024; u += gridDim.x) {
    const int bh = u >> 6, e = (u & 63) * 2 + (tid >> 7), d = tid & 127;
    float S = 0.f;
    size_t idx = ((size_t)bh * 128) * 16384 + (size_t)e * 128 + d;
    size_t aidx = (size_t)bh * 128 * 128 + d;
    for (int c = 0; c < 128; c += 32) {
      float uv[32], av[32];
#pragma unroll
      for (int k = 0; k < 32; ++k) { uv[k] = bf2f(UT[idx + (size_t)k * 16384]); av[k] = ACH[aidx + (size_t)k * 128]; }
#pragma unroll
      for (int k = 0; k < 32; ++k) { UT[idx + (size_t)k * 16384] = f2bf(S); S = av[k] * S + uv[k]; }
      idx += (size_t)32 * 16384; aidx += 32 * 128;
    }
  }
}

DI void gla_g3(const Params& p, unsigned char* lds) {
  const int tid = opaque_tid(), lane = tid & 63, w = tid >> 6, l31 = lane & 31, half = lane >> 5;
  unsigned char* ws = p.ws;
  const _Float16* LOGF = (const _Float16*)(ws + OFF_LOGF);
  const u16* Qg = (const u16*)(ws + OFF_QG);
  const u16* Vg = (const u16*)(ws + OFF_VG);
  const u16* Gg = (const u16*)(ws + OFF_GG);
  const u16* ST = (const u16*)(ws + OFF_UT);
  u16* OG = (u16*)(ws + OFF_OG);
  unsigned char* QP = lds;
  unsigned char* KP = lds + 16384;
  unsigned char* VT = lds + 32768;
  unsigned char* STs = lds + 16384;
  float* tot = (float*)(lds + 49152);
  float* red = (float*)(lds + 49152 + 4096);
  for (int item = blockIdx.x; item < 2048; item += gridDim.x) {
    const int bh = item >> 7, c = item & 127, b = bh >> 3, h = bh & 7;
    const int t0 = b * SEQ + c * 64;
    u32x4 stq[8];
    {
      const u16* src = ST + (size_t)item * 16384;
#pragma unroll
      for (int j = 0; j < 8; ++j) { const int id = tid + 256 * j; stq[j] = *(const u32x4*)(src + (size_t)(id >> 4) * 128 + (id & 15) * 8); }
    }
    u32x2 ggq[2][4];
    {
      const int tq_ = t0 + (w & 1) * 32 + l31;
#pragma unroll
      for (int ee = 0; ee < 2; ++ee)
#pragma unroll
        for (int g = 0; g < 4; ++g) ggq[ee][g] = *(const u32x2*)(Gg + (size_t)tq_ * 1024 + h * 128 + ((w >> 1) * 2 + ee) * 32 + 8 * g + 4 * half);
    }
    const int dg = tid & 31, jr = tid >> 5, d0 = dg * 4;
    const size_t tb = (size_t)item * 8192 + (size_t)(dg * 64 + jr * 8) * 4;
    float lfv[8][4], bl[8][4];
    {
      typedef _Float16 h8 __attribute__((ext_vector_type(8)));
      float run[4] = {0.f, 0.f, 0.f, 0.f};
#pragma unroll
      for (int q = 0; q < 4; ++q) {
        const h8 lf = *(const h8*)(LOGF + tb + 8 * q);
#pragma unroll
        for (int i = 0; i < 8; ++i) { const int jj = 2 * q + (i >> 2), dd = i & 3; lfv[jj][dd] = (float)lf[i]; run[dd] += lfv[jj][dd]; bl[jj][dd] = run[dd]; }
      }
      *(float4*)(tot + jr * 128 + d0) = make_float4(run[0], run[1], run[2], run[3]);
    }
    __syncthreads();
    float pre[4] = {0.f, 0.f, 0.f, 0.f}, blast[4] = {0.f, 0.f, 0.f, 0.f};
#pragma unroll
    for (int r = 0; r < 8; ++r) {
      const float4 tv = *(const float4*)(tot + r * 128 + d0);
      const float m_ = (r < jr) ? 1.f : 0.f;
      pre[0] += m_ * tv.x; pre[1] += m_ * tv.y; pre[2] += m_ * tv.z; pre[3] += m_ * tv.w;
      blast[0] += tv.x; blast[1] += tv.y; blast[2] += tv.z; blast[3] += tv.w;
    }
    {
      uint4 qq[4];
#pragma unroll
      for (int q = 0; q < 4; ++q) qq[q] = *(const uint4*)(Qg + tb + 8 * q);
#pragma unroll
      for (int jj = 0; jj < 8; ++jj) {
        const int i = jr * 8 + jj;
        const unsigned q01 = (jj & 1) ? qq[jj >> 1].z : qq[jj >> 1].x, q23 = (jj & 1) ? qq[jj >> 1].w : qq[jj >> 1].y;
        const float qf[4] = {bflo(q01), bfhi(q01), bflo(q23), bfhi(q23)};
        float qv[4], kv[4];
#pragma unroll
        for (int dd = 0; dd < 4; ++dd) { const float bv = bl[jj][dd] + pre[dd]; qv[dd] = qf[dd] * __expf(bv); kv[dd] = (1.f - __expf(lfv[jj][dd])) * __expf(-bv); }
        const int o = i * 256 + (((d0 >> 3) ^ (i & 15)) << 4) + (d0 & 7) * 2;
        *(uint2*)(QP + o) = make_uint2(pack2(qv[0], qv[1]), pack2(qv[2], qv[3]));
        *(uint2*)(KP + o) = make_uint2(pack2(kv[0], kv[1]), pack2(kv[2], kv[3]));
      }
    }
    {
      uint4 vq[4];
#pragma unroll
      for (int q = 0; q < 4; ++q) vq[q] = *(const uint4*)(Vg + tb + 8 * q);
      *(uint4*)(VT + off128(d0 + 0, jr)) = make_uint4((vq[0].x & 0xffffu) | (vq[0].z << 16), (vq[1].x & 0xffffu) | (vq[1].z << 16), (vq[2].x & 0xffffu) | (vq[2].z << 16), (vq[3].x & 0xffffu) | (vq[3].z << 16));
      *(uint4*)(VT + off128(d0 + 1, jr)) = make_uint4((vq[0].x >> 16) | (vq[0].z & 0xffff0000u), (vq[1].x >> 16) | (vq[1].z & 0xffff0000u), (vq[2].x >> 16) | (vq[2].z & 0xffff0000u), (vq[3].x >> 16) | (vq[3].z & 0xffff0000u));
      *(uint4*)(VT + off128(d0 + 2, jr)) = make_uint4((vq[0].y & 0xffffu) | (vq[0].w << 16), (vq[1].y & 0xffffu) | (vq[1].w << 16), (vq[2].y & 0xffffu) | (vq[2].w << 16), (vq[3].y & 0xffffu) | (vq[3].w << 16));
      *(uint4*)(VT + off128(d0 + 3, jr)) = make_uint4((vq[0].y >> 16) | (vq[0].w & 0xffff0000u), (vq[1].y >> 16) | (vq[1].w & 0xffff0000u), (vq[2].y >> 16) | (vq[2].w & 0xffff0000u), (vq[3].y >> 16) | (vq[3].w & 0xffff0000u));
    }
    __syncthreads();
    const int it = w & 1, eh = w >> 1;
    f32x16 pt0, pt1;
#pragma unroll
    for (int r = 0; r < 16; ++r) { pt0[r] = 0.f; pt1[r] = 0.f; }
#pragma unroll
    for (int kk = 0; kk < 8; ++kk) {
      const bf16x8 bq = *(const bf16x8*)(QP + off256(it * 32 + l31, 2 * kk + half));
      const bf16x8 a0 = *(const bf16x8*)(KP + off256(l31, 2 * kk + half));
      pt0 = MFMA32(a0, bq, pt0);
      if (it) {
        const bf16x8 a1 = *(const bf16x8*)(KP + off256(32 + l31, 2 * kk + half));
        pt1 = MFMA32(a1, bq, pt1);
      }
    }
    if (it == 0) {
#pragma unroll
      for (int r = 0; r < 16; ++r) if (crow(r, half) > l31) pt0[r] = 0.f;
    } else {
#pragma unroll
      for (int r = 0; r < 16; ++r) if (crow(r, half) > l31) pt1[r] = 0.f;
    }
    bf16x8 pf[2][2];
#pragma unroll
    for (int s = 0; s < 2; ++s) {
      uint4 u0 = make_uint4(pack2(pt0[8 * s], pt0[8 * s + 1]), pack2(pt0[8 * s + 2], pt0[8 * s + 3]), pack2(pt0[8 * s + 4], pt0[8 * s + 5]), pack2(pt0[8 * s + 6], pt0[8 * s + 7]));
      uint4 u1 = make_uint4(pack2(pt1[8 * s], pt1[8 * s + 1]), pack2(pt1[8 * s + 2], pt1[8 * s + 3]), pack2(pt1[8 * s + 4], pt1[8 * s + 5]), pack2(pt1[8 * s + 6], pt1[8 * s + 7]));
      pf[0][s] = __builtin_bit_cast(bf16x8, u0);
      pf[1][s] = __builtin_bit_cast(bf16x8, u1);
    }
    f32x16 acc[2];
#pragma unroll
    for (int i = 0; i < 2; ++i)
#pragma unroll
      for (int r = 0; r < 16; ++r) acc[i][r] = 0.f;
#pragma unroll
    for (int ee = 0; ee < 2; ++ee) {
      const int e = (eh * 2 + ee) * 32 + l31;
#pragma unroll
      for (int jt = 0; jt < 2; ++jt) {
        if (jt <= it) {
#pragma unroll
          for (int s = 0; s < 2; ++s) {
            const int cA = 4 * jt + 2 * s;
            const uint2 lo = *(const uint2*)(VT + off128(e, cA) + 8 * half);
            const uint2 hi = *(const uint2*)(VT + off128(e, cA + 1) + 8 * half);
            const bf16x8 av = __builtin_bit_cast(bf16x8, make_uint4(lo.x, lo.y, hi.x, hi.y));
            acc[ee] = MFMA32(av, pf[jt][s], acc[ee]);
          }
        }
      }
    }
    __syncthreads();
    {
#pragma unroll
      for (int j = 0; j < 8; ++j) {
        const int id = tid + 256 * j, e = id >> 4, cc = id & 15;
        *(u32x4*)(STs + off256(e, cc)) = stq[j];
      }
    }
    __syncthreads();
#pragma unroll
    for (int kk = 0; kk < 8; ++kk) {
      const bf16x8 bq = *(const bf16x8*)(QP + off256(it * 32 + l31, 2 * kk + half));
#pragma unroll
      for (int ee = 0; ee < 2; ++ee) {
        const bf16x8 as = *(const bf16x8*)(STs + off256((eh * 2 + ee) * 32 + l31, 2 * kk + half));
        acc[ee] = MFMA32(as, bq, acc[ee]);
      }
    }
    float ssq = 0.f;
#pragma unroll
    for (int ee = 0; ee < 2; ++ee)
#pragma unroll
      for (int r = 0; r < 16; ++r) ssq += acc[ee][r] * acc[ee][r];
    ssq += __shfl_xor(ssq, 32);
    if (half == 0) red[w * 32 + l31] = ssq;
    __syncthreads();
    const float rn = rsqrtf((red[w * 32 + l31] + red[(w ^ 2) * 32 + l31]) * (1.f / 128.f) + EPS);
    const int t = t0 + it * 32 + l31;
#pragma unroll
    for (int ee = 0; ee < 2; ++ee)
#pragma unroll
      for (int g = 0; g < 4; ++g) {
        const int e0 = (eh * 2 + ee) * 32 + 8 * g + 4 * half;
        const size_t o = (size_t)t * 1024 + h * 128 + e0;
        const uint2 gg = make_uint2(ggq[ee][g][0], ggq[ee][g][1]);
        const float4 og = *(const float4*)(p.hgrn_out_norm + e0);
        const float v0 = acc[ee][4 * g] * rn * og.x * bflo(gg.x), v1 = acc[ee][4 * g + 1] * rn * og.y * bfhi(gg.x);
        const float v2 = acc[ee][4 * g + 2] * rn * og.z * bflo(gg.y), v3 = acc[ee][4 * g + 3] * rn * og.w * bfhi(gg.y);
        *(uint2*)(OG + tiledA(t, h * 128 + e0, 1024)) = make_uint2(pack2(v0, v1), pack2(v2, v3));
      }
    __syncthreads();
  }
}

struct XcdSlot { int part0, pstride, rank, cnt; };
DI XcdSlot xcd_slot(const Params& p, unsigned myrank) {
  const unsigned* census = (const unsigned*)(p.ws + OFF_CENSUS);
  const unsigned myx = (unsigned)__builtin_amdgcn_s_getreg((3 << 11) | 20) & 0xFu;
  int nx = 0, ix = 0, cnt = 1;
#pragma unroll
  for (int j = 0; j < 16; ++j) {
    const unsigned c = __builtin_amdgcn_readfirstlane(census[j]);
    if (c) { if ((unsigned)j == myx) { ix = nx; cnt = (int)c; } ++nx; }
  }
  XcdSlot sl; sl.part0 = ix; sl.pstride = nx > 0 ? nx : 1; sl.rank = (int)myrank; sl.cnt = cnt;
  return sl;
}

DI void peer_s1(const Params& p, int layer, const XcdSlot sl) {
  const int tid = opaque_tid(), lane = tid & 63, w = tid >> 6;
  unsigned char* ws = p.ws;
  const int* EX = (const int*)(ws + OFF_EX);
  const unsigned char* U8 = ws + (layer ? OFF_UV1 : OFF_UV0);
  const u16* HB = (const u16*)(ws + OFF_HBT);
  float* ZP = (float*)(ws + OFF_ZP);
  const int c8 = lane & 7, rg = lane >> 3;
  const bool b2 = (lane & 4) != 0, b1 = (lane & 2) != 0, b0 = (lane & 1) != 0;
  const int first = sl.rank * 4 + w, stride = sl.cnt * 4;
  const int nT = (T_TOK - first + stride - 1) / stride;
  const int nparts = (8 - sl.part0 + sl.pstride - 1) / sl.pstride;
  const int total = nT * nparts;
  if (total <= 0) return;
#define Z1_ITEM(IT, X, T) do { int it_ = (IT) < total ? (IT) : total - 1; const int xi_ = it_ / nT; X = sl.part0 + xi_ * sl.pstride; T = first + (it_ - xi_ * nT) * stride; } while (0)
#define Z1_LOAD_EH(EV, H0, H1, X, T) do { _Pragma("unroll") for (int q = 0; q < 4; ++q) { \
      const int4 e4 = *(const int4*)(EX + (size_t)(T) * 128 + rg * 16 + 4 * q); EV[4 * q] = e4.x; EV[4 * q + 1] = e4.y; EV[4 * q + 2] = e4.z; EV[4 * q + 3] = e4.w; } \
      H0 = *(const uint4*)(HB + tiledA((T), (X) * 128 + c8 * 16, 1024)); H1 = *(const uint4*)(HB + tiledA((T), (X) * 128 + c8 * 16 + 8, 1024)); } while (0)
#define Z1_LOAD_ROWS(EV, X) do { const unsigned char* ub_ = U8 + (size_t)(X) * 16384 * 128 + c8 * 16; \
      _Pragma("unroll") for (int j = 0; j < 16; ++j) q8[j] = *(const uint4*)(ub_ + (size_t)EV[j] * 128); } while (0)
  int evA[16], evB[16]; uint4 hA0, hA1, hB0, hB1;
  uint4 q8[16];
  int xC, tC, xN, tN, x2, t2;
  Z1_ITEM(0, xC, tC);
  Z1_LOAD_EH(evA, hA0, hA1, xC, tC);
  Z1_LOAD_ROWS(evA, xC);
  Z1_ITEM(1, xN, tN);
  Z1_LOAD_EH(evB, hB0, hB1, xN, tN);
#define Z1_BODY(EVC, HC0, HC1, EVN, IT) do { \
    f32x2 hf[8]; \
    { const unsigned hw[8] = {HC0.x, HC0.y, HC0.z, HC0.w, HC1.x, HC1.y, HC1.z, HC1.w}; \
      _Pragma("unroll") for (int k = 0; k < 8; ++k) { hf[k][0] = bflo(hw[k]); hf[k][1] = bfhi(hw[k]); } } \
    float pz[16]; \
    _Pragma("unroll") for (int j = 0; j < 16; ++j) { \
      const unsigned wd[4] = {q8[j].x, q8[j].y, q8[j].z, q8[j].w}; \
      f32x2 a2 = {0.f, 0.f}; \
      _Pragma("unroll") for (int d = 0; d < 4; ++d) { \
        const f32x2 lo = __builtin_amdgcn_cvt_pk_f32_fp8((int)wd[d], false), hi = __builtin_amdgcn_cvt_pk_f32_fp8((int)wd[d], true); \
        a2 = __builtin_elementwise_fma(lo, hf[2 * d], a2); a2 = __builtin_elementwise_fma(hi, hf[2 * d + 1], a2); } \
      pz[j] = a2[0] + a2[1]; } \
      \
    float r1[8], r2[4], r3[2]; \
    _Pragma("unroll") for (int i = 0; i < 8; ++i) { const float send = b2 ? pz[i] : pz[8 + i], mine = b2 ? pz[8 + i] : pz[i]; r1[i] = mine + __shfl_xor(send, 4); } \
    _Pragma("unroll") for (int i = 0; i < 4; ++i) { const float send = b1 ? r1[i] : r1[4 + i], mine = b1 ? r1[4 + i] : r1[i]; r2[i] = mine + __shfl_xor(send, 2); } \
    _Pragma("unroll") for (int i = 0; i < 2; ++i) { const float send = b0 ? r2[i] : r2[2 + i], mine = b0 ? r2[2 + i] : r2[i]; r3[i] = mine + __shfl_xor(send, 1); } \
      \
    Z1_LOAD_ROWS(EVN, xN); \
    Z1_ITEM((IT) + 2, x2, t2); \
    Z1_LOAD_EH(EVC, HC0, HC1, x2, t2); \
      \
    *(float2*)(ZP + ((size_t)xC * T_TOK + tC) * 128 + rg * 16 + 2 * c8) = make_float2(r3[0], r3[1]); \
    xC = xN; tC = tN; xN = x2; tN = t2; } while (0)
  for (int it = 0; it < total; it += 2) {
    Z1_BODY(evA, hA0, hA1, evB, it);
    if (it + 1 < total) Z1_BODY(evB, hB0, hB1, evA, it + 1);
  }
#undef Z1_BODY
#undef Z1_ITEM
#undef Z1_LOAD_EH
#undef Z1_LOAD_ROWS
}

DI void peer_zmerge(const Params& p, int layer, const float* ss_in) {
  unsigned char* ws = p.ws;
  const int* EX = (const int*)(ws + OFF_EX);
  const float* GT = (const float*)(ws + OFF_GT);
  const float* ZP = (const float*)(ws + OFF_ZP);
  const float2* SC = (const float2*)(ws + (layer ? OFF_SC1 : OFF_SC0));
  float* ACT = (float*)(ws + OFF_ACT);
  for (int i4 = blockIdx.x * NTHREADS + opaque_tid(); i4 < T_TOK * 32; i4 += gridDim.x * NTHREADS) {
    const int idx = i4 * 4, t = idx >> 7;
    float4 z = make_float4(0.f, 0.f, 0.f, 0.f);
#pragma unroll
    for (int x = 0; x < 8; ++x) { const float4 v = *(const float4*)(ZP + (size_t)x * T_TOK * 128 + idx); z.x += v.x; z.y += v.y; z.z += v.z; z.w += v.w; }
    const int4 e4 = *(const int4*)(EX + idx);
    const float4 g4 = *(const float4*)(GT + idx);
    const float2 s0 = SC[e4.x], s1 = SC[e4.y], s2 = SC[e4.z], s3 = SC[e4.w];
    const float rs = rstd_from_partials(ss_in, t);
    *(float4*)(ACT + idx) = make_float4(gelu_tanh(z.x * rs * s0.x) * g4.x * s0.y, gelu_tanh(z.y * rs * s1.x) * g4.y * s1.y,
                                        gelu_tanh(z.z * rs * s2.x) * g4.z * s2.y, gelu_tanh(z.w * rs * s3.x) * g4.w * s3.y);
  }
}

template <bool FINAL>
DI void peer_s2(const Params& p, int layer, float* ss_out, const XcdSlot sl) {
  const int tid = opaque_tid(), lane = tid & 63, w = tid >> 6;
  unsigned char* ws = p.ws;
  const int* EX = (const int*)(ws + OFF_EX);
  const float* ACT = (const float*)(ws + OFF_ACT);
  const unsigned char* V8 = ws + (layer ? OFF_UV1 : OFF_UV0) + 16 * MiB;
  u16* HBT = (u16*)(ws + OFF_HBT);
  float* out = p.out;
  float* ssd = ss_out ? ss_out : (float*)(ws + OFF_DUMMY);
  const int c8 = lane & 7, rg = lane >> 3;
  const bool b5 = (lane & 32) != 0, b4 = (lane & 16) != 0, b3 = (lane & 8) != 0;
  const int first = sl.rank * 4 + w, stride = sl.cnt * 4;
  const int nT = (T_TOK - first + stride - 1) / stride;
  const int nparts = (8 - sl.part0 + sl.pstride - 1) / sl.pstride;
  const int total = nT * nparts;
  if (total <= 0) return;
#define S2_ITEM(IT, X, T) do { int it_ = (IT) < total ? (IT) : total - 1; const int xi_ = it_ / nT; X = sl.part0 + xi_ * sl.pstride; T = first + (it_ - xi_ * nT) * stride; } while (0)
#define S2_LOAD_EA(EV, AV, T) do { _Pragma("unroll") for (int q = 0; q < 4; ++q) { \
      const int4 e4 = *(const int4*)(EX + (size_t)(T) * 128 + rg * 16 + 4 * q); const float4 a4 = *(const float4*)(ACT + (size_t)(T) * 128 + rg * 16 + 4 * q); \
      EV[4 * q] = e4.x; EV[4 * q + 1] = e4.y; EV[4 * q + 2] = e4.z; EV[4 * q + 3] = e4.w; AV[4 * q] = a4.x; AV[4 * q + 1] = a4.y; AV[4 * q + 2] = a4.z; AV[4 * q + 3] = a4.w; } } while (0)
#define S2_LOAD_ROWS(EV, X, T, HOLD) do { const unsigned char* vb_ = V8 + (size_t)(X) * 16384 * 128 + c8 * 16; \
      _Pragma("unroll") for (int j = 0; j < 16; ++j) q8[j] = *(const uint4*)(vb_ + (size_t)EV[j] * 128); \
      HOLD = *(const unsigned*)(HBT + tiledA((T), (X) * 128 + c8 * 16 + 2 * rg, 1024)); } while (0)
  int evA[16], evB[16]; float avA[16], avB[16];
  uint4 q8[16];
  unsigned hold, holdN;
  int xC, tC, xN, tN, x2, t2;
  S2_ITEM(0, xC, tC);
  S2_LOAD_EA(evA, avA, tC);
  S2_LOAD_ROWS(evA, xC, tC, hold);
  S2_ITEM(1, xN, tN);
  S2_LOAD_EA(evB, avB, tN);
#define S2_BODY(EVC, AVC, EVN, AVN, IT) do { \
    float acc[16]; \
    _Pragma("unroll") for (int i = 0; i < 16; ++i) acc[i] = 0.f; \
    _Pragma("unroll") for (int j = 0; j < 16; ++j) { \
      const unsigned wd[4] = {q8[j].x, q8[j].y, q8[j].z, q8[j].w}; \
      const f32x2 a2 = {AVC[j], AVC[j]}; \
      _Pragma("unroll") for (int d = 0; d < 4; ++d) { \
        const f32x2 lo = __builtin_amdgcn_cvt_pk_f32_fp8((int)wd[d], false), hi = __builtin_amdgcn_cvt_pk_f32_fp8((int)wd[d], true); \
        f32x2 c0 = {acc[4 * d], acc[4 * d + 1]}, c1 = {acc[4 * d + 2], acc[4 * d + 3]}; \
        c0 = __builtin_elementwise_fma(lo, a2, c0); c1 = __builtin_elementwise_fma(hi, a2, c1); \
        acc[4 * d] = c0[0]; acc[4 * d + 1] = c0[1]; acc[4 * d + 2] = c1[0]; acc[4 * d + 3] = c1[1]; } } \
      \
    float r1[8], r2[4], r3[2]; \
    _Pragma("unroll") for (int i = 0; i < 8; ++i) { const float send = b5 ? acc[i] : acc[8 + i], mine = b5 ? acc[8 + i] : acc[i]; r1[i] = mine + __shfl_xor(send, 32); } \
    _Pragma("unroll") for (int i = 0; i < 4; ++i) { const float send = b4 ? r1[i] : r1[4 + i], mine = b4 ? r1[4 + i] : r1[i]; r2[i] = mine + __shfl_xor(send, 16); } \
    _Pragma("unroll") for (int i = 0; i < 2; ++i) { const float send = b3 ? r2[i] : r2[2 + i], mine = b3 ? r2[2 + i] : r2[i]; r3[i] = mine + __shfl_xor(send, 8); } \
    const float n0 = bflo(hold) + r3[0], n1 = bfhi(hold) + r3[1]; \
    float ssq = n0 * n0 + n1 * n1; \
    _Pragma("unroll") for (int o = 32; o >= 1; o >>= 1) ssq += __shfl_xor(ssq, o); \
      \
    S2_LOAD_ROWS(EVN, xN, tN, holdN); \
    S2_ITEM((IT) + 2, x2, t2); \
    S2_LOAD_EA(EVC, AVC, t2); \
      \
    if (FINAL) *(float2*)(out + (size_t)tC * 1024 + xC * 128 + c8 * 16 + 2 * rg) = make_float2(n0, n1); \
    else { *(unsigned*)(HBT + tiledA(tC, xC * 128 + c8 * 16 + 2 * rg, 1024)) = pack2(n0, n1); ssd[(size_t)tC * 8 + xC] = ssq; } \
    hold = holdN; xC = xN; tC = tN; xN = x2; tN = t2; } while (0)
  for (int it = 0; it < total; it += 2) {
    S2_BODY(evA, avA, evB, avB, it);
    if (it + 1 < total) S2_BODY(evB, avB, evA, avA, it + 1);
  }
#undef S2_BODY
#undef S2_ITEM
#undef S2_LOAD_EA
#undef S2_LOAD_ROWS
}

constexpr int VT_STRIDE = 392;
DI void attn_phase(const Params& p, unsigned char* lds) {
  const int tid = opaque_tid(), lane = tid & 63, w = tid >> 6, l31 = lane & 31, half = lane >> 5;
  unsigned char* ws = p.ws;
  const u16* Kb = (const u16*)(ws + OFF_K);
  const u16* Vb = (const u16*)(ws + OFF_V);
  const u16* Qb = (const u16*)(ws + OFF_Q);
  u16* OGA = (u16*)(ws + OFF_OGA);
  float* LG = (float*)(ws + OFF_LG);
  const float Mx = ((const float*)(ws + OFF_MISC))[0];
  const float scale = 0.08838834764831845f;
  for (int item = blockIdx.x; item < 1536; item += gridDim.x) {
    const int qb = item & 127, rest = item >> 7, kvh = rest & 1, gi = (rest >> 1) % 3, b = rest / 6;
    const int dl = (gi == 0) ? 1 : (gi == 1 ? 4 : 16);
    const int bpr = (SEQ / dl) / 64;
    const int rho = qb / bpr, tau0 = (qb % bpr) * 64;
#pragma unroll 4
    for (int j = 0; j < 12; ++j) {
      const int id = tid + 256 * j, row = id >> 4, c = id & 15;
      const int tk = tau0 - 128 + row;
      const int tokk = rho + dl * (tk < 0 ? 0 : tk);
      *(uint4*)(lds + off256(row, c)) = *(const uint4*)(Kb + ((size_t)(b * SEQ + tokk)) * 768 + gi * 256 + kvh * 128 + c * 8);
    }
    const int r = w & 1, qh = w >> 1;
    const int tauq = tau0 + qh * 32 + l31;
    const int tq = b * SEQ + rho + dl * tauq;
    bf16x8 qf[8];
    {
      const u16* qsrc = Qb + (size_t)tq * 1536 + ((gi * 2 + kvh) * 2 + r) * 128;
#pragma unroll
      for (int kk = 0; kk < 8; ++kk) qf[kk] = *(const bf16x8*)(qsrc + (2 * kk + half) * 8);
    }
    __syncthreads();
    float lsum = 0.f;
    bf16x8 pf[5][2];
#pragma unroll
    for (int jl = 0; jl < 5; ++jl) {
      f32x16 pt;
#pragma unroll
      for (int rr = 0; rr < 16; ++rr) pt[rr] = 0.f;
#pragma unroll
      for (int kk = 0; kk < 8; ++kk) {
        const bf16x8 ak = *(const bf16x8*)(lds + off256((qh + jl) * 32 + l31, 2 * kk + half));
        pt = MFMA32(ak, qf[kk], pt);
      }
#pragma unroll
      for (int rr = 0; rr < 16; ++rr) {
        const int tk = tau0 - 128 + (qh + jl) * 32 + crow(rr, half);
        const bool valid = (tk >= 0) && (tk <= tauq) && (tk >= tauq - 128);
        const float pv = valid ? __expf(pt[rr] * scale - Mx) : 0.f;
        lsum += pv;
        pt[rr] = pv;
      }
#pragma unroll
      for (int s = 0; s < 2; ++s) {
        const uint4 u0 = make_uint4(pack2(pt[8 * s], pt[8 * s + 1]), pack2(pt[8 * s + 2], pt[8 * s + 3]),
                                    pack2(pt[8 * s + 4], pt[8 * s + 5]), pack2(pt[8 * s + 6], pt[8 * s + 7]));
        pf[jl][s] = __builtin_bit_cast(bf16x8, u0);
      }
    }
    lsum += __shfl_xor(lsum, 32);
    __syncthreads();
#pragma unroll 4
    for (int j = 0; j < 12; ++j) {
      const int id = tid + 256 * j, row = id >> 4, c = id & 15;
      const int tk = tau0 - 128 + row;
      const int tokk = rho + dl * (tk < 0 ? 0 : tk);
      const uint4 vv = *(const uint4*)(Vb + ((size_t)(b * SEQ + tokk)) * 768 + gi * 256 + kvh * 128 + c * 8);
      unsigned char* dstc = lds + (size_t)(c * 8) * VT_STRIDE + row * 2;
      *(u16*)(dstc + 0 * VT_STRIDE) = (u16)(vv.x & 0xffff); *(u16*)(dstc + 1 * VT_STRIDE) = (u16)(vv.x >> 16);
      *(u16*)(dstc + 2 * VT_STRIDE) = (u16)(vv.y & 0xffff); *(u16*)(dstc + 3 * VT_STRIDE) = (u16)(vv.y >> 16);
      *(u16*)(dstc + 4 * VT_STRIDE) = (u16)(vv.z & 0xffff); *(u16*)(dstc + 5 * VT_STRIDE) = (u16)(vv.z >> 16);
      *(u16*)(dstc + 6 * VT_STRIDE) = (u16)(vv.w & 0xffff); *(u16*)(dstc + 7 * VT_STRIDE) = (u16)(vv.w >> 16);
    }
    __syncthreads();
    f32x16 acc[4];
#pragma unroll
    for (int i = 0; i < 4; ++i)
#pragma unroll
      for (int rr = 0; rr < 16; ++rr) acc[i][rr] = 0.f;
#pragma unroll
    for (int et = 0; et < 4; ++et) {
      const unsigned char* vrow = lds + (size_t)(et * 32 + l31) * VT_STRIDE;
#pragma unroll
      for (int jl = 0; jl < 5; ++jl)
#pragma unroll
        for (int s = 0; s < 2; ++s) {
          const int j0 = (qh + jl) * 32 + 16 * s + 4 * half;
          const uint2 lo = *(const uint2*)(vrow + j0 * 2);
          const uint2 hi = *(const uint2*)(vrow + (j0 + 8) * 2);
          const bf16x8 av = __builtin_bit_cast(bf16x8, make_uint4(lo.x, lo.y, hi.x, hi.y));
          acc[et] = MFMA32(av, pf[jl][s], acc[et]);
        }
    }
    const int hd = kvh * 2 + r;
    const int tglob = tq;
    u16* od = OGA + ((size_t)gi * T_TOK + tglob) * 512 + hd * 128;
#pragma unroll
    for (int et = 0; et < 4; ++et)
#pragma unroll
      for (int g = 0; g < 4; ++g)
        *(uint2*)(od + et * 32 + 8 * g + 4 * half) = make_uint2(pack2(acc[et][4 * g], acc[et][4 * g + 1]), pack2(acc[et][4 * g + 2], acc[et][4 * g + 3]));
    if (half == 0) LG[((size_t)gi * T_TOK + tglob) * 4 + hd] = lsum;
    __syncthreads();
  }
}

DI void attn_combine(const Params& p) {
  unsigned char* ws = p.ws;
  const u16* OGA = (const u16*)(ws + OFF_OGA);
  const float* LG = (const float*)(ws + OFF_LG);
  u16* AO = (u16*)(ws + OFF_AO);
  const int nchunk = T_TOK * 512 / 8;
  for (int i = blockIdx.x * NTHREADS + opaque_tid(); i < nchunk; i += gridDim.x * NTHREADS) {
    const int t = i >> 6, c = i & 63, hd = c >> 4;
    float num[8];
#pragma unroll
    for (int k = 0; k < 8; ++k) num[k] = 0.f;
    float den = 0.f;
#pragma unroll
    for (int gi = 0; gi < 3; ++gi) {
      const uint4 v = *(const uint4*)(OGA + ((size_t)gi * T_TOK + t) * 512 + c * 8);
      num[0] += bflo(v.x); num[1] += bfhi(v.x); num[2] += bflo(v.y); num[3] += bfhi(v.y);
      num[4] += bflo(v.z); num[5] += bfhi(v.z); num[6] += bflo(v.w); num[7] += bfhi(v.w);
      den += LG[((size_t)gi * T_TOK + t) * 4 + hd];
    }
    const float inv = 1.f / den;
    *(uint4*)(AO + tiledA(t, c * 8, 512)) = make_uint4(pack2(num[0] * inv, num[1] * inv), pack2(num[2] * inv, num[3] * inv),
                                                        pack2(num[4] * inv, num[5] * inv), pack2(num[6] * inv, num[7] * inv));
  }
}

#define XB_TMO      128
#define XB_XCNT(j)  (256  + 64 * (j))
#define XB_XSUB(j)  (1280 + 64 * (j))
#define XB_XGEN(j)  (2304 + 64 * (j))
#define XB_TOP      3328
#define XB_TOPGEN   3392
#define XCD_BAR_WORDS 3456
#define XB_SPIN_CAP (1u << 18)
#define LAS __attribute__((address_space(3)))

__device__ __forceinline__ unsigned xb_ld(unsigned* p)              { return __hip_atomic_load(p, __ATOMIC_RELAXED, __HIP_MEMORY_SCOPE_AGENT); }
__device__ __forceinline__ unsigned xb_add(unsigned* p, unsigned v) { return __hip_atomic_fetch_add(p, v, __ATOMIC_RELAXED, __HIP_MEMORY_SCOPE_AGENT); }
__device__ __forceinline__ unsigned xb_xcc_id() { return (unsigned)__builtin_amdgcn_s_getreg((3 << 11) | 20) & 0xFu; }
#define XB_SPIN(cond, bar) do { unsigned _sp = 0; while (cond) { __builtin_amdgcn_s_sleep(1); \
    if ((++_sp & 255u) == 0u) { if (xb_ld(&(bar)[XB_TMO])) break; if (_sp > XB_SPIN_CAP) { atomicAdd(&(bar)[XB_TMO], 1u); break; } } } } while (0)

struct XcdBarrier {
    unsigned* bar; unsigned x;
    volatile LAS unsigned* st;
};

__device__ __forceinline__ XcdBarrier xcd_barrier_post(unsigned* bar, volatile LAS unsigned* st) {
    XcdBarrier b; b.bar = bar; b.x = xb_xcc_id(); b.st = st;
    if (threadIdx.x == 0) (void)xb_add(&bar[XB_XCNT(b.x)], 1u);
    return b;
}
__device__ __forceinline__ void xcd_barrier_complete(unsigned* bar, unsigned x, unsigned& nloc, unsigned& nx) {
    const unsigned G = gridDim.x * gridDim.y * gridDim.z;
    unsigned sum, cnt, mine, sp = 0u;
    for (;;) {
        sum = 0u; cnt = 0u; mine = 0u;
#pragma unroll
        for (unsigned j = 0; j < 16; ++j) { const unsigned c = xb_ld(&bar[XB_XCNT(j)]); sum += c; cnt += (c > 0u) ? 1u : 0u; mine = (j == x) ? c : mine; }
        if (sum == G) break;
        __builtin_amdgcn_s_sleep(1);
        if ((++sp & 255u) == 0u) { if (xb_ld(&bar[XB_TMO])) break; if (sp > XB_SPIN_CAP) { atomicAdd(&bar[XB_TMO], 1u); break; } }
    }
    nloc = mine > 0u ? mine : 1u; nx = cnt > 0u ? cnt : 1u;
}

__device__ __forceinline__ void xcd_barrier(const XcdBarrier& b) {
    asm volatile("s_waitcnt vmcnt(0)" ::: "memory");
    __syncthreads();
    if (threadIdx.x == 0) {
        unsigned* bar = b.bar;
        __builtin_amdgcn_s_waitcnt(0);
        unsigned nloc = b.st[0], nx = b.st[1];
        if (nloc == 0u) { xcd_barrier_complete(bar, b.x, nloc, nx); b.st[0] = nloc; b.st[1] = nx; }
        const unsigned old = xb_add(&bar[XB_XSUB(b.x)], 1u);
        const unsigned gen = old / nloc;
        if (old + 1u == (gen + 1u) * nloc) {
            __builtin_amdgcn_fence(__ATOMIC_RELEASE, "agent");
            asm volatile("s_waitcnt vmcnt(0)" ::: "memory");
            const unsigned og = xb_add(&bar[XB_TOP], 1u);
            const unsigned tg = og / nx;
            if (og + 1u == (tg + 1u) * nx) xb_add(&bar[XB_TOPGEN], 1u);
            else XB_SPIN(xb_ld(&bar[XB_TOPGEN]) == tg, bar);
            __builtin_amdgcn_fence(__ATOMIC_ACQUIRE, "agent");
            xb_add(&bar[XB_XGEN(b.x)], 1u);
            asm volatile("s_waitcnt vmcnt(0)" ::: "memory");
        } else {
            XB_SPIN(xb_ld(&bar[XB_XGEN(b.x)]) == gen, bar);
            __builtin_amdgcn_fence(__ATOMIC_ACQUIRE, "agent");
            asm volatile("s_waitcnt vmcnt(0)" ::: "memory");
        }
    }
    __syncthreads();
}


constexpr int N_PHASES = 18;
template <int ph>
DI void run_phase(const Params& p, unsigned char* lds, unsigned myrank) {
  unsigned char* ws = p.ws;
  switch (ph) {
    case 0: p0_prep(p, lds); break;
    case 1: {
      EpiHgrnIn e{(const float*)(ws + OFF_RSTD0), (const float*)(ws + OFF_LB), (u16*)(ws + OFF_QG), (u16*)(ws + OFF_VG), (u16*)(ws + OFF_GG), (_Float16*)(ws + OFF_LOGF)};
      gemm_phase<EpiHgrnIn, 1>(p, (const u16*)(ws + OFF_HB), 1024, (const u16*)(ws + OFF_WIN), 1024, 128, 32, 16, e, lds);
    } break;
    case 2: gla_g1(p, lds); break;
    case 3: gla_g2(p); break;
    case 4: gla_g3(p, lds); break;
    case 5: {
      EpiResidual<false> e{p.x, (u16*)(ws + OFF_HBT), (float*)(ws + OFF_SS1)};
      gemm_phase(p, (const u16*)(ws + OFF_OG), 1024, (const u16*)(ws + OFF_WOUT), 1024, 128, 8, 16, e, lds);
    } break;
    case 6: {
      EpiTopk e{(const float*)(ws + OFF_SS1), (int*)(ws + OFF_EX), (float*)(ws + OFF_GT), lds + 32768 + (opaque_tid() >> 6) * 6144};
      gemm_phase<EpiTopk, 0, true>(p, (const u16*)(ws + OFF_HBT), 1024, (const u16*)(ws + OFF_WPQ0), 1024, 128, 16, 16, e, lds);
    } break;
    case 7: peer_s1(p, 0, xcd_slot(p, myrank)); break;
    case 8: peer_zmerge(p, 0, (const float*)(ws + OFF_SS1)); break;
    case 9: peer_s2<false>(p, 0, (float*)(ws + OFF_SS2), xcd_slot(p, myrank)); break;
    case 10: {
      EpiKVQ e{(const float*)(ws + OFF_SS2), p.k_norm, p.q_norm, (const float2*)(ws + OFF_ROPE), (u16*)(ws + OFF_K), (u16*)(ws + OFF_V), (u16*)(ws + OFF_Q)};
      gemm_phase<EpiKVQ, 2>(p, (const u16*)(ws + OFF_HBT), 1024, (const u16*)(ws + OFF_WKVQ), 1024, 128, 24, 16, e, lds);
    } break;
    case 11: attn_phase(p, lds); break;
    case 12: attn_combine(p); break;
    case 13: {
      EpiResidual<true> e{nullptr, (u16*)(ws + OFF_HBT), (float*)(ws + OFF_SS3)};
      gemm_phase(p, (const u16*)(ws + OFF_AO), 512, (const u16*)(ws + OFF_WO), 512, 128, 8, 8, e, lds);
    } break;
    case 14: {
      EpiTopk e{(const float*)(ws + OFF_SS3), (int*)(ws + OFF_EX), (float*)(ws + OFF_GT), lds + 32768 + (opaque_tid() >> 6) * 6144};
      gemm_phase<EpiTopk, 0, true>(p, (const u16*)(ws + OFF_HBT), 1024, (const u16*)(ws + OFF_WPQ1), 1024, 128, 16, 16, e, lds);
    } break;
    case 15: peer_s1(p, 1, xcd_slot(p, myrank)); break;
    case 16: peer_zmerge(p, 1, (const float*)(ws + OFF_SS3)); break;
    case 17: peer_s2<true>(p, 1, nullptr, xcd_slot(p, myrank)); break;
    default: break;
  }
}

#if MEGA
#ifndef PROBE_MASK
#define PROBE_MASK 0
#endif
__global__ void __launch_bounds__(NTHREADS, 2) yoco_mega(Params p) {
  __shared__ __attribute__((aligned(16))) unsigned char lds[LDS_BYTES];
  __shared__ uint4 xb_words;
  if (threadIdx.x == 0) {
    const unsigned myx = (unsigned)__builtin_amdgcn_s_getreg((3 << 11) | 20) & 0xFu;
    const unsigned rk = __hip_atomic_fetch_add((unsigned*)(p.ws + OFF_CENSUS) + myx, 1u, __ATOMIC_RELAXED, __HIP_MEMORY_SCOPE_AGENT);
    xb_words = make_uint4(0u, 0u, rk, 0u);
  }
  __syncthreads();
  (void)xcd_barrier_post((unsigned*)p.ws, (volatile LAS unsigned*)&xb_words);
#define GRID_BAR() do { XcdBarrier b_; b_.bar = (unsigned*)p.ws; b_.x = xb_xcc_id(); b_.st = (volatile LAS unsigned*)&xb_words; xcd_barrier(b_); } while (0)
#define MYRANK() (((volatile unsigned*)&xb_words)[2])
#define PHASE(n) do { run_phase<n>(p, lds, MYRANK()); GRID_BAR(); if (PROBE_MASK & (1 << n)) { run_phase<n>(p, lds, MYRANK()); GRID_BAR(); } } while (0)
  PHASE(0); PHASE(1); PHASE(2); PHASE(3); PHASE(4); PHASE(5); PHASE(6); PHASE(7); PHASE(8); PHASE(9);
  PHASE(10); PHASE(11); PHASE(12); PHASE(13); PHASE(14); PHASE(15); PHASE(16);
  run_phase<17>(p, lds, MYRANK());
}
#endif

extern "C" void kernel_launch(void* const* d_in, const int* in_sizes, int n_in, void* d_out, int out_size, void* d_ws, size_t ws_size,
                              hipStream_t stream) {
  if (n_in != 18 || ws_size < WS_NEED) {
    fprintf(stderr, "kernel_launch: unexpected inputs (n_in %d, ws %zu, need %zu)\n", n_in, ws_size, (size_t)WS_NEED);
    return;
  }
  Params p{};
  p.x = (const float*)d_in[0]; p.hgrn_norm = (const float*)d_in[1]; p.hgrn_w_in = (const float*)d_in[2]; p.hgrn_lb = (const float*)d_in[3];
  p.hgrn_out_norm = (const float*)d_in[4]; p.hgrn_w_out = (const float*)d_in[5]; p.kv_norm = (const float*)d_in[6]; p.w_kv = (const float*)d_in[7];
  p.k_norm = (const float*)d_in[8]; p.attn_norm = (const float*)d_in[9]; p.w_q = (const float*)d_in[10]; p.q_norm = (const float*)d_in[11];
  p.w_o = (const float*)d_in[12]; p.ffn_norm = (const float*)d_in[13]; p.peer_w_q = (const float*)d_in[14]; p.peer_sub_keys = (const float*)d_in[15];
  p.peer_u = (const float*)d_in[16]; p.peer_v = (const float*)d_in[17];
  p.out = (float*)d_out; p.ws = (unsigned char*)d_ws;
#if MEGA
  static int grid_blocks = 0;
  if (!grid_blocks) {
    int dev = 0, cus = 0, per_cu = 0;
    (void)hipGetDevice(&dev);
    (void)hipDeviceGetAttribute(&cus, hipDeviceAttributeMultiprocessorCount, dev);
    (void)hipOccupancyMaxActiveBlocksPerMultiprocessor(&per_cu, yoco_mega, NTHREADS, 0);
    if (per_cu > 2) per_cu = 2;
    if (per_cu < 1) per_cu = 1;
    grid_blocks = cus * per_cu;
  }
  if (hipMemsetAsync(d_ws, 0, 16384, stream) != hipSuccess) { fprintf(stderr, "kernel_launch: memset of barrier words failed\n"); return; }
  void* args[] = {&p};
  hipError_t e = hipLaunchCooperativeKernel((void*)yoco_mega, dim3(grid_blocks), dim3(NTHREADS), args, 0, stream);
  if (e != hipSuccess) fprintf(stderr, "cooperative launch failed: %s (grid %d)\n", hipGetErrorString(e), grid_blocks);
#endif
}
```

```cpp
#include <hip/hip_runtime.h>
#include <hip/hip_cooperative_groups.h>
#include <cstdio>
#include <cstdint>
namespace cg = cooperative_groups;

#ifndef MEGA
#define MEGA 1
#endif

#define DI __device__ __forceinline__
typedef unsigned short u16;
typedef __attribute__((ext_vector_type(8))) short bf16x8;
typedef __attribute__((ext_vector_type(16))) float f32x16;
typedef __attribute__((ext_vector_type(2))) float f32x2;
typedef __attribute__((ext_vector_type(2))) __bf16 bf16x2_t;
typedef __attribute__((ext_vector_type(4))) unsigned u32x4;
typedef __attribute__((ext_vector_type(2))) unsigned u32x2;

#define MFMA32(a, b, c) __builtin_amdgcn_mfma_f32_32x32x16_bf16((a), (b), (c), 0, 0, 0)

constexpr int T_TOK = 16384;
constexpr int DM = 1024;
constexpr int SEQ = 8192;
constexpr float EPS = 1e-6f;
constexpr int NTHREADS = 256;
constexpr int LDS_BYTES = 65536;

constexpr size_t MiB = 1u << 20;
constexpr size_t OFF_LB = 64 * 1024;
constexpr size_t OFF_MISC = 68 * 1024;
constexpr size_t OFF_RSTD0 = 128 * 1024;
constexpr size_t OFF_SS1 = 29 * MiB;
constexpr size_t OFF_RSTD2 = 256 * 1024;
constexpr size_t OFF_SS3 = 30 * MiB;
constexpr size_t OFF_LG = 1 * MiB;
constexpr size_t OFF_ROPE = 2 * MiB;
constexpr size_t OFF_ACH = 3 * MiB;
constexpr size_t OFF_WIN = 4 * MiB;
constexpr size_t OFF_WOUT = 12 * MiB;
constexpr size_t OFF_WPQ0 = 14 * MiB;
constexpr size_t OFF_WKVQ = 18 * MiB;
constexpr size_t OFF_WO = 24 * MiB;
constexpr size_t OFF_WPQ1 = 25 * MiB;
constexpr size_t OFF_UV0 = 32 * MiB;
constexpr size_t OFF_UV1 = 64 * MiB;
constexpr size_t OFF_SC0 = 31 * MiB;
constexpr size_t OFF_SC1 = 31 * MiB + 256 * 1024;
constexpr size_t OFF_HB = 160 * MiB;
constexpr size_t OFF_QG = 192 * MiB;
constexpr size_t OFF_KG = 224 * MiB;
constexpr size_t OFF_LOGF = 256 * MiB;
constexpr size_t OFF_VG = 320 * MiB;
constexpr size_t OFF_GG = 352 * MiB;
constexpr size_t OFF_UT = 384 * MiB;
constexpr size_t OFF_OG = 448 * MiB;
constexpr size_t WS_NEED = 480 * MiB;
constexpr size_t OFF_K = 208 * MiB;
constexpr size_t OFF_V = 232 * MiB;
constexpr size_t OFF_Q = 256 * MiB;
constexpr size_t OFF_OGA = 304 * MiB;
constexpr size_t OFF_AO = 352 * MiB;
constexpr size_t OFF_EX = 368 * MiB;
constexpr size_t OFF_GT = 376 * MiB;
constexpr size_t OFF_ACT = 384 * MiB;
constexpr size_t OFF_SS2 = 30 * MiB + 512 * 1024;
constexpr size_t OFF_HBT = OFF_HB;
constexpr size_t OFF_ZP = 392 * MiB;
constexpr size_t OFF_DUMMY = 512 * 1024;
constexpr size_t OFF_CENSUS = 15 * 1024;

struct Params {
  const float *x, *hgrn_norm, *hgrn_w_in, *hgrn_lb, *hgrn_out_norm, *hgrn_w_out, *kv_norm, *w_kv, *k_norm, *attn_norm, *w_q,
      *q_norm, *w_o, *ffn_norm, *peer_w_q, *peer_sub_keys, *peer_u, *peer_v;
  float* out;
  unsigned char* ws;
};

DI int opaque_tid() { int t = threadIdx.x; asm volatile("" : "+v"(t)); return t; }
DI int crow(int r, int h) { return (r & 3) + 8 * (r >> 2) + 4 * h; }
DI unsigned pack2(float a, float b) {
  f32x2 v = {a, b};
  return __builtin_bit_cast(unsigned, __builtin_convertvector(v, bf16x2_t));
}
DI u16 f2bf(float f) { return (u16)(pack2(f, 0.f) & 0xffffu); }
DI float bf2f(u16 h) { return __uint_as_float(((unsigned)h) << 16); }
DI float bflo(unsigned u) { return __uint_as_float(u << 16); }
DI float bfhi(unsigned u) { return __uint_as_float(u & 0xffff0000u); }
DI float sigmoidf_(float v) { return 1.f / (1.f + __expf(-v)); }
DI float siluf_(float v) { return v / (1.f + __expf(-v)); }
DI float gelu_tanh(float z) {
  const float y = 0.7978845608028654f * (z + 0.044715f * z * z * z);
  const float t = 1.f - 2.f / (1.f + __expf(2.f * y));
  return 0.5f * z * (1.f + t);
}
DI size_t tiledA(int t, int col, int K) {
  return (size_t)(t >> 5) * (32 * (size_t)K) + (size_t)((((col >> 6) * 4 + ((col >> 4) & 3)) * 64 + ((col >> 3) & 1) * 32 + (t & 31)) * 8 + (col & 7));
}
DI int off128(int row, int c) { return row * 128 + ((c ^ ((row >> 1) & 7)) << 4); }
DI int off256(int row, int c) { return row * 256 + ((c ^ (row & 15)) << 4); }
DI int key_of(float f) { int k = __float_as_int(f); k ^= (k >> 31) & 0x7fffffff; return k; }
DI float val_of(int k) { k ^= (k >> 31) & 0x7fffffff; return __int_as_float(k); }
DI float rstd_from_partials(const float* ss, int m) {
  const float4 a = *(const float4*)(ss + (size_t)m * 8), b = *(const float4*)(ss + (size_t)m * 8 + 4);
  const float t = ((a.x + a.y) + (a.z + a.w)) + ((b.x + b.y) + (b.z + b.w));
  return rsqrtf(t * (1.f / 1024.f) + EPS);
}

template <int N>
DI void bitonic_sort_desc(int (&a)[N]) {
#pragma unroll
  for (int k = 2; k <= N; k <<= 1)
#pragma unroll
    for (int j = k >> 1; j > 0; j >>= 1)
#pragma unroll
      for (int i = 0; i < N; ++i) {
        const int l = i ^ j;
        if (l > i) {
          const int hi = max(a[i], a[l]), lo = min(a[i], a[l]);
          if ((i & k) == 0) { a[i] = hi; a[l] = lo; } else { a[i] = lo; a[l] = hi; }
        }
      }
}
DI void merge_top16(int (&a)[16], const int (&b)[16]) {
#pragma unroll
  for (int i = 0; i < 16; ++i) a[i] = max(a[i], b[15 - i]);
#pragma unroll
  for (int j = 8; j > 0; j >>= 1)
#pragma unroll
    for (int i = 0; i < 16; ++i) {
      const int l = i ^ j;
      if (l > i) { const int hi = max(a[i], a[l]), lo = min(a[i], a[l]); a[i] = hi; a[l] = lo; }
    }
}
#define TOPK_INSERT(a, xk) do { int _x = (xk); _Pragma("unroll") for (int _j = 0; _j < 16; ++_j) { int _t = max(a[_j], _x); _x = min(a[_j], _x); a[_j] = _t; } } while (0)

constexpr int N_TR = 1024 + 256 + 384 + 384 + 128;
constexpr int N_CP = 1024;
constexpr int N_UV = 8192;
constexpr int N_X = 512;
constexpr int N_ROPE = 512;
constexpr int N_MISC = 64;
constexpr int N_P0 = N_TR + N_CP + N_X + N_ROPE + N_MISC;

DI void p0_transpose_tile(const float* src, int N, const float* gain, u16* dst, int ld, int rowoff, int kt, int ntile, float* tile) {
  const int tid = opaque_tid();
  const int k0 = kt * 64, n0 = ntile * 64;
#pragma unroll
  for (int i = 0; i < 4; ++i) {
    const int k = i * 16 + (tid >> 4), n = (tid & 15) * 4;
    float4 v = *(const float4*)(src + (size_t)(k0 + k) * N + n0 + n);
    if (gain) { const float gk = gain[k0 + k]; v.x *= gk; v.y *= gk; v.z *= gk; v.w *= gk; }
    tile[k * 65 + n] = v.x; tile[k * 65 + n + 1] = v.y; tile[k * 65 + n + 2] = v.z; tile[k * 65 + n + 3] = v.w;
  }
  __syncthreads();
  {
    const int n = tid >> 2, kq = (tid & 3) * 16;
    unsigned pk[8];
#pragma unroll
    for (int i = 0; i < 8; ++i) pk[i] = pack2(tile[(kq + 2 * i) * 65 + n], tile[(kq + 2 * i + 1) * 65 + n]);
    uint4* d = (uint4*)(dst + (size_t)(rowoff + n0 + n) * ld + k0 + kq);
    d[0] = make_uint4(pk[0], pk[1], pk[2], pk[3]);
    d[1] = make_uint4(pk[4], pk[5], pk[6], pk[7]);
  }
  __syncthreads();
}

DI void p0_prep(const Params& p, unsigned char* lds) {
  const int tid = opaque_tid(), lane = tid & 63, w = tid >> 6;
  unsigned char* ws = p.ws;
  for (int item = blockIdx.x; item < N_P0; item += gridDim.x) {
    int it = item;
    if (it < N_TR) {
      float* tile = (float*)lds;
      if (it < 1024) p0_transpose_tile(p.hgrn_w_in, 4096, p.hgrn_norm, (u16*)(ws + OFF_WIN), 1024, 0, it / 64, it % 64, tile);
      else if (it < 1280) { it -= 1024; p0_transpose_tile(p.hgrn_w_out, 1024, nullptr, (u16*)(ws + OFF_WOUT), 1024, 0, it / 16, it % 16, tile); }
      else if (it < 1664) { it -= 1280; p0_transpose_tile(p.w_kv, 1536, p.kv_norm, (u16*)(ws + OFF_WKVQ), 1024, 0, it / 24, it % 24, tile); }
      else if (it < 2048) { it -= 1664; p0_transpose_tile(p.w_q, 1536, p.attn_norm, (u16*)(ws + OFF_WKVQ), 1024, 1536, it / 24, it % 24, tile); }
      else { it -= 2048; p0_transpose_tile(p.w_o, 1024, nullptr, (u16*)(ws + OFF_WO), 512, 0, it / 16, it % 16, tile); }
      continue;
    }
    it -= N_TR;
    if (it < N_CP) {
      const int l = it >> 9, rem = it & 511, h = rem >> 6, wsel = (rem >> 5) & 1, nh = (rem >> 4) & 1;
      const int c0 = (rem & 15) * 64;
      float* Ws = (float*)lds;
      float* Ks = (float*)(lds + 64 * 65 * 4);
      const float* keys = p.peer_sub_keys + ((size_t)(l * 2 + wsel) * 128 + nh * 64) * 128;
      const float* Wp = p.peer_w_q + (size_t)l * 1024 * 2048 + (size_t)c0 * 2048 + h * 256 + wsel * 128;
      const int ci = w & 1, ni = w >> 1, r31 = lane & 31, kh = lane >> 5;
      f32x16 acc;
#pragma unroll
      for (int r = 0; r < 16; ++r) acc[r] = 0.f;
      for (int ps = 0; ps < 2; ++ps) {
#pragma unroll 4
        for (int i = 0; i < 16; ++i) {
          const int idx = tid + 256 * i, rr = idx >> 6, d = idx & 63;
          Ws[rr * 65 + d] = Wp[(size_t)rr * 2048 + ps * 64 + d] * p.ffn_norm[l * 1024 + c0 + rr];
          Ks[rr * 65 + d] = keys[rr * 128 + ps * 64 + d];
        }
        __syncthreads();
#pragma unroll 8
        for (int s2 = 0; s2 < 32; ++s2)
          acc = __builtin_amdgcn_mfma_f32_32x32x2f32(Ws[(ci * 32 + r31) * 65 + 2 * s2 + kh], Ks[(ni * 32 + r31) * 65 + 2 * s2 + kh], acc, 0, 0, 0);
        __syncthreads();
      }
      u16* dst = (u16*)(ws + (l ? OFF_WPQ1 : OFF_WPQ0)) + (size_t)(h * 256 + wsel * 128 + nh * 64 + ni * 32 + r31) * 1024 + c0 + ci * 32;
#pragma unroll
      for (int g = 0; g < 4; ++g) *(uint2*)(dst + 8 * g + 4 * kh) = make_uint2(pack2(acc[4 * g], acc[4 * g + 1]), pack2(acc[4 * g + 2], acc[4 * g + 3]));
      continue;
    }
    it -= N_CP;
    if (it < N_X) {
      float* xt = (float*)lds;
      const int t0 = it * 32;
      u16* dst = (u16*)(ws + OFF_HB) + (size_t)it * 32768;
      float ssr[8];
#pragma unroll
      for (int i = 0; i < 8; ++i) ssr[i] = 0.f;
      typedef float v4f __attribute__((ext_vector_type(4)));
      v4f xa[8], xb[8];
#define X_LOAD(R, CH) do { _Pragma("unroll") for (int i = 0; i < 8; ++i) R[i] = *(const v4f*)(p.x + (size_t)(t0 + w + 4 * i) * 1024 + (CH) * 256 + lane * 4); } while (0)
#define X_CHUNK(R, CH) do { \
        _Pragma("unroll") for (int i = 0; i < 8; ++i) { ssr[i] += R[i][0] * R[i][0] + R[i][1] * R[i][1] + R[i][2] * R[i][2] + R[i][3] * R[i][3]; *(v4f*)(xt + (w + 4 * i) * 260 + lane * 4) = R[i]; } \
        __syncthreads(); \
        _Pragma("unroll") for (int sl = 0; sl < 4; ++sl) {     \
          const int slot = w * 4 + sl, l31 = lane & 31, hf = lane >> 5; \
          const float4 v0 = *(const float4*)(xt + l31 * 260 + slot * 16 + hf * 8), v1 = *(const float4*)(xt + l31 * 260 + slot * 16 + hf * 8 + 4); \
          *(uint4*)(dst + (size_t)(((CH) * 16 + slot) * 64 + lane) * 8) = make_uint4(pack2(v0.x, v0.y), pack2(v0.z, v0.w), pack2(v1.x, v1.y), pack2(v1.z, v1.w)); } \
        __syncthreads(); } while (0)
      X_LOAD(xa, 0);
      X_LOAD(xb, 1);
      X_CHUNK(xa, 0);
      X_LOAD(xa, 2);
      X_CHUNK(xb, 1);
      X_LOAD(xb, 3);
      X_CHUNK(xa, 2);
      X_CHUNK(xb, 3);
#undef X_LOAD
#undef X_CHUNK
#pragma unroll
      for (int i = 0; i < 8; ++i) {
        float ss = ssr[i];
#pragma unroll
        for (int o = 32; o >= 1; o >>= 1) ss += __shfl_xor(ss, o);
        if (lane == 0) ((float*)(ws + OFF_RSTD0))[t0 + w + 4 * i] = rsqrtf(ss * (1.f / 1024.f) + EPS);
      }
      continue;
    }
    it -= N_X;
    if (it < N_ROPE) {
      const int idx = it * 256 + tid; const int pos = idx >> 4, i = idx & 15;
      const float inv = powf(500000.f, -(float)i * (1.f / 16.f));
      const float ang = (float)pos * inv;
      float s, c; sincosf(ang, &s, &c);
      ((float2*)(ws + OFF_ROPE))[idx] = make_float2(c, s);
      continue;
    }
    it -= N_ROPE;
    {
      const int idx = it * 256 + tid;
      if (idx < 1024) {
        const float l0 = p.hgrn_lb[idx], l1 = p.hgrn_lb[1024 + idx];
        ((float*)(ws + OFF_LB))[idx] = 1.f / (1.f + __expf(l1 - l0));
      }
      if (idx == 0) {
        float mq = 0.f, mk = 0.f;
        for (int i = 0; i < 128; ++i) { mq = fmaxf(mq, fabsf(p.q_norm[i])); mk = fmaxf(mk, fabsf(p.k_norm[i])); }
        ((float*)(ws + OFF_MISC))[0] = 11.313708499f * mq * mk;
      }
    }
  }
}

DI void peer_tables(const Params& p, int l, int ibeg, int iend) {
  const int tid = opaque_tid(), lane = tid & 63, w = tid >> 6;
  unsigned char* ws = p.ws;
  for (int i = ibeg; i < iend; ++i) {
    const int e = (int)(blockIdx.x * 4 + w) + (int)(gridDim.x * 4) * i;
    if (e >= 16384) break;
    const float* su = p.peer_u + ((size_t)l * 16384 + e) * 1024 + lane * 4;
    const float* sv = p.peer_v + ((size_t)l * 16384 + e) * 1024 + lane * 4;
    const float* g = p.ffn_norm + l * 1024 + lane * 4;
    float uu[16], vv[16];
#pragma unroll
    for (int k = 0; k < 4; ++k) {
      const float4 a = *(const float4*)(su + 256 * k); const float4 gg = *(const float4*)(g + 256 * k); const float4 bq = *(const float4*)(sv + 256 * k);
      uu[4 * k] = a.x * gg.x; uu[4 * k + 1] = a.y * gg.y; uu[4 * k + 2] = a.z * gg.z; uu[4 * k + 3] = a.w * gg.w;
      vv[4 * k] = bq.x; vv[4 * k + 1] = bq.y; vv[4 * k + 2] = bq.z; vv[4 * k + 3] = bq.w;
    }
    float mu = 0.f, mv = 0.f;
#pragma unroll
    for (int k = 0; k < 16; ++k) { mu = fmaxf(mu, fabsf(uu[k])); mv = fmaxf(mv, fabsf(vv[k])); }
#pragma unroll
    for (int o = 32; o >= 1; o >>= 1) { mu = fmaxf(mu, __shfl_xor(mu, o)); mv = fmaxf(mv, __shfl_xor(mv, o)); }
    const float scu = mu > 0.f ? mu * (1.f / 448.f) : 1.f, scv = mv > 0.f ? mv * (1.f / 448.f) : 1.f;
    const float iu = 1.f / scu, iv = 1.f / scv;
    unsigned char* base = ws + (l ? OFF_UV1 : OFF_UV0);
#pragma unroll
    for (int k = 0; k < 4; ++k) {
      int pk = 0;
      pk = __builtin_amdgcn_cvt_pk_fp8_f32(uu[4 * k] * iu, uu[4 * k + 1] * iu, pk, false);
      pk = __builtin_amdgcn_cvt_pk_fp8_f32(uu[4 * k + 2] * iu, uu[4 * k + 3] * iu, pk, true);
      int pv = 0;
      pv = __builtin_amdgcn_cvt_pk_fp8_f32(vv[4 * k] * iv, vv[4 * k + 1] * iv, pv, false);
      pv = __builtin_amdgcn_cvt_pk_fp8_f32(vv[4 * k + 2] * iv, vv[4 * k + 3] * iv, pv, true);
      const size_t off = ((size_t)(2 * k + (lane >> 5)) * 16384 + e) * 128 + (lane & 31) * 4;
      *(int*)(base + off) = pk;
      *(int*)(base + 16 * MiB + off) = pv;
    }
    if (lane == 0) ((float2*)(ws + (l ? OFF_SC1 : OFF_SC0)))[e] = make_float2(scu, scv);
  }
}

template <class Epi, int SIDE = 0, bool PAIR = false>
DI void gemm_phase(const Params& p, const u16* __restrict__ A, int lda, const u16* __restrict__ Bt, int ldb, int MT, int NT, int nk, Epi& epi, unsigned char* lds) {
  const int ntl = 0;
  const int nrw = (16384 + (int)gridDim.x * 4 - 1) / ((int)gridDim.x * 4);
  int seq = 0;
  const bool side_first = SIDE && (blockIdx.x * 2 >= gridDim.x);
  if (side_first) peer_tables(p, SIDE - 1, 0, nrw);
  const int Gx = (int)gridDim.x, bxx = (int)blockIdx.x;
  const bool two = Gx >= 2;
  const int Gl = two ? (Gx + 1) >> 1 : Gx;
  const bool upper = two && bxx >= Gl;
  const int NU = PAIR ? NT / 2 : NT;
  const int NH = two ? (upper ? NU - (NU >> 1) : (NU >> 1)) : NU;
  const int ubase = upper ? (NU >> 1) : 0;
  const int ustride = upper ? Gx - Gl : Gl;
  for (int u = upper ? bxx - Gl : bxx; u < MT * NH; u += ustride)
  for (int sub = 0; sub < (PAIR ? 2 : 1); ++sub) {
    const int mt = u / NH, unit = (u - mt * NH) + ubase;
    const int tid = opaque_tid(), lane = tid & 63, w = tid >> 6, l31 = lane & 31, half = lane >> 5;
    const int goffB0 = (tid >> 3) * ldb + (tid & 7) * 8;
    const int loffB0 = off128(tid >> 3, tid & 7);
    const int goffA = w * 32 * lda + lane * 8;
    const int lrowF = l31 * 128, lxF = (half ^ ((l31 >> 1) & 7)) << 4;
    const int nt = PAIR ? 2 * unit + sub : unit;
    const int m0 = mt * 128, n0 = nt * 128;
    f32x16 acc[4];
#pragma unroll
    for (int i = 0; i < 4; ++i)
#pragma unroll
      for (int r = 0; r < 16; ++r) acc[i][r] = 0.f;
    const u16* Ab = A + (size_t)m0 * lda + goffA;
    const u16* Bb = Bt + (size_t)n0 * ldb;
    bf16x8 aR[2][4];
    u32x4 bR[4][4];
#define LOAD_A(slot, ks) do { _Pragma("unroll") for (int kk = 0; kk < 4; ++kk) aR[slot][kk] = *(const bf16x8*)(Ab + ((ks) * 4 + kk) * 512); } while (0)
#define LOAD_B(slot, ks) do { _Pragma("unroll") for (int j = 0; j < 4; ++j) bR[slot][j] = *(const u32x4*)(Bb + goffB0 + j * 32 * ldb + (ks) * 64); } while (0)
#define STORE_B(slot, buf) do { _Pragma("unroll") for (int j = 0; j < 4; ++j) *(u32x4*)(lds + (buf) * 16384 + loffB0 + j * 4096) = bR[slot][j]; } while (0)
#define GEMM_STEP(ks, sa, sb) do { \
      const unsigned char* base_ = lds + ((sa) & 1) * 16384; \
      _Pragma("unroll") for (int kk = 0; kk < 4; ++kk) { \
        _Pragma("unroll") for (int n4 = 0; n4 < 4; ++n4) { \
          const bf16x8 wf = *(const bf16x8*)(base_ + n4 * 4096 + lrowF + (lxF ^ (kk << 5))); \
          acc[n4] = MFMA32(wf, aR[(sa) & 1][kk], acc[n4]); } } \
      if ((ks) + 2 < nk) LOAD_A((sa) & 1, (ks) + 2); \
      if ((ks) + 1 < nk) STORE_B(sb, (sb) & 1); \
      if ((ks) + 5 < nk) LOAD_B(sb, (ks) + 5); \
      __syncthreads(); } while (0)
    LOAD_B(0, 0); LOAD_B(1, 1); LOAD_B(2, 2); LOAD_B(3, 3);
    LOAD_A(0, 0); LOAD_A(1, 1);
    STORE_B(0, 0);
    LOAD_B(0, 4);
    __syncthreads();
#pragma unroll 1
    for (int ks = 0; ks < nk; ks += 4) {
      GEMM_STEP(ks, 0, 1);
      GEMM_STEP(ks + 1, 1, 2);
      GEMM_STEP(ks + 2, 2, 3);
      GEMM_STEP(ks + 3, 3, 0);
    }
    epi(acc, m0 + w * 32 + l31, n0, half);
    ++seq;
  }
  if (SIDE && !side_first) peer_tables(p, SIDE - 1, 0, nrw);
  (void)ntl; (void)seq;
#undef LOAD_A
#undef LOAD_B
#undef STORE_B
#undef GEMM_STEP
}

struct EpiNull {
  DI void operator()(f32x16 (&acc)[4], int m, int n0, int half) const {
#pragma unroll
    for (int i = 0; i < 4; ++i)
#pragma unroll
      for (int r = 0; r < 16; ++r) asm volatile("" :: "v"(acc[i][r]));
  }
};
struct EpiHgrnIn {
  const float* rstd; const float* lb; u16 *Qg, *Vg, *Gg; _Float16* LOGF;
  DI void operator()(f32x16 (&acc)[4], int m, int n0, int half) const {
    const float rs = rstd[m];
    const int sec = n0 >> 10, colb = n0 & 1023;
    const int pos = m & (SEQ - 1);
    const size_t tb0 = ((size_t)(((m >> 13) * 8 + (colb >> 7)) * 128 + (pos >> 6))) * 8192 + (size_t)(pos & 63) * 4;
#pragma unroll
    for (int n4 = 0; n4 < 4; ++n4)
#pragma unroll
      for (int g = 0; g < 4; ++g) {
        const int dl = n4 * 32 + 8 * g + 4 * half;
        const size_t to = tb0 + (size_t)(dl >> 2) * 256;
        float v[4];
#pragma unroll
        for (int j = 0; j < 4; ++j) v[j] = acc[n4][4 * g + j] * rs;
        if (sec == 0) {
          *(uint2*)(Qg + to) = make_uint2(pack2(siluf_(v[0]), siluf_(v[1])), pack2(siluf_(v[2]), siluf_(v[3])));
        } else if (sec == 1) {
          const float4 lbv = *(const float4*)(lb + colb + dl);
          const float lbs[4] = {lbv.x, lbv.y, lbv.z, lbv.w};
          typedef _Float16 h4 __attribute__((ext_vector_type(4)));
          h4 lf;
#pragma unroll
          for (int j = 0; j < 4; ++j) lf[j] = (_Float16)__logf(lbs[j] + (1.f - lbs[j]) * sigmoidf_(v[j]));
          *(h4*)(LOGF + to) = lf;
        } else if (sec == 2) {
          *(uint2*)(Vg + to) = make_uint2(pack2(v[0], v[1]), pack2(v[2], v[3]));
        } else {
          *(uint2*)(Gg + to) = make_uint2(pack2(siluf_(v[0]), siluf_(v[1])), pack2(siluf_(v[2]), siluf_(v[3])));
        }
      }
  }
};

template <bool RES_TILED>
struct EpiResidual {
  const float* res; u16* hbt; float* ss;
  DI void operator()(f32x16 (&acc)[4], int m, int n0, int half) const {
    float s = 0.f;
#pragma unroll
    for (int n4 = 0; n4 < 4; ++n4)
#pragma unroll
      for (int g = 0; g < 4; ++g) {
        const int col = n0 + n4 * 32 + 8 * g + 4 * half;
        u16* dst = hbt + tiledA(m, col, 1024);
        float r0, r1, r2, r3;
        if (RES_TILED) { const uint2 rv = *(const uint2*)dst; r0 = bflo(rv.x); r1 = bfhi(rv.x); r2 = bflo(rv.y); r3 = bfhi(rv.y); }
        else { const float4 rv = *(const float4*)(res + (size_t)m * 1024 + col); r0 = rv.x; r1 = rv.y; r2 = rv.z; r3 = rv.w; }
        const float v0 = acc[n4][4 * g] + r0, v1 = acc[n4][4 * g + 1] + r1, v2 = acc[n4][4 * g + 2] + r2, v3 = acc[n4][4 * g + 3] + r3;
        *(uint2*)dst = make_uint2(pack2(v0, v1), pack2(v2, v3));
        s += v0 * v0 + v1 * v1 + v2 * v2 + v3 * v3;
      }
    s += __shfl_xor(s, 32);
    if (half == 0) ss[(size_t)m * 8 + (n0 >> 7)] = s;
  }
};

struct EpiTopk {
  const float* ss; int* EX; float* GT; unsigned char* sel_lds;
  DI void operator()(f32x16 (&acc)[4], int m, int n0, int half) {
    const float rs = rstd_from_partials(ss, m);
    int k0[16], k1[16];
#pragma unroll
    for (int r = 0; r < 16; ++r) {
      k0[r] = (key_of(acc[0][r] * rs) & ~0x7f) | (crow(r, half));
      k1[r] = (key_of(acc[1][r] * rs) & ~0x7f) | (32 + crow(r, half));
    }
    bitonic_sort_desc<16>(k0);
    __builtin_amdgcn_sched_barrier(0);
    bitonic_sort_desc<16>(k1);
    merge_top16(k0, k1);
    __builtin_amdgcn_sched_barrier(0);
#pragma unroll
    for (int r = 0; r < 16; ++r) k1[r] = (key_of(acc[2][r] * rs) & ~0x7f) | (64 + crow(r, half));
    bitonic_sort_desc<16>(k1);
    merge_top16(k0, k1);
    __builtin_amdgcn_sched_barrier(0);
#pragma unroll
    for (int r = 0; r < 16; ++r) k1[r] = (key_of(acc[3][r] * rs) & ~0x7f) | (96 + crow(r, half));
    bitonic_sort_desc<16>(k1);
    merge_top16(k0, k1);
    __builtin_amdgcn_sched_barrier(0);
    int b[16];
#pragma unroll
    for (int j = 0; j < 16; ++j) b[j] = __shfl_xor(k0[j], 32);
    merge_top16(k0, b);
    volatile int* stash = (volatile int*)(sel_lds + 2048 + (threadIdx.x & 63) * 64);
    if (((n0 >> 7) & 1) == 0) {
#pragma unroll
      for (int j = 0; j < 16; ++j) stash[j] = k0[j];
      return;
    }
    int kprev[16];
#pragma unroll
    for (int j = 0; j < 16; ++j) kprev[j] = stash[j];
#define F1(i) val_of(kprev[i] & ~0x7f)
#define F2(j) val_of(k0[j] & ~0x7f)
    int a[16];
#pragma unroll
    for (int j = 0; j < 16; ++j) a[j] = (int)0x80000000;
#define SEL_PAIR(IA, JA, IB, JB) do { const int ka_ = (key_of(F1(IA) + F2(JA)) & ~0xff) | ((IA) * 16 + (JA)), kb_ = (key_of(F1(IB) + F2(JB)) & ~0xff) | ((IB) * 16 + (JB)); \
      const int kk_ = half ? kb_ : ka_; TOPK_INSERT(a, kk_); } while (0)
      SEL_PAIR(0, 0, 0, 1);
      SEL_PAIR(0, 2, 0, 3);
      SEL_PAIR(0, 4, 0, 5);
      SEL_PAIR(0, 6, 0, 7);
      SEL_PAIR(0, 8, 0, 9);
      SEL_PAIR(0, 10, 0, 11);
      SEL_PAIR(0, 12, 0, 13);
      SEL_PAIR(0, 14, 0, 15);
      SEL_PAIR(1, 0, 1, 1);
      SEL_PAIR(1, 2, 1, 3);
      SEL_PAIR(1, 4, 1, 5);
      SEL_PAIR(1, 6, 1, 7);
      SEL_PAIR(2, 0, 2, 1);
      SEL_PAIR(2, 2, 2, 3);
      SEL_PAIR(2, 4, 3, 0);
      SEL_PAIR(3, 1, 3, 2);
      SEL_PAIR(3, 3, 4, 0);
      SEL_PAIR(4, 1, 4, 2);
      SEL_PAIR(5, 0, 5, 1);
      SEL_PAIR(6, 0, 6, 1);
      SEL_PAIR(7, 0, 7, 1);
      SEL_PAIR(8, 0, 9, 0);
      SEL_PAIR(10, 0, 11, 0);
      SEL_PAIR(12, 0, 13, 0);
      SEL_PAIR(14, 0, 15, 0);
#undef SEL_PAIR
#undef F1
#undef F2
#pragma unroll
    for (int j = 0; j < 16; ++j) b[j] = __shfl_xor(a[j], 32);
    merge_top16(a, b);
    unsigned char* my = sel_lds + (m & 31) * 36;
    {
      unsigned pk4[4];
#pragma unroll
      for (int q = 0; q < 4; ++q) {
        const int s0 = half ? k0[4 * q] : kprev[4 * q], s1 = half ? k0[4 * q + 1] : kprev[4 * q + 1], s2 = half ? k0[4 * q + 2] : kprev[4 * q + 2], s3 = half ? k0[4 * q + 3] : kprev[4 * q + 3];
        pk4[q] = (unsigned)(s0 & 0x7f) | ((unsigned)(s1 & 0x7f) << 8) | ((unsigned)(s2 & 0x7f) << 16) | ((unsigned)(s3 & 0x7f) << 24);
      }
#pragma unroll
      for (int q = 0; q < 4; ++q) *(volatile unsigned*)(my + half * 16 + 4 * q) = pk4[q];
    }
    asm volatile("s_waitcnt lgkmcnt(0)" ::: "memory");
    float cs[16];
    float sum = 0.f;
    const float mx = val_of(a[0] & ~0xff);
#pragma unroll
    for (int k = 0; k < 16; ++k) { cs[k] = __expf(val_of(a[k] & ~0xff) - mx); sum += cs[k]; }
    const float inv = 1.f / sum;
    const int hcol = (n0 >> 8) * 16;
    if (half == 0) {
      int eo[16];
#pragma unroll
      for (int k = 0; k < 16; ++k) { const int ij = a[k] & 0xff; eo[k] = (int)((volatile unsigned char*)my)[ij >> 4] * 128 + (int)((volatile unsigned char*)my)[16 + (ij & 15)]; }
      int4* de = (int4*)(EX + (size_t)m * 128 + hcol);
#pragma unroll
      for (int q = 0; q < 4; ++q) de[q] = make_int4(eo[4 * q], eo[4 * q + 1], eo[4 * q + 2], eo[4 * q + 3]);
    } else {
      float4* dg = (float4*)(GT + (size_t)m * 128 + hcol);
#pragma unroll
      for (int q = 0; q < 4; ++q) dg[q] = make_float4(cs[4 * q] * inv, cs[4 * q + 1] * inv, cs[4 * q + 2] * inv, cs[4 * q + 3] * inv);
    }
  }
};

struct EpiKVQ {
  const float* ss; const float *k_norm, *q_norm; const float2* rope; u16 *Kb, *Vb, *Qb; unsigned char* stage;
  DI void operator()(f32x16 (&acc)[4], int m, int n0, int half) const {
    const float rs = rstd_from_partials(ss, m);
    u16* dst; const float* gain = nullptr; int ld;
    if (n0 < 768) { dst = Kb + (size_t)m * 768 + n0; gain = k_norm; ld = 768; }
    else if (n0 < 1536) { dst = Vb + (size_t)m * 768 + (n0 - 768); ld = 768; }
    else { dst = Qb + (size_t)m * 1536 + (n0 - 1536); gain = q_norm; ld = 1536; }
#pragma unroll
    for (int n4 = 0; n4 < 4; ++n4)
#pragma unroll
      for (int r = 0; r < 16; ++r) acc[n4][r] *= rs;
    if (gain) {
      float s = 0.f;
#pragma unroll
      for (int n4 = 0; n4 < 4; ++n4)
#pragma unroll
        for (int r = 0; r < 16; ++r) s += acc[n4][r] * acc[n4][r];
      s += __shfl_xor(s, 32);
      const float rn = rsqrtf(s * (1.f / 128.f) + EPS);
#pragma unroll
      for (int n4 = 0; n4 < 4; ++n4)
#pragma unroll
        for (int g = 0; g < 4; ++g) {
          const float4 gv = *(const float4*)(gain + n4 * 32 + 8 * g + 4 * half);
          acc[n4][4 * g] *= rn * gv.x; acc[n4][4 * g + 1] *= rn * gv.y; acc[n4][4 * g + 2] *= rn * gv.z; acc[n4][4 * g + 3] *= rn * gv.w;
        }
      const int pos = m & (SEQ - 1);
#pragma unroll
      for (int r = 0; r < 8; ++r) {
        const float2 cs = rope[pos * 16 + crow(r, half)];
        const float x1 = acc[0][r], x2 = acc[0][r + 8];
        acc[0][r] = x1 * cs.x - x2 * cs.y;
        acc[0][r + 8] = x2 * cs.x + x1 * cs.y;
      }
    }
    unsigned char* st = stage + (threadIdx.x >> 6) * 4352;
    const int l31 = threadIdx.x & 31;
    const int rr = (threadIdx.x & 63) >> 3, cc = threadIdx.x & 7;
    u16* dbase = dst - (size_t)l31 * ld;
#pragma unroll
    for (int ps = 0; ps < 2; ++ps) {
#pragma unroll
      for (int n2 = 0; n2 < 2; ++n2)
#pragma unroll
        for (int g = 0; g < 4; ++g)
          *(uint2*)(st + l31 * 136 + (n2 * 32 + 8 * g + 4 * half) * 2) = make_uint2(pack2(acc[ps * 2 + n2][4 * g], acc[ps * 2 + n2][4 * g + 1]), pack2(acc[ps * 2 + n2][4 * g + 2], acc[ps * 2 + n2][4 * g + 3]));
      asm volatile("s_waitcnt lgkmcnt(0)" ::: "memory");
#pragma unroll
      for (int i = 0; i < 4; ++i) {
        const uint2 a = *(const uint2*)(st + (rr + 8 * i) * 136 + cc * 16), b = *(const uint2*)(st + (rr + 8 * i) * 136 + cc * 16 + 8);
        *(uint4*)(dbase + (size_t)(rr + 8 * i) * ld + ps * 64 + cc * 8) = make_uint4(a.x, a.y, b.x, b.y);
      }
      asm volatile("s_waitcnt lgkmcnt(0)" ::: "memory");
    }
  }
};

DI void gla_g1(const Params& p, unsigned char* lds) {
  const int tid = opaque_tid(), lane = tid & 63, w = tid >> 6, l31 = lane & 31, half = lane >> 5;
  unsigned char* ws = p.ws;
  const _Float16* LOGF = (const _Float16*)(ws + OFF_LOGF);
  const u16* Vg = (const u16*)(ws + OFF_VG);
  u16* UT = (u16*)(ws + OFF_UT);
  float* ACH = (float*)(ws + OFF_ACH);
  unsigned char* KT = lds;
  unsigned char* VT = lds + 16384;
  float* tot = (float*)(lds + 32768);
  for (int item = blockIdx.x; item < 2048; item += gridDim.x) {
    const int bh = item >> 7, c = item & 127, b = bh >> 3, h = bh & 7;
    (void)b; (void)h;
    const int dg = tid & 31, jr = tid >> 5, d0 = dg * 4;
    const size_t tb = (size_t)item * 8192 + (size_t)(dg * 64 + jr * 8) * 4;
    float lfv[8][4], bl[8][4];
    {
      typedef _Float16 h8 __attribute__((ext_vector_type(8)));
      float run[4] = {0.f, 0.f, 0.f, 0.f};
#pragma unroll
      for (int q = 0; q < 4; ++q) {
        const h8 lf = *(const h8*)(LOGF + tb + 8 * q);
#pragma unroll
        for (int i = 0; i < 8; ++i) { const int jj = 2 * q + (i >> 2), dd = i & 3; lfv[jj][dd] = (float)lf[i]; run[dd] += lfv[jj][dd]; bl[jj][dd] = run[dd]; }
      }
      *(float4*)(tot + jr * 128 + d0) = make_float4(run[0], run[1], run[2], run[3]);
    }
    __syncthreads();
    float pre[4] = {0.f, 0.f, 0.f, 0.f}, blast[4] = {0.f, 0.f, 0.f, 0.f};
#pragma unroll
    for (int r = 0; r < 8; ++r) {
      const float4 tv = *(const float4*)(tot + r * 128 + d0);
      const float m_ = (r < jr) ? 1.f : 0.f;
      pre[0] += m_ * tv.x; pre[1] += m_ * tv.y; pre[2] += m_ * tv.z; pre[3] += m_ * tv.w;
      blast[0] += tv.x; blast[1] += tv.y; blast[2] += tv.z; blast[3] += tv.w;
    }
#pragma unroll
    for (int dd = 0; dd < 4; ++dd) {
      unsigned pk[4];
#pragma unroll
      for (int i = 0; i < 4; ++i)
        pk[i] = pack2((1.f - __expf(lfv[2 * i][dd])) * __expf(blast[dd] - (bl[2 * i][dd] + pre[dd])), (1.f - __expf(lfv[2 * i + 1][dd])) * __expf(blast[dd] - (bl[2 * i + 1][dd] + pre[dd])));
      *(uint4*)(KT + off128(d0 + dd, jr)) = make_uint4(pk[0], pk[1], pk[2], pk[3]);
    }
    {
      uint4 vq[4];
#pragma unroll
      for (int q = 0; q < 4; ++q) vq[q] = *(const uint4*)(Vg + tb + 8 * q);
      *(uint4*)(VT + off128(d0 + 0, jr)) = make_uint4((vq[0].x & 0xffffu) | (vq[0].z << 16), (vq[1].x & 0xffffu) | (vq[1].z << 16), (vq[2].x & 0xffffu) | (vq[2].z << 16), (vq[3].x & 0xffffu) | (vq[3].z << 16));
      *(uint4*)(VT + off128(d0 + 1, jr)) = make_uint4((vq[0].x >> 16) | (vq[0].z & 0xffff0000u), (vq[1].x >> 16) | (vq[1].z & 0xffff0000u), (vq[2].x >> 16) | (vq[2].z & 0xffff0000u), (vq[3].x >> 16) | (vq[3].z & 0xffff0000u));
      *(uint4*)(VT + off128(d0 + 2, jr)) = make_uint4((vq[0].y & 0xffffu) | (vq[0].w << 16), (vq[1].y & 0xffffu) | (vq[1].w << 16), (vq[2].y & 0xffffu) | (vq[2].w << 16), (vq[3].y & 0xffffu) | (vq[3].w << 16));
      *(uint4*)(VT + off128(d0 + 3, jr)) = make_uint4((vq[0].y >> 16) | (vq[0].w & 0xffff0000u), (vq[1].y >> 16) | (vq[1].w & 0xffff0000u), (vq[2].y >> 16) | (vq[2].w & 0xffff0000u), (vq[3].y >> 16) | (vq[3].w & 0xffff0000u));
    }
    if (jr == 0) *(float4*)(ACH + item * 128 + d0) = make_float4(__expf(blast[0]), __expf(blast[1]), __expf(blast[2]), __expf(blast[3]));
    __syncthreads();
    f32x16 acc[4];
#pragma unroll
    for (int i = 0; i < 4; ++i)
#pragma unroll
      for (int r = 0; r < 16; ++r) acc[i][r] = 0.f;
#pragma unroll
    for (int s = 0; s < 4; ++s) {
      const bf16x8 af = *(const bf16x8*)(KT + off128(w * 32 + l31, 2 * s + half));
#pragma unroll
      for (int et = 0; et < 4; ++et) {
        const bf16x8 bfr = *(const bf16x8*)(VT + off128(et * 32 + l31, 2 * s + half));
        acc[et] = MFMA32(af, bfr, acc[et]);
      }
    }
#pragma unroll
    for (int et = 0; et < 4; ++et)
#pragma unroll
      for (int g = 0; g < 4; ++g) {
        const int e = et * 32 + l31, d0 = w * 32 + 8 * g + 4 * half;
        *(uint2*)(UT + ((size_t)item * 128 + e) * 128 + d0) = make_uint2(pack2(acc[et][4 * g], acc[et][4 * g + 1]), pack2(acc[et][4 * g + 2], acc[et][4 * g + 3]));
      }
    __syncthreads();
  }
}

DI void gla_g2(const Params& p) {
  const int tid = opaque_tid();
  unsigned char* ws = p.ws;
  u16* UT = (u16*)(ws + OFF_UT);
  const float* ACH = (const float*)(ws + OFF_ACH);
  for (int u = blockIdx.x; u < 1024; u += gridDim.x) {
    const int bh = u >> 6, e = (u & 63) * 2 + (tid >> 7), d = tid & 127;
    float S = 0.f;
    size_t idx = ((size_t)bh * 128) * 16384 + (size_t)e * 128 + d;
    size_t aidx = (size_t)bh * 128 * 128 + d;
    for (int c = 0; c < 128; c += 32) {
      float uv[32], av[32];
#pragma unroll
      for (int k = 0; k < 32; ++k) { uv[k] = bf2f(UT[idx + (size_t)k * 16384]); av[k] = ACH[aidx + (size_t)k * 128]; }
#pragma unroll
      for (int k = 0; k < 32; ++k) { UT[idx + (size_t)k * 16384] = f2bf(S); S = av[k] * S + uv[k]; }
      idx += (size_t)32 * 16384; aidx += 32 * 128;
    }
  }
}

DI void gla_g3(const Params& p, unsigned char* lds) {
  const int tid = opaque_tid(), lane = tid & 63, w = tid >> 6, l31 = lane & 31, half = lane >> 5;
  unsigned char* ws = p.ws;
  const _Float16* LOGF = (const _Float16*)(ws + OFF_LOGF);
  const u16* Qg = (const u16*)(ws + OFF_QG);
  const u16* Vg = (const u16*)(ws + OFF_VG);
  const u16* Gg = (const u16*)(ws + OFF_GG);
  const u16* ST = (const u16*)(ws + OFF_UT);
  u16* OG = (u16*)(ws + OFF_OG);
  unsigned char* QP = lds;
  unsigned char* KP = lds + 16384;
  unsigned char* VT = lds + 32768;
  unsigned char* STs = lds + 16384;
  float* tot = (float*)(lds + 49152);
  float* red = (float*)(lds + 49152 + 4096);
  for (int item = blockIdx.x; item < 2048; item += gridDim.x) {
    const int bh = item >> 7, c = item & 127, b = bh >> 3, h = bh & 7;
    const int t0 = b * SEQ + c * 64;
    u32x4 stq[8];
    {
      const u16* src = ST + (size_t)item * 16384;
#pragma unroll
      for (int j = 0; j < 8; ++j) { const int id = tid + 256 * j; stq[j] = *(const u32x4*)(src + (size_t)(id >> 4) * 128 + (id & 15) * 8); }
    }
    u32x2 ggq[2][4];
    {
      const int tq_ = t0 + (w & 1) * 32 + l31;
#pragma unroll
      for (int ee = 0; ee < 2; ++ee)
#pragma unroll
        for (int g = 0; g < 4; ++g) ggq[ee][g] = *(const u32x2*)(Gg + (size_t)item * 8192 + (size_t)(((((w >> 1) * 2 + ee) * 32 + 8 * g + 4 * half) >> 2) * 64 + (w & 1) * 32 + l31) * 4);
    }
    const int dg = tid & 31, jr = tid >> 5, d0 = dg * 4;
    const size_t tb = (size_t)item * 8192 + (size_t)(dg * 64 + jr * 8) * 4;
    float lfv[8][4], bl[8][4];
    {
      typedef _Float16 h8 __attribute__((ext_vector_type(8)));
      float run[4] = {0.f, 0.f, 0.f, 0.f};
#pragma unroll
      for (int q = 0; q < 4; ++q) {
        const h8 lf = *(const h8*)(LOGF + tb + 8 * q);
#pragma unroll
        for (int i = 0; i < 8; ++i) { const int jj = 2 * q + (i >> 2), dd = i & 3; lfv[jj][dd] = (float)lf[i]; run[dd] += lfv[jj][dd]; bl[jj][dd] = run[dd]; }
      }
      *(float4*)(tot + jr * 128 + d0) = make_float4(run[0], run[1], run[2], run[3]);
    }
    __syncthreads();
    float pre[4] = {0.f, 0.f, 0.f, 0.f}, blast[4] = {0.f, 0.f, 0.f, 0.f};
#pragma unroll
    for (int r = 0; r < 8; ++r) {
      const float4 tv = *(const float4*)(tot + r * 128 + d0);
      const float m_ = (r < jr) ? 1.f : 0.f;
      pre[0] += m_ * tv.x; pre[1] += m_ * tv.y; pre[2] += m_ * tv.z; pre[3] += m_ * tv.w;
      blast[0] += tv.x; blast[1] += tv.y; blast[2] += tv.z; blast[3] += tv.w;
    }
    {
      uint4 qq[4];
#pragma unroll
      for (int q = 0; q < 4; ++q) qq[q] = *(const uint4*)(Qg + tb + 8 * q);
#pragma unroll
      for (int jj = 0; jj < 8; ++jj) {
        const int i = jr * 8 + jj;
        const unsigned q01 = (jj & 1) ? qq[jj >> 1].z : qq[jj >> 1].x, q23 = (jj & 1) ? qq[jj >> 1].w : qq[jj >> 1].y;
        const float qf[4] = {bflo(q01), bfhi(q01), bflo(q23), bfhi(q23)};
        float qv[4], kv[4];
#pragma unroll
        for (int dd = 0; dd < 4; ++dd) { const float bv = bl[jj][dd] + pre[dd]; qv[dd] = qf[dd] * __expf(bv); kv[dd] = (1.f - __expf(lfv[jj][dd])) * __expf(-bv); }
        const int o = i * 256 + (((d0 >> 3) ^ (i & 15)) << 4) + (d0 & 7) * 2;
        *(uint2*)(QP + o) = make_uint2(pack2(qv[0], qv[1]), pack2(qv[2], qv[3]));
        *(uint2*)(KP + o) = make_uint2(pack2(kv[0], kv[1]), pack2(kv[2], kv[3]));
      }
    }
    {
      uint4 vq[4];
#pragma unroll
      for (int q = 0; q < 4; ++q) vq[q] = *(const uint4*)(Vg + tb + 8 * q);
      *(uint4*)(VT + off128(d0 + 0, jr)) = make_uint4((vq[0].x & 0xffffu) | (vq[0].z << 16), (vq[1].x & 0xffffu) | (vq[1].z << 16), (vq[2].x & 0xffffu) | (vq[2].z << 16), (vq[3].x & 0xffffu) | (vq[3].z << 16));
      *(uint4*)(VT + off128(d0 + 1, jr)) = make_uint4((vq[0].x >> 16) | (vq[0].z & 0xffff0000u), (vq[1].x >> 16) | (vq[1].z & 0xffff0000u), (vq[2].x >> 16) | (vq[2].z & 0xffff0000u), (vq[3].x >> 16) | (vq[3].z & 0xffff0000u));
      *(uint4*)(VT + off128(d0 + 2, jr)) = make_uint4((vq[0].y & 0xffffu) | (vq[0].w << 16), (vq[1].y & 0xffffu) | (vq[1].w << 16), (vq[2].y & 0xffffu) | (vq[2].w << 16), (vq[3].y & 0xffffu) | (vq[3].w << 16));
      *(uint4*)(VT + off128(d0 + 3, jr)) = make_uint4((vq[0].y >> 16) | (vq[0].w & 0xffff0000u), (vq[1].y >> 16) | (vq[1].w & 0xffff0000u), (vq[2].y >> 16) | (vq[2].w & 0xffff0000u), (vq[3].y >> 16) | (vq[3].w & 0xffff0000u));
    }
    __syncthreads();
    const int it = w & 1, eh = w >> 1;
    f32x16 pt0, pt1;
#pragma unroll
    for (int r = 0; r < 16; ++r) { pt0[r] = 0.f; pt1[r] = 0.f; }
#pragma unroll
    for (int kk = 0; kk < 8; ++kk) {
      const bf16x8 bq = *(const bf16x8*)(QP + off256(it * 32 + l31, 2 * kk + half));
      const bf16x8 a0 = *(const bf16x8*)(KP + off256(l31, 2 * kk + half));
      pt0 = MFMA32(a0, bq, pt0);
      if (it) {
        const bf16x8 a1 = *(const bf16x8*)(KP + off256(32 + l31, 2 * kk + half));
        pt1 = MFMA32(a1, bq, pt1);
      }
    }
    if (it == 0) {
#pragma unroll
      for (int r = 0; r < 16; ++r) if (crow(r, half) > l31) pt0[r] = 0.f;
    } else {
#pragma unroll
      for (int r = 0; r < 16; ++r) if (crow(r, half) > l31) pt1[r] = 0.f;
    }
    bf16x8 pf[2][2];
#pragma unroll
    for (int s = 0; s < 2; ++s) {
      uint4 u0 = make_uint4(pack2(pt0[8 * s], pt0[8 * s + 1]), pack2(pt0[8 * s + 2], pt0[8 * s + 3]), pack2(pt0[8 * s + 4], pt0[8 * s + 5]), pack2(pt0[8 * s + 6], pt0[8 * s + 7]));
      uint4 u1 = make_uint4(pack2(pt1[8 * s], pt1[8 * s + 1]), pack2(pt1[8 * s + 2], pt1[8 * s + 3]), pack2(pt1[8 * s + 4], pt1[8 * s + 5]), pack2(pt1[8 * s + 6], pt1[8 * s + 7]));
      pf[0][s] = __builtin_bit_cast(bf16x8, u0);
      pf[1][s] = __builtin_bit_cast(bf16x8, u1);
    }
    f32x16 acc[2];
#pragma unroll
    for (int i = 0; i < 2; ++i)
#pragma unroll
      for (int r = 0; r < 16; ++r) acc[i][r] = 0.f;
#pragma unroll
    for (int ee = 0; ee < 2; ++ee) {
      const int e = (eh * 2 + ee) * 32 + l31;
#pragma unroll
      for (int jt = 0; jt < 2; ++jt) {
        if (jt <= it) {
#pragma unroll
          for (int s = 0; s < 2; ++s) {
            const int cA = 4 * jt + 2 * s;
            const uint2 lo = *(const uint2*)(VT + off128(e, cA) + 8 * half);
            const uint2 hi = *(const uint2*)(VT + off128(e, cA + 1) + 8 * half);
            const bf16x8 av = __builtin_bit_cast(bf16x8, make_uint4(lo.x, lo.y, hi.x, hi.y));
            acc[ee] = MFMA32(av, pf[jt][s], acc[ee]);
          }
        }
      }
    }
    __syncthreads();
    {
#pragma unroll
      for (int j = 0; j < 8; ++j) {
        const int id = tid + 256 * j, e = id >> 4, cc = id & 15;
        *(u32x4*)(STs + off256(e, cc)) = stq[j];
      }
    }
    __syncthreads();
#pragma unroll
    for (int kk = 0; kk < 8; ++kk) {
      const bf16x8 bq = *(const bf16x8*)(QP + off256(it * 32 + l31, 2 * kk + half));
#pragma unroll
      for (int ee = 0; ee < 2; ++ee) {
        const bf16x8 as = *(const bf16x8*)(STs + off256((eh * 2 + ee) * 32 + l31, 2 * kk + half));
        acc[ee] = MFMA32(as, bq, acc[ee]);
      }
    }
    float ssq = 0.f;
#pragma unroll
    for (int ee = 0; ee < 2; ++ee)
#pragma unroll
      for (int r = 0; r < 16; ++r) ssq += acc[ee][r] * acc[ee][r];
    ssq += __shfl_xor(ssq, 32);
    if (half == 0) red[w * 32 + l31] = ssq;
    __syncthreads();
    const float rn = rsqrtf((red[w * 32 + l31] + red[(w ^ 2) * 32 + l31]) * (1.f / 128.f) + EPS);
    const int t = t0 + it * 32 + l31;
#pragma unroll
    for (int ee = 0; ee < 2; ++ee)
#pragma unroll
      for (int g = 0; g < 4; ++g) {
        const int e0 = (eh * 2 + ee) * 32 + 8 * g + 4 * half;
        const size_t o = (size_t)t * 1024 + h * 128 + e0;
        const uint2 gg = make_uint2(ggq[ee][g][0], ggq[ee][g][1]);
        const float4 og = *(const float4*)(p.hgrn_out_norm + e0);
        const float v0 = acc[ee][4 * g] * rn * og.x * bflo(gg.x), v1 = acc[ee][4 * g + 1] * rn * og.y * bfhi(gg.x);
        const float v2 = acc[ee][4 * g + 2] * rn * og.z * bflo(gg.y), v3 = acc[ee][4 * g + 3] * rn * og.w * bfhi(gg.y);
        *(uint2*)(OG + tiledA(t, h * 128 + e0, 1024)) = make_uint2(pack2(v0, v1), pack2(v2, v3));
      }
    __syncthreads();
  }
}

struct XcdSlot { int part0, pstride, rank, cnt; };
DI XcdSlot xcd_slot(const Params& p, unsigned myrank) {
  const unsigned* census = (const unsigned*)(p.ws + OFF_CENSUS);
  const unsigned myx = (unsigned)__builtin_amdgcn_s_getreg((3 << 11) | 20) & 0xFu;
  int nx = 0, ix = 0, cnt = 1;
#pragma unroll
  for (int j = 0; j < 16; ++j) {
    const unsigned c = __builtin_amdgcn_readfirstlane(census[j]);
    if (c) { if ((unsigned)j == myx) { ix = nx; cnt = (int)c; } ++nx; }
  }
  XcdSlot sl; sl.part0 = ix; sl.pstride = nx > 0 ? nx : 1; sl.rank = (int)myrank; sl.cnt = cnt;
  return sl;
}

DI void peer_s1(const Params& p, int layer, const XcdSlot sl) {
  const int tid = opaque_tid(), lane = tid & 63, w = tid >> 6;
  unsigned char* ws = p.ws;
  const int* EX = (const int*)(ws + OFF_EX);
  const unsigned char* U8 = ws + (layer ? OFF_UV1 : OFF_UV0);
  const u16* HB = (const u16*)(ws + OFF_HBT);
  float* ZP = (float*)(ws + OFF_ZP);
  const int c8 = lane & 7, rg = lane >> 3;
  const bool b2 = (lane & 4) != 0, b1 = (lane & 2) != 0, b0 = (lane & 1) != 0;
  const int first = sl.rank * 4 + w, stride = sl.cnt * 4;
  const int nT = (T_TOK - first + stride - 1) / stride;
  const int nparts = (8 - sl.part0 + sl.pstride - 1) / sl.pstride;
  const int total = nT * nparts;
  if (total <= 0) return;
#define Z1_ITEM(IT, X, T) do { int it_ = (IT) < total ? (IT) : total - 1; const int xi_ = it_ / nT; X = sl.part0 + xi_ * sl.pstride; T = first + (it_ - xi_ * nT) * stride; } while (0)
#define Z1_LOAD_EH(EV, H0, H1, X, T) do { _Pragma("unroll") for (int q = 0; q < 4; ++q) { \
      const int4 e4 = *(const int4*)(EX + (size_t)(T) * 128 + rg * 16 + 4 * q); EV[4 * q] = e4.x; EV[4 * q + 1] = e4.y; EV[4 * q + 2] = e4.z; EV[4 * q + 3] = e4.w; } \
      H0 = *(const uint4*)(HB + tiledA((T), (X) * 128 + c8 * 16, 1024)); H1 = *(const uint4*)(HB + tiledA((T), (X) * 128 + c8 * 16 + 8, 1024)); } while (0)
#define Z1_LOAD_ROWS(EV, X) do { const unsigned char* ub_ = U8 + (size_t)(X) * 16384 * 128 + c8 * 16; \
      _Pragma("unroll") for (int j = 0; j < 16; ++j) q8[j] = *(const uint4*)(ub_ + (size_t)EV[j] * 128); } while (0)
  int evA[16], evB[16]; uint4 hA0, hA1, hB0, hB1;
  uint4 q8[16];
  int xC, tC, xN, tN, x2, t2;
  Z1_ITEM(0, xC, tC);
  Z1_LOAD_EH(evA, hA0, hA1, xC, tC);
  Z1_LOAD_ROWS(evA, xC);
  Z1_ITEM(1, xN, tN);
  Z1_LOAD_EH(evB, hB0, hB1, xN, tN);
#define Z1_BODY(EVC, HC0, HC1, EVN, IT) do { \
    f32x2 hf[8]; \
    { const unsigned hw[8] = {HC0.x, HC0.y, HC0.z, HC0.w, HC1.x, HC1.y, HC1.z, HC1.w}; \
      _Pragma("unroll") for (int k = 0; k < 8; ++k) { hf[k][0] = bflo(hw[k]); hf[k][1] = bfhi(hw[k]); } } \
    float pz[16]; \
    _Pragma("unroll") for (int j = 0; j < 16; ++j) { \
      const unsigned wd[4] = {q8[j].x, q8[j].y, q8[j].z, q8[j].w}; \
      f32x2 a2 = {0.f, 0.f}; \
      _Pragma("unroll") for (int d = 0; d < 4; ++d) { \
        const f32x2 lo = __builtin_amdgcn_cvt_pk_f32_fp8((int)wd[d], false), hi = __builtin_amdgcn_cvt_pk_f32_fp8((int)wd[d], true); \
        a2 = __builtin_elementwise_fma(lo, hf[2 * d], a2); a2 = __builtin_elementwise_fma(hi, hf[2 * d + 1], a2); } \
      pz[j] = a2[0] + a2[1]; } \
      \
    float r1[8], r2[4], r3[2]; \
    _Pragma("unroll") for (int i = 0; i < 8; ++i) { const float send = b2 ? pz[i] : pz[8 + i], mine = b2 ? pz[8 + i] : pz[i]; r1[i] = mine + __shfl_xor(send, 4); } \
    _Pragma("unroll") for (int i = 0; i < 4; ++i) { const float send = b1 ? r1[i] : r1[4 + i], mine = b1 ? r1[4 + i] : r1[i]; r2[i] = mine + __shfl_xor(send, 2); } \
    _Pragma("unroll") for (int i = 0; i < 2; ++i) { const float send = b0 ? r2[i] : r2[2 + i], mine = b0 ? r2[2 + i] : r2[i]; r3[i] = mine + __shfl_xor(send, 1); } \
      \
    Z1_LOAD_ROWS(EVN, xN); \
    Z1_ITEM((IT) + 2, x2, t2); \
    Z1_LOAD_EH(EVC, HC0, HC1, x2, t2); \
      \
    *(float2*)(ZP + ((size_t)xC * T_TOK + tC) * 128 + rg * 16 + 2 * c8) = make_float2(r3[0], r3[1]); \
    xC = xN; tC = tN; xN = x2; tN = t2; } while (0)
  for (int it = 0; it < total; it += 2) {
    Z1_BODY(evA, hA0, hA1, evB, it);
    if (it + 1 < total) Z1_BODY(evB, hB0, hB1, evA, it + 1);
  }
#undef Z1_BODY
#undef Z1_ITEM
#undef Z1_LOAD_EH
#undef Z1_LOAD_ROWS
}

DI void peer_zmerge(const Params& p, int layer, const float* ss_in) {
  unsigned char* ws = p.ws;
  const int* EX = (const int*)(ws + OFF_EX);
  const float* GT = (const float*)(ws + OFF_GT);
  const float* ZP = (const float*)(ws + OFF_ZP);
  const float2* SC = (const float2*)(ws + (layer ? OFF_SC1 : OFF_SC0));
  float* ACT = (float*)(ws + OFF_ACT);
  for (int i4 = blockIdx.x * NTHREADS + opaque_tid(); i4 < T_TOK * 32; i4 += gridDim.x * NTHREADS) {
    const int idx = i4 * 4, t = idx >> 7;
    float4 z = make_float4(0.f, 0.f, 0.f, 0.f);
#pragma unroll
    for (int x = 0; x < 8; ++x) { const float4 v = *(const float4*)(ZP + (size_t)x * T_TOK * 128 + idx); z.x += v.x; z.y += v.y; z.z += v.z; z.w += v.w; }
    const int4 e4 = *(const int4*)(EX + idx);
    const float4 g4 = *(const float4*)(GT + idx);
    const float2 s0 = SC[e4.x], s1 = SC[e4.y], s2 = SC[e4.z], s3 = SC[e4.w];
    const float rs = rstd_from_partials(ss_in, t);
    *(float4*)(ACT + idx) = make_float4(gelu_tanh(z.x * rs * s0.x) * g4.x * s0.y, gelu_tanh(z.y * rs * s1.x) * g4.y * s1.y,
                                        gelu_tanh(z.z * rs * s2.x) * g4.z * s2.y, gelu_tanh(z.w * rs * s3.x) * g4.w * s3.y);
  }
}

template <bool FINAL>
DI void peer_s2(const Params& p, int layer, float* ss_out, const XcdSlot sl) {
  const int tid = opaque_tid(), lane = tid & 63, w = tid >> 6;
  unsigned char* ws = p.ws;
  const int* EX = (const int*)(ws + OFF_EX);
  const float* ACT = (const float*)(ws + OFF_ACT);
  const unsigned char* V8 = ws + (layer ? OFF_UV1 : OFF_UV0) + 16 * MiB;
  u16* HBT = (u16*)(ws + OFF_HBT);
  float* out = p.out;
  float* ssd = ss_out ? ss_out : (float*)(ws + OFF_DUMMY);
  const int c8 = lane & 7, rg = lane >> 3;
  const bool b5 = (lane & 32) != 0, b4 = (lane & 16) != 0, b3 = (lane & 8) != 0;
  const int first = sl.rank * 4 + w, stride = sl.cnt * 4;
  const int nT = (T_TOK - first + stride - 1) / stride;
  const int nparts = (8 - sl.part0 + sl.pstride - 1) / sl.pstride;
  const int total = nT * nparts;
  if (total <= 0) return;
#define S2_ITEM(IT, X, T) do { int it_ = (IT) < total ? (IT) : total - 1; const int xi_ = it_ / nT; X = sl.part0 + xi_ * sl.pstride; T = first + (it_ - xi_ * nT) * stride; } while (0)
#define S2_LOAD_EA(EV, AV, T) do { _Pragma("unroll") for (int q = 0; q < 4; ++q) { \
      const int4 e4 = *(const int4*)(EX + (size_t)(T) * 128 + rg * 16 + 4 * q); const float4 a4 = *(const float4*)(ACT + (size_t)(T) * 128 + rg * 16 + 4 * q); \
      EV[4 * q] = e4.x; EV[4 * q + 1] = e4.y; EV[4 * q + 2] = e4.z; EV[4 * q + 3] = e4.w; AV[4 * q] = a4.x; AV[4 * q + 1] = a4.y; AV[4 * q + 2] = a4.z; AV[4 * q + 3] = a4.w; } } while (0)
#define S2_LOAD_ROWS(EV, X, T, HOLD) do { const unsigned char* vb_ = V8 + (size_t)(X) * 16384 * 128 + c8 * 16; \
      _Pragma("unroll") for (int j = 0; j < 16; ++j) q8[j] = *(const uint4*)(vb_ + (size_t)EV[j] * 128); \
      HOLD = *(const unsigned*)(HBT + tiledA((T), (X) * 128 + c8 * 16 + 2 * rg, 1024)); } while (0)
  int evA[16], evB[16]; float avA[16], avB[16];
  uint4 q8[16];
  unsigned hold, holdN;
  int xC, tC, xN, tN, x2, t2;
  S2_ITEM(0, xC, tC);
  S2_LOAD_EA(evA, avA, tC);
  S2_LOAD_ROWS(evA, xC, tC, hold);
  S2_ITEM(1, xN, tN);
  S2_LOAD_EA(evB, avB, tN);
#define S2_BODY(EVC, AVC, EVN, AVN, IT) do { \
    float acc[16]; \
    _Pragma("unroll") for (int i = 0; i < 16; ++i) acc[i] = 0.f; \
    _Pragma("unroll") for (int j = 0; j < 16; ++j) { \
      const unsigned wd[4] = {q8[j].x, q8[j].y, q8[j].z, q8[j].w}; \
      const f32x2 a2 = {AVC[j], AVC[j]}; \
      _Pragma("unroll") for (int d = 0; d < 4; ++d) { \
        const f32x2 lo = __builtin_amdgcn_cvt_pk_f32_fp8((int)wd[d], false), hi = __builtin_amdgcn_cvt_pk_f32_fp8((int)wd[d], true); \
        f32x2 c0 = {acc[4 * d], acc[4 * d + 1]}, c1 = {acc[4 * d + 2], acc[4 * d + 3]}; \
        c0 = __builtin_elementwise_fma(lo, a2, c0); c1 = __builtin_elementwise_fma(hi, a2, c1); \
        acc[4 * d] = c0[0]; acc[4 * d + 1] = c0[1]; acc[4 * d + 2] = c1[0]; acc[4 * d + 3] = c1[1]; } } \
      \
    float r1[8], r2[4], r3[2]; \
    _Pragma("unroll") for (int i = 0; i < 8; ++i) { const float send = b5 ? acc[i] : acc[8 + i], mine = b5 ? acc[8 + i] : acc[i]; r1[i] = mine + __shfl_xor(send, 32); } \
    _Pragma("unroll") for (int i = 0; i < 4; ++i) { const float send = b4 ? r1[i] : r1[4 + i], mine = b4 ? r1[4 + i] : r1[i]; r2[i] = mine + __shfl_xor(send, 16); } \
    _Pragma("unroll") for (int i = 0; i < 2; ++i) { const float send = b3 ? r2[i] : r2[2 + i], mine = b3 ? r2[2 + i] : r2[i]; r3[i] = mine + __shfl_xor(send, 8); } \
    const float n0 = bflo(hold) + r3[0], n1 = bfhi(hold) + r3[1]; \
    float ssq = n0 * n0 + n1 * n1; \
    _Pragma("unroll") for (int o = 32; o >= 1; o >>= 1) ssq += __shfl_xor(ssq, o); \
      \
    S2_LOAD_ROWS(EVN, xN, tN, holdN); \
    S2_ITEM((IT) + 2, x2, t2); \
    S2_LOAD_EA(EVC, AVC, t2); \
      \
    if (FINAL) *(float2*)(out + (size_t)tC * 1024 + xC * 128 + c8 * 16 + 2 * rg) = make_float2(n0, n1); \
    else { *(unsigned*)(HBT + tiledA(tC, xC * 128 + c8 * 16 + 2 * rg, 1024)) = pack2(n0, n1); ssd[(size_t)tC * 8 + xC] = ssq; } \
    hold = holdN; xC = xN; tC = tN; xN = x2; tN = t2; } while (0)
  for (int it = 0; it < total; it += 2) {
    S2_BODY(evA, avA, evB, avB, it);
    if (it + 1 < total) S2_BODY(evB, avB, evA, avA, it + 1);
  }
#undef S2_BODY
#undef S2_ITEM
#undef S2_LOAD_EA
#undef S2_LOAD_ROWS
}

constexpr int VT_STRIDE = 392;
DI void attn_phase(const Params& p, unsigned char* lds) {
  const int tid = opaque_tid(), lane = tid & 63, w = tid >> 6, l31 = lane & 31, half = lane >> 5;
  unsigned char* ws = p.ws;
  const u16* Kb = (const u16*)(ws + OFF_K);
  const u16* Vb = (const u16*)(ws + OFF_V);
  const u16* Qb = (const u16*)(ws + OFF_Q);
  u16* OGA = (u16*)(ws + OFF_OGA);
  float* LG = (float*)(ws + OFF_LG);
  const float Mx = ((const float*)(ws + OFF_MISC))[0];
  const float scale = 0.08838834764831845f;
  for (int item = blockIdx.x; item < 1536; item += gridDim.x) {
    const int qb = item & 127, rest = item >> 7, kvh = rest & 1, gi = (rest >> 1) % 3, b = rest / 6;
    const int dl = (gi == 0) ? 1 : (gi == 1 ? 4 : 16);
    const int bpr = (SEQ / dl) / 64;
    const int rho = qb / bpr, tau0 = (qb % bpr) * 64;
#pragma unroll 4
    for (int j = 0; j < 12; ++j) {
      const int id = tid + 256 * j, row = id >> 4, c = id & 15;
      const int tk = tau0 - 128 + row;
      const int tokk = rho + dl * (tk < 0 ? 0 : tk);
      *(uint4*)(lds + off256(row, c)) = *(const uint4*)(Kb + ((size_t)(b * SEQ + tokk)) * 768 + gi * 256 + kvh * 128 + c * 8);
    }
    const int r = w & 1, qh = w >> 1;
    const int tauq = tau0 + qh * 32 + l31;
    const int tq = b * SEQ + rho + dl * tauq;
    bf16x8 qf[8];
    {
      const u16* qsrc = Qb + (size_t)tq * 1536 + ((gi * 2 + kvh) * 2 + r) * 128;
#pragma unroll
      for (int kk = 0; kk < 8; ++kk) qf[kk] = *(const bf16x8*)(qsrc + (2 * kk + half) * 8);
    }
    __syncthreads();
    float lsum = 0.f;
    bf16x8 pf[5][2];
#pragma unroll
    for (int jl = 0; jl < 5; ++jl) {
      f32x16 pt;
#pragma unroll
      for (int rr = 0; rr < 16; ++rr) pt[rr] = 0.f;
#pragma unroll
      for (int kk = 0; kk < 8; ++kk) {
        const bf16x8 ak = *(const bf16x8*)(lds + off256((qh + jl) * 32 + l31, 2 * kk + half));
        pt = MFMA32(ak, qf[kk], pt);
      }
#pragma unroll
      for (int rr = 0; rr < 16; ++rr) {
        const int tk = tau0 - 128 + (qh + jl) * 32 + crow(rr, half);
        const bool valid = (tk >= 0) && (tk <= tauq) && (tk >= tauq - 128);
        const float pv = valid ? __expf(pt[rr] * scale - Mx) : 0.f;
        lsum += pv;
        pt[rr] = pv;
      }
#pragma unroll
      for (int s = 0; s < 2; ++s) {
        const uint4 u0 = make_uint4(pack2(pt[8 * s], pt[8 * s + 1]), pack2(pt[8 * s + 2], pt[8 * s + 3]),
                                    pack2(pt[8 * s + 4], pt[8 * s + 5]), pack2(pt[8 * s + 6], pt[8 * s + 7]));
        pf[jl][s] = __builtin_bit_cast(bf16x8, u0);
      }
    }
    lsum += __shfl_xor(lsum, 32);
    __syncthreads();
#pragma unroll 4
    for (int j = 0; j < 12; ++j) {
      const int id = tid + 256 * j, row = id >> 4, c = id & 15;
      const int tk = tau0 - 128 + row;
      const int tokk = rho + dl * (tk < 0 ? 0 : tk);
      const uint4 vv = *(const uint4*)(Vb + ((size_t)(b * SEQ + tokk)) * 768 + gi * 256 + kvh * 128 + c * 8);
      unsigned char* dstc = lds + (size_t)(c * 8) * VT_STRIDE + row * 2;
      *(u16*)(dstc + 0 * VT_STRIDE) = (u16)(vv.x & 0xffff); *(u16*)(dstc + 1 * VT_STRIDE) = (u16)(vv.x >> 16);
      *(u16*)(dstc + 2 * VT_STRIDE) = (u16)(vv.y & 0xffff); *(u16*)(dstc + 3 * VT_STRIDE) = (u16)(vv.y >> 16);
      *(u16*)(dstc + 4 * VT_STRIDE) = (u16)(vv.z & 0xffff); *(u16*)(dstc + 5 * VT_STRIDE) = (u16)(vv.z >> 16);
      *(u16*)(dstc + 6 * VT_STRIDE) = (u16)(vv.w & 0xffff); *(u16*)(dstc + 7 * VT_STRIDE) = (u16)(vv.w >> 16);
    }
    __syncthreads();
    f32x16 acc[4];
#pragma unroll
    for (int i = 0; i < 4; ++i)
#pragma unroll
      for (int rr = 0; rr < 16; ++rr) acc[i][rr] = 0.f;
#pragma unroll
    for (int et = 0; et < 4; ++et) {
      const unsigned char* vrow = lds + (size_t)(et * 32 + l31) * VT_STRIDE;
#pragma unroll
      for (int jl = 0; jl < 5; ++jl)
#pragma unroll
        for (int s = 0; s < 2; ++s) {
          const int j0 = (qh + jl) * 32 + 16 * s + 4 * half;
          const uint2 lo = *(const uint2*)(vrow + j0 * 2);
          const uint2 hi = *(const uint2*)(vrow + (j0 + 8) * 2);
          const bf16x8 av = __builtin_bit_cast(bf16x8, make_uint4(lo.x, lo.y, hi.x, hi.y));
          acc[et] = MFMA32(av, pf[jl][s], acc[et]);
        }
    }
    const int hd = kvh * 2 + r;
    const int tglob = tq;
    u16* od = OGA + ((size_t)gi * T_TOK + tglob) * 512 + hd * 128;
#pragma unroll
    for (int et = 0; et < 4; ++et)
#pragma unroll
      for (int g = 0; g < 4; ++g)
        *(uint2*)(od + et * 32 + 8 * g + 4 * half) = make_uint2(pack2(acc[et][4 * g], acc[et][4 * g + 1]), pack2(acc[et][4 * g + 2], acc[et][4 * g + 3]));
    if (half == 0) LG[((size_t)gi * T_TOK + tglob) * 4 + hd] = lsum;
    __syncthreads();
  }
}

DI void attn_combine(const Params& p) {
  unsigned char* ws = p.ws;
  const u16* OGA = (const u16*)(ws + OFF_OGA);
  const float* LG = (const float*)(ws + OFF_LG);
  u16* AO = (u16*)(ws + OFF_AO);
  const int nchunk = T_TOK * 512 / 8;
  for (int i = blockIdx.x * NTHREADS + opaque_tid(); i < nchunk; i += gridDim.x * NTHREADS) {
    const int t = i >> 6, c = i & 63, hd = c >> 4;
    float num[8];
#pragma unroll
    for (int k = 0; k < 8; ++k) num[k] = 0.f;
    float den = 0.f;
#pragma unroll
    for (int gi = 0; gi < 3; ++gi) {
      const uint4 v = *(const uint4*)(OGA + ((size_t)gi * T_TOK + t) * 512 + c * 8);
      num[0] += bflo(v.x); num[1] += bfhi(v.x); num[2] += bflo(v.y); num[3] += bfhi(v.y);
      num[4] += bflo(v.z); num[5] += bfhi(v.z); num[6] += bflo(v.w); num[7] += bfhi(v.w);
      den += LG[((size_t)gi * T_TOK + t) * 4 + hd];
    }
    const float inv = 1.f / den;
    *(uint4*)(AO + tiledA(t, c * 8, 512)) = make_uint4(pack2(num[0] * inv, num[1] * inv), pack2(num[2] * inv, num[3] * inv),
                                                        pack2(num[4] * inv, num[5] * inv), pack2(num[6] * inv, num[7] * inv));
  }
}

#define XB_TMO      128
#define XB_XCNT(j)  (256  + 64 * (j))
#define XB_XSUB(j)  (1280 + 64 * (j))
#define XB_XGEN(j)  (2304 + 64 * (j))
#define XB_TOP      3328
#define XB_TOPGEN   3392
#define XCD_BAR_WORDS 3456
#define XB_SPIN_CAP (1u << 18)
#define LAS __attribute__((address_space(3)))

__device__ __forceinline__ unsigned xb_ld(unsigned* p)              { return __hip_atomic_load(p, __ATOMIC_RELAXED, __HIP_MEMORY_SCOPE_AGENT); }
__device__ __forceinline__ unsigned xb_add(unsigned* p, unsigned v) { return __hip_atomic_fetch_add(p, v, __ATOMIC_RELAXED, __HIP_MEMORY_SCOPE_AGENT); }
__device__ __forceinline__ unsigned xb_xcc_id() { return (unsigned)__builtin_amdgcn_s_getreg((3 << 11) | 20) & 0xFu; }
#define XB_SPIN(cond, bar) do { unsigned _sp = 0; while (cond) { __builtin_amdgcn_s_sleep(1); \
    if ((++_sp & 255u) == 0u) { if (xb_ld(&(bar)[XB_TMO])) break; if (_sp > XB_SPIN_CAP) { atomicAdd(&(bar)[XB_TMO], 1u); break; } } } } while (0)

struct XcdBarrier {
    unsigned* bar; unsigned x;
    volatile LAS unsigned* st;
};

__device__ __forceinline__ XcdBarrier xcd_barrier_post(unsigned* bar, volatile LAS unsigned* st) {
    XcdBarrier b; b.bar = bar; b.x = xb_xcc_id(); b.st = st;
    if (threadIdx.x == 0) (void)xb_add(&bar[XB_XCNT(b.x)], 1u);
    return b;
}
__device__ __forceinline__ void xcd_barrier_complete(unsigned* bar, unsigned x, unsigned& nloc, unsigned& nx) {
    const unsigned G = gridDim.x * gridDim.y * gridDim.z;
    unsigned sum, cnt, mine, sp = 0u;
    for (;;) {
        sum = 0u; cnt = 0u; mine = 0u;
#pragma unroll
        for (unsigned j = 0; j < 16; ++j) { const unsigned c = xb_ld(&bar[XB_XCNT(j)]); sum += c; cnt += (c > 0u) ? 1u : 0u; mine = (j == x) ? c : mine; }
        if (sum == G) break;
        __builtin_amdgcn_s_sleep(1);
        if ((++sp & 255u) == 0u) { if (xb_ld(&bar[XB_TMO])) break; if (sp > XB_SPIN_CAP) { atomicAdd(&bar[XB_TMO], 1u); break; } }
    }
    nloc = mine > 0u ? mine : 1u; nx = cnt > 0u ? cnt : 1u;
}

__device__ __forceinline__ void xcd_barrier(const XcdBarrier& b) {
    asm volatile("s_waitcnt vmcnt(0)" ::: "memory");
    __syncthreads();
    if (threadIdx.x == 0) {
        unsigned* bar = b.bar;
        __builtin_amdgcn_s_waitcnt(0);
        unsigned nloc = b.st[0], nx = b.st[1];
        if (nloc == 0u) { xcd_barrier_complete(bar, b.x, nloc, nx); b.st[0] = nloc; b.st[1] = nx; }
        const unsigned old = xb_add(&bar[XB_XSUB(b.x)], 1u);
        const unsigned gen = old / nloc;
        if (old + 1u == (gen + 1u) * nloc) {
            __builtin_amdgcn_fence(__ATOMIC_RELEASE, "agent");
            asm volatile("s_waitcnt vmcnt(0)" ::: "memory");
            const unsigned og = xb_add(&bar[XB_TOP], 1u);
            const unsigned tg = og / nx;
            if (og + 1u == (tg + 1u) * nx) xb_add(&bar[XB_TOPGEN], 1u);
            else XB_SPIN(xb_ld(&bar[XB_TOPGEN]) == tg, bar);
            __builtin_amdgcn_fence(__ATOMIC_ACQUIRE, "agent");
            xb_add(&bar[XB_XGEN(b.x)], 1u);
            asm volatile("s_waitcnt vmcnt(0)" ::: "memory");
        } else {
            XB_SPIN(xb_ld(&bar[XB_XGEN(b.x)]) == gen, bar);
            __builtin_amdgcn_fence(__ATOMIC_ACQUIRE, "agent");
            asm volatile("s_waitcnt vmcnt(0)" ::: "memory");
        }
    }
    __syncthreads();
}


constexpr int N_PHASES = 18;
template <int ph>
DI void run_phase(const Params& p, unsigned char* lds, unsigned myrank) {
  unsigned char* ws = p.ws;
  switch (ph) {
    case 0: p0_prep(p, lds); break;
    case 1: {
      EpiHgrnIn e{(const float*)(ws + OFF_RSTD0), (const float*)(ws + OFF_LB), (u16*)(ws + OFF_QG), (u16*)(ws + OFF_VG), (u16*)(ws + OFF_GG), (_Float16*)(ws + OFF_LOGF)};
      gemm_phase<EpiHgrnIn, 1>(p, (const u16*)(ws + OFF_HB), 1024, (const u16*)(ws + OFF_WIN), 1024, 128, 32, 16, e, lds);
    } break;
    case 2: gla_g1(p, lds); break;
    case 3: gla_g2(p); break;
    case 4: gla_g3(p, lds); break;
    case 5: {
      EpiResidual<false> e{p.x, (u16*)(ws + OFF_HBT), (float*)(ws + OFF_SS1)};
      gemm_phase(p, (const u16*)(ws + OFF_OG), 1024, (const u16*)(ws + OFF_WOUT), 1024, 128, 8, 16, e, lds);
    } break;
    case 6: {
      EpiTopk e{(const float*)(ws + OFF_SS1), (int*)(ws + OFF_EX), (float*)(ws + OFF_GT), lds + 32768 + (opaque_tid() >> 6) * 6144};
      gemm_phase<EpiTopk, 0, true>(p, (const u16*)(ws + OFF_HBT), 1024, (const u16*)(ws + OFF_WPQ0), 1024, 128, 16, 16, e, lds);
    } break;
    case 7: peer_s1(p, 0, xcd_slot(p, myrank)); break;
    case 8: peer_zmerge(p, 0, (const float*)(ws + OFF_SS1)); break;
    case 9: peer_s2<false>(p, 0, (float*)(ws + OFF_SS2), xcd_slot(p, myrank)); break;
    case 10: {
      EpiKVQ e{(const float*)(ws + OFF_SS2), p.k_norm, p.q_norm, (const float2*)(ws + OFF_ROPE), (u16*)(ws + OFF_K), (u16*)(ws + OFF_V), (u16*)(ws + OFF_Q), lds + 32768};
      gemm_phase<EpiKVQ, 2>(p, (const u16*)(ws + OFF_HBT), 1024, (const u16*)(ws + OFF_WKVQ), 1024, 128, 24, 16, e, lds);
    } break;
    case 11: attn_phase(p, lds); break;
    case 12: attn_combine(p); break;
    case 13: {
      EpiResidual<true> e{nullptr, (u16*)(ws + OFF_HBT), (float*)(ws + OFF_SS3)};
      gemm_phase(p, (const u16*)(ws + OFF_AO), 512, (const u16*)(ws + OFF_WO), 512, 128, 8, 8, e, lds);
    } break;
    case 14: {
      EpiTopk e{(const float*)(ws + OFF_SS3), (int*)(ws + OFF_EX), (float*)(ws + OFF_GT), lds + 32768 + (opaque_tid() >> 6) * 6144};
      gemm_phase<EpiTopk, 0, true>(p, (const u16*)(ws + OFF_HBT), 1024, (const u16*)(ws + OFF_WPQ1), 1024, 128, 16, 16, e, lds);
    } break;
    case 15: peer_s1(p, 1, xcd_slot(p, myrank)); break;
    case 16: peer_zmerge(p, 1, (const float*)(ws + OFF_SS3)); break;
    case 17: peer_s2<true>(p, 1, nullptr, xcd_slot(p, myrank)); break;
    default: break;
  }
}

#if MEGA
#ifndef PROBE_MASK
#define PROBE_MASK 0
#endif
__global__ void __launch_bounds__(NTHREADS, 2) yoco_mega(Params p) {
  __shared__ __attribute__((aligned(16))) unsigned char lds[LDS_BYTES];
  __shared__ uint4 xb_words;
  if (threadIdx.x == 0) {
    const unsigned myx = (unsigned)__builtin_amdgcn_s_getreg((3 << 11) | 20) & 0xFu;
    const unsigned rk = __hip_atomic_fetch_add((unsigned*)(p.ws + OFF_CENSUS) + myx, 1u, __ATOMIC_RELAXED, __HIP_MEMORY_SCOPE_AGENT);
    xb_words = make_uint4(0u, 0u, rk, 0u);
  }
  __syncthreads();
  (void)xcd_barrier_post((unsigned*)p.ws, (volatile LAS unsigned*)&xb_words);
#define GRID_BAR() do { XcdBarrier b_; b_.bar = (unsigned*)p.ws; b_.x = xb_xcc_id(); b_.st = (volatile LAS unsigned*)&xb_words; xcd_barrier(b_); } while (0)
#define MYRANK() (((volatile unsigned*)&xb_words)[2])
#define PHASE(n) do { run_phase<n>(p, lds, MYRANK()); GRID_BAR(); if (PROBE_MASK & (1 << n)) { run_phase<n>(p, lds, MYRANK()); GRID_BAR(); } } while (0)
  PHASE(0); PHASE(1); PHASE(2); PHASE(3); PHASE(4); PHASE(5); PHASE(6); PHASE(7); PHASE(8); PHASE(9);
  PHASE(10); PHASE(11); PHASE(12); PHASE(13); PHASE(14); PHASE(15); PHASE(16);
  run_phase<17>(p, lds, MYRANK());
}
#endif

extern "C" void kernel_launch(void* const* d_in, const int* in_sizes, int n_in, void* d_out, int out_size, void* d_ws, size_t ws_size,
                              hipStream_t stream) {
  if (n_in != 18 || ws_size < WS_NEED) {
    fprintf(stderr, "kernel_launch: unexpected inputs (n_in %d, ws %zu, need %zu)\n", n_in, ws_size, (size_t)WS_NEED);
    return;
  }
  Params p{};
  p.x = (const float*)d_in[0]; p.hgrn_norm = (const float*)d_in[1]; p.hgrn_w_in = (const float*)d_in[2]; p.hgrn_lb = (const float*)d_in[3];
  p.hgrn_out_norm = (const float*)d_in[4]; p.hgrn_w_out = (const float*)d_in[5]; p.kv_norm = (const float*)d_in[6]; p.w_kv = (const float*)d_in[7];
  p.k_norm = (const float*)d_in[8]; p.attn_norm = (const float*)d_in[9]; p.w_q = (const float*)d_in[10]; p.q_norm = (const float*)d_in[11];
  p.w_o = (const float*)d_in[12]; p.ffn_norm = (const float*)d_in[13]; p.peer_w_q = (const float*)d_in[14]; p.peer_sub_keys = (const float*)d_in[15];
  p.peer_u = (const float*)d_in[16]; p.peer_v = (const float*)d_in[17];
  p.out = (float*)d_out; p.ws = (unsigned char*)d_ws;
#if MEGA
  static int grid_blocks = 0;
  if (!grid_blocks) {
    int dev = 0, cus = 0, per_cu = 0;
    (void)hipGetDevice(&dev);
    (void)hipDeviceGetAttribute(&cus, hipDeviceAttributeMultiprocessorCount, dev);
    (void)hipOccupancyMaxActiveBlocksPerMultiprocessor(&per_cu, yoco_mega, NTHREADS, 0);
    if (per_cu > 2) per_cu = 2;
    if (per_cu < 1) per_cu = 1;
    grid_blocks = cus * per_cu;
  }
  if (hipMemsetAsync(d_ws, 0, 16384, stream) != hipSuccess) { fprintf(stderr, "kernel_launch: memset of barrier words failed\n"); return; }
  void* args[] = {&p};
  hipError_t e = hipLaunchCooperativeKernel((void*)yoco_mega, dim3(grid_blocks), dim3(NTHREADS), args, 0, stream);
  if (e != hipSuccess) fprintf(stderr, "cooperative launch failed: %s (grid %d)\n", hipGetErrorString(e), grid_blocks);
#endif
}
```

```cpp
#include <hip/hip_runtime.h>
#include <hip/hip_cooperative_groups.h>
#include <cstdio>
#include <cstdint>
namespace cg = cooperative_groups;

#ifndef MEGA
#define MEGA 1
#endif

#define DI __device__ __forceinline__
typedef unsigned short u16;
typedef __attribute__((ext_vector_type(8))) short bf16x8;
typedef __attribute__((ext_vector_type(16))) float f32x16;
typedef __attribute__((ext_vector_type(2))) float f32x2;
typedef __attribute__((ext_vector_type(2))) __bf16 bf16x2_t;
typedef __attribute__((ext_vector_type(4))) unsigned u32x4;
typedef __attribute__((ext_vector_type(2))) unsigned u32x2;

#define MFMA32(a, b, c) __builtin_amdgcn_mfma_f32_32x32x16_bf16((a), (b), (c), 0, 0, 0)

constexpr int T_TOK = 16384;
constexpr int DM = 1024;
constexpr int SEQ = 8192;
constexpr float EPS = 1e-6f;
constexpr int NTHREADS = 256;
constexpr int LDS_BYTES = 65536;

constexpr size_t MiB = 1u << 20;
constexpr size_t OFF_LB = 64 * 1024;
constexpr size_t OFF_MISC = 68 * 1024;
constexpr size_t OFF_RSTD0 = 128 * 1024;
constexpr size_t OFF_SS1 = 29 * MiB;
constexpr size_t OFF_RSTD2 = 256 * 1024;
constexpr size_t OFF_SS3 = 30 * MiB;
constexpr size_t OFF_LG = 1 * MiB;
constexpr size_t OFF_ROPE = 2 * MiB;
constexpr size_t OFF_ACH = 3 * MiB;
constexpr size_t OFF_WIN = 4 * MiB;
constexpr size_t OFF_WOUT = 12 * MiB;
constexpr size_t OFF_WPQ0 = 14 * MiB;
constexpr size_t OFF_WKVQ = 18 * MiB;
constexpr size_t OFF_WO = 24 * MiB;
constexpr size_t OFF_WPQ1 = 25 * MiB;
constexpr size_t OFF_UV0 = 32 * MiB;
constexpr size_t OFF_UV1 = 64 * MiB;
constexpr size_t OFF_SC0 = 31 * MiB;
constexpr size_t OFF_SC1 = 31 * MiB + 256 * 1024;
constexpr size_t OFF_HB = 160 * MiB;
constexpr size_t OFF_QG = 192 * MiB;
constexpr size_t OFF_KG = 224 * MiB;
constexpr size_t OFF_LOGF = 256 * MiB;
constexpr size_t OFF_VG = 320 * MiB;
constexpr size_t OFF_GG = 352 * MiB;
constexpr size_t OFF_UT = 384 * MiB;
constexpr size_t OFF_OG = 448 * MiB;
constexpr size_t WS_NEED = 480 * MiB;
constexpr size_t OFF_K = 208 * MiB;
constexpr size_t OFF_V = 232 * MiB;
constexpr size_t OFF_Q = 256 * MiB;
constexpr size_t OFF_OGA = 304 * MiB;
constexpr size_t OFF_AO = 352 * MiB;
constexpr size_t OFF_EX = 368 * MiB;
constexpr size_t OFF_GT = 376 * MiB;
constexpr size_t OFF_ACT = 384 * MiB;
constexpr size_t OFF_SS2 = 30 * MiB + 512 * 1024;
constexpr size_t OFF_HBT = OFF_HB;
constexpr size_t OFF_ZP = 392 * MiB;
constexpr size_t OFF_DUMMY = 512 * 1024;
constexpr size_t OFF_CENSUS = 15 * 1024;

struct Params {
  const float *x, *hgrn_norm, *hgrn_w_in, *hgrn_lb, *hgrn_out_norm, *hgrn_w_out, *kv_norm, *w_kv, *k_norm, *attn_norm, *w_q,
      *q_norm, *w_o, *ffn_norm, *peer_w_q, *peer_sub_keys, *peer_u, *peer_v;
  float* out;
  unsigned char* ws;
};

DI int opaque_tid() { int t = threadIdx.x; asm volatile("" : "+v"(t)); return t; }
DI int crow(int r, int h) { return (r & 3) + 8 * (r >> 2) + 4 * h; }
DI unsigned pack2(float a, float b) {
  f32x2 v = {a, b};
  return __builtin_bit_cast(unsigned, __builtin_convertvector(v, bf16x2_t));
}
DI u16 f2bf(float f) { return (u16)(pack2(f, 0.f) & 0xffffu); }
DI float bf2f(u16 h) { return __uint_as_float(((unsigned)h) << 16); }
DI float bflo(unsigned u) { return __uint_as_float(u << 16); }
DI float bfhi(unsigned u) { return __uint_as_float(u & 0xffff0000u); }
DI float sigmoidf_(float v) { return 1.f / (1.f + __expf(-v)); }
DI float siluf_(float v) { return v / (1.f + __expf(-v)); }
DI float gelu_tanh(float z) {
  const float y = 0.7978845608028654f * (z + 0.044715f * z * z * z);
  const float t = 1.f - 2.f / (1.f + __expf(2.f * y));
  return 0.5f * z * (1.f + t);
}
DI size_t tiledA(int t, int col, int K) {
  return (size_t)(t >> 5) * (32 * (size_t)K) + (size_t)((((col >> 6) * 4 + ((col >> 4) & 3)) * 64 + ((col >> 3) & 1) * 32 + (t & 31)) * 8 + (col & 7));
}
DI int off128(int row, int c) { return row * 128 + ((c ^ ((row >> 1) & 7)) << 4); }
DI int off256(int row, int c) { return row * 256 + ((c ^ (row & 15)) << 4); }
DI int key_of(float f) { int k = __float_as_int(f); k ^= (k >> 31) & 0x7fffffff; return k; }
DI float val_of(int k) { k ^= (k >> 31) & 0x7fffffff; return __int_as_float(k); }
DI float rstd_from_partials(const float* ss, int m) {
  const float4 a = *(const float4*)(ss + (size_t)m * 8), b = *(const float4*)(ss + (size_t)m * 8 + 4);
  const float t = ((a.x + a.y) + (a.z + a.w)) + ((b.x + b.y) + (b.z + b.w));
  return rsqrtf(t * (1.f / 1024.f) + EPS);
}

template <int N>
DI void bitonic_sort_desc(int (&a)[N]) {
#pragma unroll
  for (int k = 2; k <= N; k <<= 1)
#pragma unroll
    for (int j = k >> 1; j > 0; j >>= 1)
#pragma unroll
      for (int i = 0; i < N; ++i) {
        const int l = i ^ j;
        if (l > i) {
          const int hi = max(a[i], a[l]), lo = min(a[i], a[l]);
          if ((i & k) == 0) { a[i] = hi; a[l] = lo; } else { a[i] = lo; a[l] = hi; }
        }
      }
}
DI void merge_top16(int (&a)[16], const int (&b)[16]) {
#pragma unroll
  for (int i = 0; i < 16; ++i) a[i] = max(a[i], b[15 - i]);
#pragma unroll
  for (int j = 8; j > 0; j >>= 1)
#pragma unroll
    for (int i = 0; i < 16; ++i) {
      const int l = i ^ j;
      if (l > i) { const int hi = max(a[i], a[l]), lo = min(a[i], a[l]); a[i] = hi; a[l] = lo; }
    }
}
#define TOPK_INSERT(a, xk) do { int _x = (xk); _Pragma("unroll") for (int _j = 0; _j < 16; ++_j) { int _t = max(a[_j], _x); _x = min(a[_j], _x); a[_j] = _t; } } while (0)

constexpr int N_TR = 1024 + 256 + 384 + 384 + 128;
constexpr int N_CP = 1024;
constexpr int N_UV = 8192;
constexpr int N_X = 512;
constexpr int N_ROPE = 512;
constexpr int N_MISC = 64;
constexpr int N_P0 = N_TR + N_CP + N_X + N_ROPE + N_MISC;

DI void p0_transpose_tile(const float* src, int N, const float* gain, u16* dst, int ld, int rowoff, int kt, int ntile, float* tile) {
  const int tid = opaque_tid();
  const int k0 = kt * 64, n0 = ntile * 64;
#pragma unroll
  for (int i = 0; i < 4; ++i) {
    const int k = i * 16 + (tid >> 4), n = (tid & 15) * 4;
    float4 v = *(const float4*)(src + (size_t)(k0 + k) * N + n0 + n);
    if (gain) { const float gk = gain[k0 + k]; v.x *= gk; v.y *= gk; v.z *= gk; v.w *= gk; }
    tile[k * 65 + n] = v.x; tile[k * 65 + n + 1] = v.y; tile[k * 65 + n + 2] = v.z; tile[k * 65 + n + 3] = v.w;
  }
  __syncthreads();
  {
    const int n = tid >> 2, kq = (tid & 3) * 16;
    unsigned pk[8];
#pragma unroll
    for (int i = 0; i < 8; ++i) pk[i] = pack2(tile[(kq + 2 * i) * 65 + n], tile[(kq + 2 * i + 1) * 65 + n]);
    uint4* d = (uint4*)(dst + (size_t)(rowoff + n0 + n) * ld + k0 + kq);
    d[0] = make_uint4(pk[0], pk[1], pk[2], pk[3]);
    d[1] = make_uint4(pk[4], pk[5], pk[6], pk[7]);
  }
  __syncthreads();
}

DI void p0_prep(const Params& p, unsigned char* lds) {
  const int tid = opaque_tid(), lane = tid & 63, w = tid >> 6;
  unsigned char* ws = p.ws;
  for (int item = blockIdx.x; item < N_P0; item += gridDim.x) {
    int it = item;
    if (it < N_TR) {
      float* tile = (float*)lds;
      if (it < 1024) p0_transpose_tile(p.hgrn_w_in, 4096, p.hgrn_norm, (u16*)(ws + OFF_WIN), 1024, 0, it / 64, it % 64, tile);
      else if (it < 1280) { it -= 1024; p0_transpose_tile(p.hgrn_w_out, 1024, nullptr, (u16*)(ws + OFF_WOUT), 1024, 0, it / 16, it % 16, tile); }
      else if (it < 1664) { it -= 1280; p0_transpose_tile(p.w_kv, 1536, p.kv_norm, (u16*)(ws + OFF_WKVQ), 1024, 0, it / 24, it % 24, tile); }
      else if (it < 2048) { it -= 1664; p0_transpose_tile(p.w_q, 1536, p.attn_norm, (u16*)(ws + OFF_WKVQ), 1024, 1536, it / 24, it % 24, tile); }
      else { it -= 2048; p0_transpose_tile(p.w_o, 1024, nullptr, (u16*)(ws + OFF_WO), 512, 0, it / 16, it % 16, tile); }
      continue;
    }
    it -= N_TR;
    if (it < N_CP) {
      const int l = it >> 9, rem = it & 511, h = rem >> 6, wsel = (rem >> 5) & 1, nh = (rem >> 4) & 1;
      const int c0 = (rem & 15) * 64;
      float* Ws = (float*)lds;
      float* Ks = (float*)(lds + 64 * 65 * 4);
      const float* keys = p.peer_sub_keys + ((size_t)(l * 2 + wsel) * 128 + nh * 64) * 128;
      const float* Wp = p.peer_w_q + (size_t)l * 1024 * 2048 + (size_t)c0 * 2048 + h * 256 + wsel * 128;
      const int ci = w & 1, ni = w >> 1, r31 = lane & 31, kh = lane >> 5;
      f32x16 acc;
#pragma unroll
      for (int r = 0; r < 16; ++r) acc[r] = 0.f;
      for (int ps = 0; ps < 2; ++ps) {
#pragma unroll 4
        for (int i = 0; i < 16; ++i) {
          const int idx = tid + 256 * i, rr = idx >> 6, d = idx & 63;
          Ws[rr * 65 + d] = Wp[(size_t)rr * 2048 + ps * 64 + d] * p.ffn_norm[l * 1024 + c0 + rr];
          Ks[rr * 65 + d] = keys[rr * 128 + ps * 64 + d];
        }
        __syncthreads();
#pragma unroll 8
        for (int s2 = 0; s2 < 32; ++s2)
          acc = __builtin_amdgcn_mfma_f32_32x32x2f32(Ws[(ci * 32 + r31) * 65 + 2 * s2 + kh], Ks[(ni * 32 + r31) * 65 + 2 * s2 + kh], acc, 0, 0, 0);
        __syncthreads();
      }
      u16* dst = (u16*)(ws + (l ? OFF_WPQ1 : OFF_WPQ0)) + (size_t)(h * 256 + wsel * 128 + nh * 64 + ni * 32 + r31) * 1024 + c0 + ci * 32;
#pragma unroll
      for (int g = 0; g < 4; ++g) *(uint2*)(dst + 8 * g + 4 * kh) = make_uint2(pack2(acc[4 * g], acc[4 * g + 1]), pack2(acc[4 * g + 2], acc[4 * g + 3]));
      continue;
    }
    it -= N_CP;
    if (it < N_X) {
      float* xt = (float*)lds;
      const int t0 = it * 32;
      u16* dst = (u16*)(ws + OFF_HB) + (size_t)it * 32768;
      float ssr[8];
#pragma unroll
      for (int i = 0; i < 8; ++i) ssr[i] = 0.f;
      typedef float v4f __attribute__((ext_vector_type(4)));
      v4f xa[8], xb[8];
#define X_LOAD(R, CH) do { _Pragma("unroll") for (int i = 0; i < 8; ++i) R[i] = *(const v4f*)(p.x + (size_t)(t0 + w + 4 * i) * 1024 + (CH) * 256 + lane * 4); } while (0)
#define X_CHUNK(R, CH) do { \
        _Pragma("unroll") for (int i = 0; i < 8; ++i) { ssr[i] += R[i][0] * R[i][0] + R[i][1] * R[i][1] + R[i][2] * R[i][2] + R[i][3] * R[i][3]; *(v4f*)(xt + (w + 4 * i) * 260 + lane * 4) = R[i]; } \
        __syncthreads(); \
        _Pragma("unroll") for (int sl = 0; sl < 4; ++sl) {     \
          const int slot = w * 4 + sl, l31 = lane & 31, hf = lane >> 5; \
          const float4 v0 = *(const float4*)(xt + l31 * 260 + slot * 16 + hf * 8), v1 = *(const float4*)(xt + l31 * 260 + slot * 16 + hf * 8 + 4); \
          *(uint4*)(dst + (size_t)(((CH) * 16 + slot) * 64 + lane) * 8) = make_uint4(pack2(v0.x, v0.y), pack2(v0.z, v0.w), pack2(v1.x, v1.y), pack2(v1.z, v1.w)); } \
        __syncthreads(); } while (0)
      X_LOAD(xa, 0);
      X_LOAD(xb, 1);
      X_CHUNK(xa, 0);
      X_LOAD(xa, 2);
      X_CHUNK(xb, 1);
      X_LOAD(xb, 3);
      X_CHUNK(xa, 2);
      X_CHUNK(xb, 3);
#undef X_LOAD
#undef X_CHUNK
#pragma unroll
      for (int i = 0; i < 8; ++i) {
        float ss = ssr[i];
#pragma unroll
        for (int o = 32; o >= 1; o >>= 1) ss += __shfl_xor(ss, o);
        if (lane == 0) ((float*)(ws + OFF_RSTD0))[t0 + w + 4 * i] = rsqrtf(ss * (1.f / 1024.f) + EPS);
      }
      continue;
    }
    it -= N_X;
    if (it < N_ROPE) {
      const int idx = it * 256 + tid; const int pos = idx >> 4, i = idx & 15;
      const float inv = powf(500000.f, -(float)i * (1.f / 16.f));
      const float ang = (float)pos * inv;
      float s, c; sincosf(ang, &s, &c);
      ((float2*)(ws + OFF_ROPE))[idx] = make_float2(c, s);
      continue;
    }
    it -= N_ROPE;
    {
      const int idx = it * 256 + tid;
      if (idx < 1024) {
        const float l0 = p.hgrn_lb[idx], l1 = p.hgrn_lb[1024 + idx];
        ((float*)(ws + OFF_LB))[idx] = 1.f / (1.f + __expf(l1 - l0));
      }
      if (idx == 0) {
        float mq = 0.f, mk = 0.f;
        for (int i = 0; i < 128; ++i) { mq = fmaxf(mq, fabsf(p.q_norm[i])); mk = fmaxf(mk, fabsf(p.k_norm[i])); }
        ((float*)(ws + OFF_MISC))[0] = 11.313708499f * mq * mk;
      }
    }
  }
}

DI void peer_tables(const Params& p, int l, int ibeg, int iend) {
  const int tid = opaque_tid(), lane = tid & 63, w = tid >> 6;
  unsigned char* ws = p.ws;
  for (int i = ibeg; i < iend; ++i) {
    const int e = (int)(blockIdx.x * 4 + w) + (int)(gridDim.x * 4) * i;
    if (e >= 16384) break;
    const float* su = p.peer_u + ((size_t)l * 16384 + e) * 1024 + lane * 4;
    const float* sv = p.peer_v + ((size_t)l * 16384 + e) * 1024 + lane * 4;
    const float* g = p.ffn_norm + l * 1024 + lane * 4;
    float uu[16], vv[16];
#pragma unroll
    for (int k = 0; k < 4; ++k) {
      const float4 a = *(const float4*)(su + 256 * k); const float4 gg = *(const float4*)(g + 256 * k); const float4 bq = *(const float4*)(sv + 256 * k);
      uu[4 * k] = a.x * gg.x; uu[4 * k + 1] = a.y * gg.y; uu[4 * k + 2] = a.z * gg.z; uu[4 * k + 3] = a.w * gg.w;
      vv[4 * k] = bq.x; vv[4 * k + 1] = bq.y; vv[4 * k + 2] = bq.z; vv[4 * k + 3] = bq.w;
    }
    float mu = 0.f, mv = 0.f;
#pragma unroll
    for (int k = 0; k < 16; ++k) { mu = fmaxf(mu, fabsf(uu[k])); mv = fmaxf(mv, fabsf(vv[k])); }
#pragma unroll
    for (int o = 32; o >= 1; o >>= 1) { mu = fmaxf(mu, __shfl_xor(mu, o)); mv = fmaxf(mv, __shfl_xor(mv, o)); }
    const float scu = mu > 0.f ? mu * (1.f / 448.f) : 1.f, scv = mv > 0.f ? mv * (1.f / 448.f) : 1.f;
    const float iu = 1.f / scu, iv = 1.f / scv;
    unsigned char* base = ws + (l ? OFF_UV1 : OFF_UV0);
#pragma unroll
    for (int k = 0; k < 4; ++k) {
      int pk = 0;
      pk = __builtin_amdgcn_cvt_pk_fp8_f32(uu[4 * k] * iu, uu[4 * k + 1] * iu, pk, false);
      pk = __builtin_amdgcn_cvt_pk_fp8_f32(uu[4 * k + 2] * iu, uu[4 * k + 3] * iu, pk, true);
      int pv = 0;
      pv = __builtin_amdgcn_cvt_pk_fp8_f32(vv[4 * k] * iv, vv[4 * k + 1] * iv, pv, false);
      pv = __builtin_amdgcn_cvt_pk_fp8_f32(vv[4 * k + 2] * iv, vv[4 * k + 3] * iv, pv, true);
      const size_t off = ((size_t)(2 * k + (lane >> 5)) * 16384 + e) * 128 + (lane & 31) * 4;
      *(int*)(base + off) = pk;
      *(int*)(base + 16 * MiB + off) = pv;
    }
    if (lane == 0) ((float2*)(ws + (l ? OFF_SC1 : OFF_SC0)))[e] = make_float2(scu, scv);
  }
}

template <class Epi, int SIDE = 0, bool PAIR = false>
DI void gemm_phase(const Params& p, const u16* __restrict__ A, int lda, const u16* __restrict__ Bt, int ldb, int MT, int NT, int nk, Epi& epi, unsigned char* lds) {
  const int ntl = 0;
  const int nrw = (16384 + (int)gridDim.x * 4 - 1) / ((int)gridDim.x * 4);
  int seq = 0;
  const bool side_first = SIDE && (blockIdx.x * 2 >= gridDim.x);
  if (side_first) peer_tables(p, SIDE - 1, 0, nrw);
  const int Gx = (int)gridDim.x, bxx = (int)blockIdx.x;
  const bool two = Gx >= 2;
  const int Gl = two ? (Gx + 1) >> 1 : Gx;
  const bool upper = two && bxx >= Gl;
  const int NU = PAIR ? NT / 2 : NT;
  const int NH = two ? (upper ? NU - (NU >> 1) : (NU >> 1)) : NU;
  const int ubase = upper ? (NU >> 1) : 0;
  const int ustride = upper ? Gx - Gl : Gl;
  for (int u = upper ? bxx - Gl : bxx; u < MT * NH; u += ustride)
  for (int sub = 0; sub < (PAIR ? 2 : 1); ++sub) {
    const int mt = u / NH, unit = (u - mt * NH) + ubase;
    const int tid = opaque_tid(), lane = tid & 63, w = tid >> 6, l31 = lane & 31, half = lane >> 5;
    const int goffB0 = (tid >> 3) * ldb + (tid & 7) * 8;
    const int loffB0 = off128(tid >> 3, tid & 7);
    const int goffA = w * 32 * lda + lane * 8;
    const int lrowF = l31 * 128, lxF = (half ^ ((l31 >> 1) & 7)) << 4;
    const int nt = PAIR ? 2 * unit + sub : unit;
    const int m0 = mt * 128, n0 = nt * 128;
    f32x16 acc[4];
#pragma unroll
    for (int i = 0; i < 4; ++i)
#pragma unroll
      for (int r = 0; r < 16; ++r) acc[i][r] = 0.f;
    const u16* Ab = A + (size_t)m0 * lda + goffA;
    const u16* Bb = Bt + (size_t)n0 * ldb;
    bf16x8 aR[2][4];
    u32x4 bR[4][4];
#define LOAD_A(slot, ks) do { _Pragma("unroll") for (int kk = 0; kk < 4; ++kk) aR[slot][kk] = *(const bf16x8*)(Ab + ((ks) * 4 + kk) * 512); } while (0)
#define LOAD_B(slot, ks) do { _Pragma("unroll") for (int j = 0; j < 4; ++j) bR[slot][j] = *(const u32x4*)(Bb + goffB0 + j * 32 * ldb + (ks) * 64); } while (0)
#define STORE_B(slot, buf) do { _Pragma("unroll") for (int j = 0; j < 4; ++j) *(u32x4*)(lds + (buf) * 16384 + loffB0 + j * 4096) = bR[slot][j]; } while (0)
#define GEMM_STEP(ks, sa, sb) do { \
      const unsigned char* base_ = lds + ((sa) & 1) * 16384; \
      _Pragma("unroll") for (int kk = 0; kk < 4; ++kk) { \
        _Pragma("unroll") for (int n4 = 0; n4 < 4; ++n4) { \
          const bf16x8 wf = *(const bf16x8*)(base_ + n4 * 4096 + lrowF + (lxF ^ (kk << 5))); \
          acc[n4] = MFMA32(wf, aR[(sa) & 1][kk], acc[n4]); } } \
      if ((ks) + 2 < nk) LOAD_A((sa) & 1, (ks) + 2); \
      if ((ks) + 1 < nk) STORE_B(sb, (sb) & 1); \
      if ((ks) + 5 < nk) LOAD_B(sb, (ks) + 5); \
      __syncthreads(); } while (0)
    LOAD_B(0, 0); LOAD_B(1, 1); LOAD_B(2, 2); LOAD_B(3, 3);
    LOAD_A(0, 0); LOAD_A(1, 1);
    STORE_B(0, 0);
    LOAD_B(0, 4);
    __syncthreads();
#pragma unroll 1
    for (int ks = 0; ks < nk; ks += 4) {
      GEMM_STEP(ks, 0, 1);
      GEMM_STEP(ks + 1, 1, 2);
      GEMM_STEP(ks + 2, 2, 3);
      GEMM_STEP(ks + 3, 3, 0);
    }
    epi(acc, m0 + w * 32 + l31, n0, half);
    ++seq;
  }
  if (SIDE && !side_first) peer_tables(p, SIDE - 1, 0, nrw);
  (void)ntl; (void)seq;
#undef LOAD_A
#undef LOAD_B
#undef STORE_B
#undef GEMM_STEP
}

struct EpiNull {
  DI void operator()(f32x16 (&acc)[4], int m, int n0, int half) const {
#pragma unroll
    for (int i = 0; i < 4; ++i)
#pragma unroll
      for (int r = 0; r < 16; ++r) asm volatile("" :: "v"(acc[i][r]));
  }
};
struct EpiHgrnIn {
  const float* rstd; const float* lb; u16 *Qg, *Vg, *Gg; _Float16* LOGF;
  DI void operator()(f32x16 (&acc)[4], int m, int n0, int half) const {
    const float rs = rstd[m];
    const int sec = n0 >> 10, colb = n0 & 1023;
    const int pos = m & (SEQ - 1);
    const size_t tb0 = ((size_t)(((m >> 13) * 8 + (colb >> 7)) * 128 + (pos >> 6))) * 8192 + (size_t)(pos & 63) * 4;
#pragma unroll
    for (int n4 = 0; n4 < 4; ++n4)
#pragma unroll
      for (int g = 0; g < 4; ++g) {
        const int dl = n4 * 32 + 8 * g + 4 * half;
        const size_t to = tb0 + (size_t)(dl >> 2) * 256;
        float v[4];
#pragma unroll
        for (int j = 0; j < 4; ++j) v[j] = acc[n4][4 * g + j] * rs;
        if (sec == 0) {
          *(uint2*)(Qg + to) = make_uint2(pack2(siluf_(v[0]), siluf_(v[1])), pack2(siluf_(v[2]), siluf_(v[3])));
        } else if (sec == 1) {
          const float4 lbv = *(const float4*)(lb + colb + dl);
          const float lbs[4] = {lbv.x, lbv.y, lbv.z, lbv.w};
          typedef _Float16 h4 __attribute__((ext_vector_type(4)));
          h4 lf;
#pragma unroll
          for (int j = 0; j < 4; ++j) lf[j] = (_Float16)__logf(lbs[j] + (1.f - lbs[j]) * sigmoidf_(v[j]));
          *(h4*)(LOGF + to) = lf;
        } else if (sec == 2) {
          *(uint2*)(Vg + to) = make_uint2(pack2(v[0], v[1]), pack2(v[2], v[3]));
        } else {
          *(uint2*)(Gg + to) = make_uint2(pack2(siluf_(v[0]), siluf_(v[1])), pack2(siluf_(v[2]), siluf_(v[3])));
        }
      }
  }
};

template <bool RES_TILED>
struct EpiResidual {
  const float* res; u16* hbt; float* ss;
  DI void operator()(f32x16 (&acc)[4], int m, int n0, int half) const {
    float s = 0.f;
#pragma unroll
    for (int n4 = 0; n4 < 4; ++n4)
#pragma unroll
      for (int g = 0; g < 4; ++g) {
        const int col = n0 + n4 * 32 + 8 * g + 4 * half;
        u16* dst = hbt + tiledA(m, col, 1024);
        float r0, r1, r2, r3;
        if (RES_TILED) { const uint2 rv = *(const uint2*)dst; r0 = bflo(rv.x); r1 = bfhi(rv.x); r2 = bflo(rv.y); r3 = bfhi(rv.y); }
        else { const float4 rv = *(const float4*)(res + (size_t)m * 1024 + col); r0 = rv.x; r1 = rv.y; r2 = rv.z; r3 = rv.w; }
        const float v0 = acc[n4][4 * g] + r0, v1 = acc[n4][4 * g + 1] + r1, v2 = acc[n4][4 * g + 2] + r2, v3 = acc[n4][4 * g + 3] + r3;
        *(uint2*)dst = make_uint2(pack2(v0, v1), pack2(v2, v3));
        s += v0 * v0 + v1 * v1 + v2 * v2 + v3 * v3;
      }
    s += __shfl_xor(s, 32);
    if (half == 0) ss[(size_t)m * 8 + (n0 >> 7)] = s;
  }
};

struct EpiTopk {
  const float* ss; int* EX; float* GT; unsigned char* sel_lds;
  DI void operator()(f32x16 (&acc)[4], int m, int n0, int half) {
    const float rs = rstd_from_partials(ss, m);
    int k0[16], k1[16];
#pragma unroll
    for (int r = 0; r < 16; ++r) {
      k0[r] = (key_of(acc[0][r] * rs) & ~0x7f) | (crow(r, half));
      k1[r] = (key_of(acc[1][r] * rs) & ~0x7f) | (32 + crow(r, half));
    }
    bitonic_sort_desc<16>(k0);
    __builtin_amdgcn_sched_barrier(0);
    bitonic_sort_desc<16>(k1);
    merge_top16(k0, k1);
    __builtin_amdgcn_sched_barrier(0);
#pragma unroll
    for (int r = 0; r < 16; ++r) k1[r] = (key_of(acc[2][r] * rs) & ~0x7f) | (64 + crow(r, half));
    bitonic_sort_desc<16>(k1);
    merge_top16(k0, k1);
    __builtin_amdgcn_sched_barrier(0);
#pragma unroll
    for (int r = 0; r < 16; ++r) k1[r] = (key_of(acc[3][r] * rs) & ~0x7f) | (96 + crow(r, half));
    bitonic_sort_desc<16>(k1);
    merge_top16(k0, k1);
    __builtin_amdgcn_sched_barrier(0);
    int b[16];
#pragma unroll
    for (int j = 0; j < 16; ++j) b[j] = __shfl_xor(k0[j], 32);
    merge_top16(k0, b);
    volatile int* stash = (volatile int*)(sel_lds + 2048 + (threadIdx.x & 63) * 64);
    if (((n0 >> 7) & 1) == 0) {
#pragma unroll
      for (int j = 0; j < 16; ++j) stash[j] = k0[j];
      return;
    }
    int kprev[16];
#pragma unroll
    for (int j = 0; j < 16; ++j) kprev[j] = stash[j];
#define F1(i) val_of(kprev[i] & ~0x7f)
#define F2(j) val_of(k0[j] & ~0x7f)
    int a[16];
#pragma unroll
    for (int j = 0; j < 16; ++j) a[j] = (int)0x80000000;
#define SEL_PAIR(IA, JA, IB, JB) do { const int ka_ = (key_of(F1(IA) + F2(JA)) & ~0xff) | ((IA) * 16 + (JA)), kb_ = (key_of(F1(IB) + F2(JB)) & ~0xff) | ((IB) * 16 + (JB)); \
      const int kk_ = half ? kb_ : ka_; TOPK_INSERT(a, kk_); } while (0)
      SEL_PAIR(0, 0, 0, 1);
      SEL_PAIR(0, 2, 0, 3);
      SEL_PAIR(0, 4, 0, 5);
      SEL_PAIR(0, 6, 0, 7);
      SEL_PAIR(0, 8, 0, 9);
      SEL_PAIR(0, 10, 0, 11);
      SEL_PAIR(0, 12, 0, 13);
      SEL_PAIR(0, 14, 0, 15);
      SEL_PAIR(1, 0, 1, 1);
      SEL_PAIR(1, 2, 1, 3);
      SEL_PAIR(1, 4, 1, 5);
      SEL_PAIR(1, 6, 1, 7);
      SEL_PAIR(2, 0, 2, 1);
      SEL_PAIR(2, 2, 2, 3);
      SEL_PAIR(2, 4, 3, 0);
      SEL_PAIR(3, 1, 3, 2);
      SEL_PAIR(3, 3, 4, 0);
      SEL_PAIR(4, 1, 4, 2);
      SEL_PAIR(5, 0, 5, 1);
      SEL_PAIR(6, 0, 6, 1);
      SEL_PAIR(7, 0, 7, 1);
      SEL_PAIR(8, 0, 9, 0);
      SEL_PAIR(10, 0, 11, 0);
      SEL_PAIR(12, 0, 13, 0);
      SEL_PAIR(14, 0, 15, 0);
#undef SEL_PAIR
#undef F1
#undef F2
#pragma unroll
    for (int j = 0; j < 16; ++j) b[j] = __shfl_xor(a[j], 32);
    merge_top16(a, b);
    unsigned char* my = sel_lds + (m & 31) * 36;
    {
      unsigned pk4[4];
#pragma unroll
      for (int q = 0; q < 4; ++q) {
        const int s0 = half ? k0[4 * q] : kprev[4 * q], s1 = half ? k0[4 * q + 1] : kprev[4 * q + 1], s2 = half ? k0[4 * q + 2] : kprev[4 * q + 2], s3 = half ? k0[4 * q + 3] : kprev[4 * q + 3];
        pk4[q] = (unsigned)(s0 & 0x7f) | ((unsigned)(s1 & 0x7f) << 8) | ((unsigned)(s2 & 0x7f) << 16) | ((unsigned)(s3 & 0x7f) << 24);
      }
#pragma unroll
      for (int q = 0; q < 4; ++q) *(volatile unsigned*)(my + half * 16 + 4 * q) = pk4[q];
    }
    asm volatile("s_waitcnt lgkmcnt(0)" ::: "memory");
    float cs[16];
    float sum = 0.f;
    const float mx = val_of(a[0] & ~0xff);
#pragma unroll
    for (int k = 0; k < 16; ++k) { cs[k] = __expf(val_of(a[k] & ~0xff) - mx); sum += cs[k]; }
    const float inv = 1.f / sum;
    const int hcol = (n0 >> 8) * 16;
    if (half == 0) {
      int eo[16];
#pragma unroll
      for (int k = 0; k < 16; ++k) { const int ij = a[k] & 0xff; eo[k] = (int)((volatile unsigned char*)my)[ij >> 4] * 128 + (int)((volatile unsigned char*)my)[16 + (ij & 15)]; }
      int4* de = (int4*)(EX + (size_t)m * 128 + hcol);
#pragma unroll
      for (int q = 0; q < 4; ++q) de[q] = make_int4(eo[4 * q], eo[4 * q + 1], eo[4 * q + 2], eo[4 * q + 3]);
    } else {
      float4* dg = (float4*)(GT + (size_t)m * 128 + hcol);
#pragma unroll
      for (int q = 0; q < 4; ++q) dg[q] = make_float4(cs[4 * q] * inv, cs[4 * q + 1] * inv, cs[4 * q + 2] * inv, cs[4 * q + 3] * inv);
    }
  }
};

struct EpiKVQ {
  const float* ss; const float *k_norm, *q_norm; const float2* rope; u16 *Kb, *Vb, *Qb; unsigned char* stage;
  DI void operator()(f32x16 (&acc)[4], int m, int n0, int half) const {
    const float rs = rstd_from_partials(ss, m);
    u16* dst; const float* gain = nullptr; int ld;
    if (n0 < 768) { dst = Kb + (size_t)m * 768 + n0; gain = k_norm; ld = 768; }
    else if (n0 < 1536) { dst = Vb + (size_t)m * 768 + (n0 - 768); ld = 768; }
    else { dst = Qb + (size_t)m * 1536 + (n0 - 1536); gain = q_norm; ld = 1536; }
#pragma unroll
    for (int n4 = 0; n4 < 4; ++n4)
#pragma unroll
      for (int r = 0; r < 16; ++r) acc[n4][r] *= rs;
    if (gain) {
      float s = 0.f;
#pragma unroll
      for (int n4 = 0; n4 < 4; ++n4)
#pragma unroll
        for (int r = 0; r < 16; ++r) s += acc[n4][r] * acc[n4][r];
      s += __shfl_xor(s, 32);
      const float rn = rsqrtf(s * (1.f / 128.f) + EPS);
#pragma unroll
      for (int n4 = 0; n4 < 4; ++n4)
#pragma unroll
        for (int g = 0; g < 4; ++g) {
          const float4 gv = *(const float4*)(gain + n4 * 32 + 8 * g + 4 * half);
          acc[n4][4 * g] *= rn * gv.x; acc[n4][4 * g + 1] *= rn * gv.y; acc[n4][4 * g + 2] *= rn * gv.z; acc[n4][4 * g + 3] *= rn * gv.w;
        }
      const int pos = m & (SEQ - 1);
#pragma unroll
      for (int r = 0; r < 8; ++r) {
        const float2 cs = rope[pos * 16 + crow(r, half)];
        const float x1 = acc[0][r], x2 = acc[0][r + 8];
        acc[0][r] = x1 * cs.x - x2 * cs.y;
        acc[0][r + 8] = x2 * cs.x + x1 * cs.y;
      }
    }
    unsigned char* st = stage + (threadIdx.x >> 6) * 4352;
    const int l31 = threadIdx.x & 31;
    const int rr = (threadIdx.x & 63) >> 3, cc = threadIdx.x & 7;
    u16* dbase = dst - (size_t)l31 * ld;
#pragma unroll
    for (int ps = 0; ps < 2; ++ps) {
#pragma unroll
      for (int n2 = 0; n2 < 2; ++n2)
#pragma unroll
        for (int g = 0; g < 4; ++g)
          *(uint2*)(st + l31 * 136 + (n2 * 32 + 8 * g + 4 * half) * 2) = make_uint2(pack2(acc[ps * 2 + n2][4 * g], acc[ps * 2 + n2][4 * g + 1]), pack2(acc[ps * 2 + n2][4 * g + 2], acc[ps * 2 + n2][4 * g + 3]));
      asm volatile("s_waitcnt lgkmcnt(0)" ::: "memory");
#pragma unroll
      for (int i = 0; i < 4; ++i) {
        const uint2 a = *(const uint2*)(st + (rr + 8 * i) * 136 + cc * 16), b = *(const uint2*)(st + (rr + 8 * i) * 136 + cc * 16 + 8);
        *(uint4*)(dbase + (size_t)(rr + 8 * i) * ld + ps * 64 + cc * 8) = make_uint4(a.x, a.y, b.x, b.y);
      }
      asm volatile("s_waitcnt lgkmcnt(0)" ::: "memory");
    }
  }
};

DI void gla_g1(const Params& p, unsigned char* lds) {
  const int tid = opaque_tid(), lane = tid & 63, w = tid >> 6, l31 = lane & 31, half = lane >> 5;
  unsigned char* ws = p.ws;
  const _Float16* LOGF = (const _Float16*)(ws + OFF_LOGF);
  const u16* Vg = (const u16*)(ws + OFF_VG);
  u16* UT = (u16*)(ws + OFF_UT);
  float* ACH = (float*)(ws + OFF_ACH);
  unsigned char* KT = lds;
  unsigned char* VT = lds + 16384;
  float* tot = (float*)(lds + 32768);
  for (int item = blockIdx.x; item < 2048; item += gridDim.x) {
    const int bh = item >> 7, c = item & 127, b = bh >> 3, h = bh & 7;
    (void)b; (void)h;
    const int dg = tid & 31, jr = tid >> 5, d0 = dg * 4;
    const size_t tb = (size_t)item * 8192 + (size_t)(dg * 64 + jr * 8) * 4;
    float lfv[8][4], bl[8][4];
    {
      typedef _Float16 h8 __attribute__((ext_vector_type(8)));
      float run[4] = {0.f, 0.f, 0.f, 0.f};
#pragma unroll
      for (int q = 0; q < 4; ++q) {
        const h8 lf = *(const h8*)(LOGF + tb + 8 * q);
#pragma unroll
        for (int i = 0; i < 8; ++i) { const int jj = 2 * q + (i >> 2), dd = i & 3; lfv[jj][dd] = (float)lf[i]; run[dd] += lfv[jj][dd]; bl[jj][dd] = run[dd]; }
      }
      *(float4*)(tot + jr * 128 + d0) = make_float4(run[0], run[1], run[2], run[3]);
    }
    __syncthreads();
    float pre[4] = {0.f, 0.f, 0.f, 0.f}, blast[4] = {0.f, 0.f, 0.f, 0.f};
#pragma unroll
    for (int r = 0; r < 8; ++r) {
      const float4 tv = *(const float4*)(tot + r * 128 + d0);
      const float m_ = (r < jr) ? 1.f : 0.f;
      pre[0] += m_ * tv.x; pre[1] += m_ * tv.y; pre[2] += m_ * tv.z; pre[3] += m_ * tv.w;
      blast[0] += tv.x; blast[1] += tv.y; blast[2] += tv.z; blast[3] += tv.w;
    }
#pragma unroll
    for (int dd = 0; dd < 4; ++dd) {
      unsigned pk[4];
#pragma unroll
      for (int i = 0; i < 4; ++i)
        pk[i] = pack2((1.f - __expf(lfv[2 * i][dd])) * __expf(blast[dd] - (bl[2 * i][dd] + pre[dd])), (1.f - __expf(lfv[2 * i + 1][dd])) * __expf(blast[dd] - (bl[2 * i + 1][dd] + pre[dd])));
      *(uint4*)(KT + off128(d0 + dd, jr)) = make_uint4(pk[0], pk[1], pk[2], pk[3]);
    }
    {
      uint4 vq[4];
#pragma unroll
      for (int q = 0; q < 4; ++q) vq[q] = *(const uint4*)(Vg + tb + 8 * q);
      *(uint4*)(VT + off128(d0 + 0, jr)) = make_uint4((vq[0].x & 0xffffu) | (vq[0].z << 16), (vq[1].x & 0xffffu) | (vq[1].z << 16), (vq[2].x & 0xffffu) | (vq[2].z << 16), (vq[3].x & 0xffffu) | (vq[3].z << 16));
      *(uint4*)(VT + off128(d0 + 1, jr)) = make_uint4((vq[0].x >> 16) | (vq[0].z & 0xffff0000u), (vq[1].x >> 16) | (vq[1].z & 0xffff0000u), (vq[2].x >> 16) | (vq[2].z & 0xffff0000u), (vq[3].x >> 16) | (vq[3].z & 0xffff0000u));
      *(uint4*)(VT + off128(d0 + 2, jr)) = make_uint4((vq[0].y & 0xffffu) | (vq[0].w << 16), (vq[1].y & 0xffffu) | (vq[1].w << 16), (vq[2].y & 0xffffu) | (vq[2].w << 16), (vq[3].y & 0xffffu) | (vq[3].w << 16));
      *(uint4*)(VT + off128(d0 + 3, jr)) = make_uint4((vq[0].y >> 16) | (vq[0].w & 0xffff0000u), (vq[1].y >> 16) | (vq[1].w & 0xffff0000u), (vq[2].y >> 16) | (vq[2].w & 0xffff0000u), (vq[3].y >> 16) | (vq[3].w & 0xffff0000u));
    }
    if (jr == 0) *(float4*)(ACH + item * 128 + d0) = make_float4(__expf(blast[0]), __expf(blast[1]), __expf(blast[2]), __expf(blast[3]));
    __syncthreads();
    f32x16 acc[4];
#pragma unroll
    for (int i = 0; i < 4; ++i)
#pragma unroll
      for (int r = 0; r < 16; ++r) acc[i][r] = 0.f;
#pragma unroll
    for (int s = 0; s < 4; ++s) {
      const bf16x8 af = *(const bf16x8*)(KT + off128(w * 32 + l31, 2 * s + half));
#pragma unroll
      for (int et = 0; et < 4; ++et) {
        const bf16x8 bfr = *(const bf16x8*)(VT + off128(et * 32 + l31, 2 * s + half));
        acc[et] = MFMA32(af, bfr, acc[et]);
      }
    }
#pragma unroll
    for (int et = 0; et < 4; ++et)
#pragma unroll
      for (int g = 0; g < 4; ++g) {
        const int e = et * 32 + l31, d0 = w * 32 + 8 * g + 4 * half;
        *(uint2*)(UT + ((size_t)item * 128 + e) * 128 + d0) = make_uint2(pack2(acc[et][4 * g], acc[et][4 * g + 1]), pack2(acc[et][4 * g + 2], acc[et][4 * g + 3]));
      }
    __syncthreads();
  }
}

DI void gla_g2(const Params& p) {
  const int tid = opaque_tid();
  unsigned char* ws = p.ws;
  u16* UT = (u16*)(ws + OFF_UT);
  const float* ACH = (const float*)(ws + OFF_ACH);
  for (int u = blockIdx.x; u < 1024; u += gridDim.x) {
    const int bh = u >> 6, e = (u & 63) * 2 + (tid >> 7), d = tid & 127;
    float S = 0.f;
    size_t idx = ((size_t)bh * 128) * 16384 + (size_t)e * 128 + d;
    size_t aidx = (size_t)bh * 128 * 128 + d;
    for (int c = 0; c < 128; c += 32) {
      float uv[32], av[32];
#pragma unroll
      for (int k = 0; k < 32; ++k) { uv[k] = bf2f(UT[idx + (size_t)k * 16384]); av[k] = ACH[aidx + (size_t)k * 128]; }
#pragma unroll
      for (int k = 0; k < 32; ++k) { UT[idx + (size_t)k * 16384] = f2bf(S); S = av[k] * S + uv[k]; }
      idx += (size_t)32 * 16384; aidx += 32 * 128;
    }
  }
}

DI void gla_g3(const Params& p, unsigned char* lds) {
  const int tid = opaque_tid(), lane = tid & 63, w = tid >> 6, l31 = lane & 31, half = lane >> 5;
  unsigned char* ws = p.ws;
  const _Float16* LOGF = (const _Float16*)(ws + OFF_LOGF);
  const u16* Qg = (const u16*)(ws + OFF_QG);
  const u16* Vg = (const u16*)(ws + OFF_VG);
  const u16* Gg = (const u16*)(ws + OFF_GG);
  const u16* ST = (const u16*)(ws + OFF_UT);
  u16* OG = (u16*)(ws + OFF_OG);
  unsigned char* QP = lds;
  unsigned char* KP = lds + 16384;
  unsigned char* VT = lds + 32768;
  unsigned char* STs = lds + 16384;
  float* tot = (float*)(lds + 49152);
  float* red = (float*)(lds + 49152 + 4096);
  for (int item = blockIdx.x; item < 2048; item += gridDim.x) {
    const int bh = item >> 7, c = item & 127, b = bh >> 3, h = bh & 7;
    const int t0 = b * SEQ + c * 64;
    u32x4 stq[8];
    {
      const u16* src = ST + (size_t)item * 16384;
#pragma unroll
      for (int j = 0; j < 8; ++j) { const int id = tid + 256 * j; stq[j] = *(const u32x4*)(src + (size_t)(id >> 4) * 128 + (id & 15) * 8); }
    }
    u32x2 ggq[2][4];
    {
      const int tq_ = t0 + (w & 1) * 32 + l31;
#pragma unroll
      for (int ee = 0; ee < 2; ++ee)
#pragma unroll
        for (int g = 0; g < 4; ++g) ggq[ee][g] = *(const u32x2*)(Gg + (size_t)item * 8192 + (size_t)(((((w >> 1) * 2 + ee) * 32 + 8 * g + 4 * half) >> 2) * 64 + (w & 1) * 32 + l31) * 4);
    }
    const int dg = tid & 31, jr = tid >> 5, d0 = dg * 4;
    const size_t tb = (size_t)item * 8192 + (size_t)(dg * 64 + jr * 8) * 4;
    float lfv[8][4], bl[8][4];
    {
      typedef _Float16 h8 __attribute__((ext_vector_type(8)));
      float run[4] = {0.f, 0.f, 0.f, 0.f};
#pragma unroll
      for (int q = 0; q < 4; ++q) {
        const h8 lf = *(const h8*)(LOGF + tb + 8 * q);
#pragma unroll
        for (int i = 0; i < 8; ++i) { const int jj = 2 * q + (i >> 2), dd = i & 3; lfv[jj][dd] = (float)lf[i]; run[dd] += lfv[jj][dd]; bl[jj][dd] = run[dd]; }
      }
      *(float4*)(tot + jr * 128 + d0) = make_float4(run[0], run[1], run[2], run[3]);
    }
    __syncthreads();
    float pre[4] = {0.f, 0.f, 0.f, 0.f}, blast[4] = {0.f, 0.f, 0.f, 0.f};
#pragma unroll
    for (int r = 0; r < 8; ++r) {
      const float4 tv = *(const float4*)(tot + r * 128 + d0);
      const float m_ = (r < jr) ? 1.f : 0.f;
      pre[0] += m_ * tv.x; pre[1] += m_ * tv.y; pre[2] += m_ * tv.z; pre[3] += m_ * tv.w;
      blast[0] += tv.x; blast[1] += tv.y; blast[2] += tv.z; blast[3] += tv.w;
    }
    {
      uint4 qq[4];
#pragma unroll
      for (int q = 0; q < 4; ++q) qq[q] = *(const uint4*)(Qg + tb + 8 * q);
#pragma unroll
      for (int jj = 0; jj < 8; ++jj) {
        const int i = jr * 8 + jj;
        const unsigned q01 = (jj & 1) ? qq[jj >> 1].z : qq[jj >> 1].x, q23 = (jj & 1) ? qq[jj >> 1].w : qq[jj >> 1].y;
        const float qf[4] = {bflo(q01), bfhi(q01), bflo(q23), bfhi(q23)};
        float qv[4], kv[4];
#pragma unroll
        for (int dd = 0; dd < 4; ++dd) { const float bv = bl[jj][dd] + pre[dd]; qv[dd] = qf[dd] * __expf(bv); kv[dd] = (1.f - __expf(lfv[jj][dd])) * __expf(-bv); }
        const int o = i * 256 + (((d0 >> 3) ^ (i & 15)) << 4) + (d0 & 7) * 2;
        *(uint2*)(QP + o) = make_uint2(pack2(qv[0], qv[1]), pack2(qv[2], qv[3]));
        *(uint2*)(KP + o) = make_uint2(pack2(kv[0], kv[1]), pack2(kv[2], kv[3]));
      }
    }
    {
      uint4 vq[4];
#pragma unroll
      for (int q = 0; q < 4; ++q) vq[q] = *(const uint4*)(Vg + tb + 8 * q);
      *(uint4*)(VT + off128(d0 + 0, jr)) = make_uint4((vq[0].x & 0xffffu) | (vq[0].z << 16), (vq[1].x & 0xffffu) | (vq[1].z << 16), (vq[2].x & 0xffffu) | (vq[2].z << 16), (vq[3].x & 0xffffu) | (vq[3].z << 16));
      *(uint4*)(VT + off128(d0 + 1, jr)) = make_uint4((vq[0].x >> 16) | (vq[0].z & 0xffff0000u), (vq[1].x >> 16) | (vq[1].z & 0xffff0000u), (vq[2].x >> 16) | (vq[2].z & 0xffff0000u), (vq[3].x >> 16) | (vq[3].z & 0xffff0000u));
      *(uint4*)(VT + off128(d0 + 2, jr)) = make_uint4((vq[0].y & 0xffffu) | (vq[0].w << 16), (vq[1].y & 0xffffu) | (vq[1].w << 16), (vq[2].y & 0xffffu) | (vq[2].w << 16), (vq[3].y & 0xffffu) | (vq[3].w << 16));
      *(uint4*)(VT + off128(d0 + 3, jr)) = make_uint4((vq[0].y >> 16) | (vq[0].w & 0xffff0000u), (vq[1].y >> 16) | (vq[1].w & 0xffff0000u), (vq[2].y >> 16) | (vq[2].w & 0xffff0000u), (vq[3].y >> 16) | (vq[3].w & 0xffff0000u));
    }
    __syncthreads();
    const int it = w & 1, eh = w >> 1;
    f32x16 pt0, pt1;
#pragma unroll
    for (int r = 0; r < 16; ++r) { pt0[r] = 0.f; pt1[r] = 0.f; }
#pragma unroll
    for (int kk = 0; kk < 8; ++kk) {
      const bf16x8 bq = *(const bf16x8*)(QP + off256(it * 32 + l31, 2 * kk + half));
      const bf16x8 a0 = *(const bf16x8*)(KP + off256(l31, 2 * kk + half));
      pt0 = MFMA32(a0, bq, pt0);
      if (it) {
        const bf16x8 a1 = *(const bf16x8*)(KP + off256(32 + l31, 2 * kk + half));
        pt1 = MFMA32(a1, bq, pt1);
      }
    }
    if (it == 0) {
#pragma unroll
      for (int r = 0; r < 16; ++r) if (crow(r, half) > l31) pt0[r] = 0.f;
    } else {
#pragma unroll
      for (int r = 0; r < 16; ++r) if (crow(r, half) > l31) pt1[r] = 0.f;
    }
    bf16x8 pf[2][2];
#pragma unroll
    for (int s = 0; s < 2; ++s) {
      uint4 u0 = make_uint4(pack2(pt0[8 * s], pt0[8 * s + 1]), pack2(pt0[8 * s + 2], pt0[8 * s + 3]), pack2(pt0[8 * s + 4], pt0[8 * s + 5]), pack2(pt0[8 * s + 6], pt0[8 * s + 7]));
      uint4 u1 = make_uint4(pack2(pt1[8 * s], pt1[8 * s + 1]), pack2(pt1[8 * s + 2], pt1[8 * s + 3]), pack2(pt1[8 * s + 4], pt1[8 * s + 5]), pack2(pt1[8 * s + 6], pt1[8 * s + 7]));
      pf[0][s] = __builtin_bit_cast(bf16x8, u0);
      pf[1][s] = __builtin_bit_cast(bf16x8, u1);
    }
    f32x16 acc[2];
#pragma unroll
    for (int i = 0; i < 2; ++i)
#pragma unroll
      for (int r = 0; r < 16; ++r) acc[i][r] = 0.f;
#pragma unroll
    for (int ee = 0; ee < 2; ++ee) {
      const int e = (eh * 2 + ee) * 32 + l31;
#pragma unroll
      for (int jt = 0; jt < 2; ++jt) {
        if (jt <= it) {
#pragma unroll
          for (int s = 0; s < 2; ++s) {
            const int cA = 4 * jt + 2 * s;
            const uint2 lo = *(const uint2*)(VT + off128(e, cA) + 8 * half);
            const uint2 hi = *(const uint2*)(VT + off128(e, cA + 1) + 8 * half);
            const bf16x8 av = __builtin_bit_cast(bf16x8, make_uint4(lo.x, lo.y, hi.x, hi.y));
            acc[ee] = MFMA32(av, pf[jt][s], acc[ee]);
          }
        }
      }
    }
    __syncthreads();
    {
#pragma unroll
      for (int j = 0; j < 8; ++j) {
        const int id = tid + 256 * j, e = id >> 4, cc = id & 15;
        *(u32x4*)(STs + off256(e, cc)) = stq[j];
      }
    }
    __syncthreads();
#pragma unroll
    for (int kk = 0; kk < 8; ++kk) {
      const bf16x8 bq = *(const bf16x8*)(QP + off256(it * 32 + l31, 2 * kk + half));
#pragma unroll
      for (int ee = 0; ee < 2; ++ee) {
        const bf16x8 as = *(const bf16x8*)(STs + off256((eh * 2 + ee) * 32 + l31, 2 * kk + half));
        acc[ee] = MFMA32(as, bq, acc[ee]);
      }
    }
    float ssq = 0.f;
#pragma unroll
    for (int ee = 0; ee < 2; ++ee)
#pragma unroll
      for (int r = 0; r < 16; ++r) ssq += acc[ee][r] * acc[ee][r];
    ssq += __shfl_xor(ssq, 32);
    if (half == 0) red[w * 32 + l31] = ssq;
    __syncthreads();
    const float rn = rsqrtf((red[w * 32 + l31] + red[(w ^ 2) * 32 + l31]) * (1.f / 128.f) + EPS);
    const int t = t0 + it * 32 + l31;
#pragma unroll
    for (int ee = 0; ee < 2; ++ee)
#pragma unroll
      for (int g = 0; g < 4; ++g) {
        const int e0 = (eh * 2 + ee) * 32 + 8 * g + 4 * half;
        const size_t o = (size_t)t * 1024 + h * 128 + e0;
        const uint2 gg = make_uint2(ggq[ee][g][0], ggq[ee][g][1]);
        const float4 og = *(const float4*)(p.hgrn_out_norm + e0);
        const float v0 = acc[ee][4 * g] * rn * og.x * bflo(gg.x), v1 = acc[ee][4 * g + 1] * rn * og.y * bfhi(gg.x);
        const float v2 = acc[ee][4 * g + 2] * rn * og.z * bflo(gg.y), v3 = acc[ee][4 * g + 3] * rn * og.w * bfhi(gg.y);
        *(uint2*)(OG + tiledA(t, h * 128 + e0, 1024)) = make_uint2(pack2(v0, v1), pack2(v2, v3));
      }
    __syncthreads();
  }
}

struct XcdSlot { int part0, pstride, rank, cnt; };
DI XcdSlot xcd_slot(const Params& p, unsigned myrank) {
  const unsigned* census = (const unsigned*)(p.ws + OFF_CENSUS);
  const unsigned myx = (unsigned)__builtin_amdgcn_s_getreg((3 << 11) | 20) & 0xFu;
  int nx = 0, ix = 0, cnt = 1;
#pragma unroll
  for (int j = 0; j < 16; ++j) {
    const unsigned c = __builtin_amdgcn_readfirstlane(census[j]);
    if (c) { if ((unsigned)j == myx) { ix = nx; cnt = (int)c; } ++nx; }
  }
  XcdSlot sl; sl.part0 = ix; sl.pstride = nx > 0 ? nx : 1; sl.rank = (int)myrank; sl.cnt = cnt;
  return sl;
}

DI void peer_s1(const Params& p, int layer, const XcdSlot sl) {
  const int tid = opaque_tid(), lane = tid & 63, w = tid >> 6;
  unsigned char* ws = p.ws;
  const int* EX = (const int*)(ws + OFF_EX);
  const unsigned char* U8 = ws + (layer ? OFF_UV1 : OFF_UV0);
  const u16* HB = (const u16*)(ws + OFF_HBT);
  float* ZP = (float*)(ws + OFF_ZP);
  const int c8 = lane & 7, rg = lane >> 3;
  const bool b2 = (lane & 4) != 0, b1 = (lane & 2) != 0, b0 = (lane & 1) != 0;
  const int first = sl.rank * 4 + w, stride = sl.cnt * 4;
  const int nT = (T_TOK - first + stride - 1) / stride;
  const int nparts = (8 - sl.part0 + sl.pstride - 1) / sl.pstride;
  const int total = nT * nparts;
  if (total <= 0) return;
#define Z1_ITEM(IT, X, T) do { int it_ = (IT) < total ? (IT) : total - 1; const int xi_ = it_ / nT; X = sl.part0 + xi_ * sl.pstride; T = first + (it_ - xi_ * nT) * stride; } while (0)
#define Z1_LOAD_EH(EV, H0, H1, X, T) do { _Pragma("unroll") for (int q = 0; q < 4; ++q) { \
      const int4 e4 = *(const int4*)(EX + (size_t)(T) * 128 + rg * 16 + 4 * q); EV[4 * q] = e4.x; EV[4 * q + 1] = e4.y; EV[4 * q + 2] = e4.z; EV[4 * q + 3] = e4.w; } \
      H0 = *(const uint4*)(HB + tiledA((T), (X) * 128 + c8 * 16, 1024)); H1 = *(const uint4*)(HB + tiledA((T), (X) * 128 + c8 * 16 + 8, 1024)); } while (0)
#define Z1_LOAD_ROWS(EV, X) do { const unsigned char* ub_ = U8 + (size_t)(X) * 16384 * 128 + c8 * 16; \
      _Pragma("unroll") for (int j = 0; j < 16; ++j) q8[j] = *(const uint4*)(ub_ + (size_t)EV[j] * 128); } while (0)
  int evA[16], evB[16]; uint4 hA0, hA1, hB0, hB1;
  uint4 q8[16];
  int xC, tC, xN, tN, x2, t2;
  Z1_ITEM(0, xC, tC);
  Z1_LOAD_EH(evA, hA0, hA1, xC, tC);
  Z1_LOAD_ROWS(evA, xC);
  Z1_ITEM(1, xN, tN);
  Z1_LOAD_EH(evB, hB0, hB1, xN, tN);
#define Z1_BODY(EVC, HC0, HC1, EVN, IT) do { \
    f32x2 hf[8]; \
    { const unsigned hw[8] = {HC0.x, HC0.y, HC0.z, HC0.w, HC1.x, HC1.y, HC1.z, HC1.w}; \
      _Pragma("unroll") for (int k = 0; k < 8; ++k) { hf[k][0] = bflo(hw[k]); hf[k][1] = bfhi(hw[k]); } } \
    float pz[16]; \
    _Pragma("unroll") for (int j = 0; j < 16; ++j) { \
      const unsigned wd[4] = {q8[j].x, q8[j].y, q8[j].z, q8[j].w}; \
      f32x2 a2 = {0.f, 0.f}; \
      _Pragma("unroll") for (int d = 0; d < 4; ++d) { \
        const f32x2 lo = __builtin_amdgcn_cvt_pk_f32_fp8((int)wd[d], false), hi = __builtin_amdgcn_cvt_pk_f32_fp8((int)wd[d], true); \
        a2 = __builtin_elementwise_fma(lo, hf[2 * d], a2); a2 = __builtin_elementwise_fma(hi, hf[2 * d + 1], a2); } \
      pz[j] = a2[0] + a2[1]; } \
      \
    float r1[8], r2[4], r3[2]; \
    _Pragma("unroll") for (int i = 0; i < 8; ++i) { const float send = b2 ? pz[i] : pz[8 + i], mine = b2 ? pz[8 + i] : pz[i]; r1[i] = mine + __shfl_xor(send, 4); } \
    _Pragma("unroll") for (int i = 0; i < 4; ++i) { const float send = b1 ? r1[i] : r1[4 + i], mine = b1 ? r1[4 + i] : r1[i]; r2[i] = mine + __shfl_xor(send, 2); } \
    _Pragma("unroll") for (int i = 0; i < 2; ++i) { const float send = b0 ? r2[i] : r2[2 + i], mine = b0 ? r2[2 + i] : r2[i]; r3[i] = mine + __shfl_xor(send, 1); } \
      \
    Z1_LOAD_ROWS(EVN, xN); \
    Z1_ITEM((IT) + 2, x2, t2); \
    Z1_LOAD_EH(EVC, HC0, HC1, x2, t2); \
      \
    *(float2*)(ZP + ((size_t)xC * T_TOK + tC) * 128 + rg * 16 + 2 * c8) = make_float2(r3[0], r3[1]); \
    xC = xN; tC = tN; xN = x2; tN = t2; } while (0)
  for (int it = 0; it < total; it += 2) {
    Z1_BODY(evA, hA0, hA1, evB, it);
    if (it + 1 < total) Z1_BODY(evB, hB0, hB1, evA, it + 1);
  }
#undef Z1_BODY
#undef Z1_ITEM
#undef Z1_LOAD_EH
#undef Z1_LOAD_ROWS
}

DI void peer_zmerge(const Params& p, int layer, const float* ss_in) {
  unsigned char* ws = p.ws;
  const int* EX = (const int*)(ws + OFF_EX);
  const float* GT = (const float*)(ws + OFF_GT);
  const float* ZP = (const float*)(ws + OFF_ZP);
  const float2* SC = (const float2*)(ws + (layer ? OFF_SC1 : OFF_SC0));
  float* ACT = (float*)(ws + OFF_ACT);
  for (int i4 = blockIdx.x * NTHREADS + opaque_tid(); i4 < T_TOK * 32; i4 += gridDim.x * NTHREADS) {
    const int idx = i4 * 4, t = idx >> 7;
    float4 z = make_float4(0.f, 0.f, 0.f, 0.f);
#pragma unroll
    for (int x = 0; x < 8; ++x) { const float4 v = *(const float4*)(ZP + (size_t)x * T_TOK * 128 + idx); z.x += v.x; z.y += v.y; z.z += v.z; z.w += v.w; }
    const int4 e4 = *(const int4*)(EX + idx);
    const float4 g4 = *(const float4*)(GT + idx);
    const float2 s0 = SC[e4.x], s1 = SC[e4.y], s2 = SC[e4.z], s3 = SC[e4.w];
    const float rs = rstd_from_partials(ss_in, t);
    *(float4*)(ACT + idx) = make_float4(gelu_tanh(z.x * rs * s0.x) * g4.x * s0.y, gelu_tanh(z.y * rs * s1.x) * g4.y * s1.y,
                                        gelu_tanh(z.z * rs * s2.x) * g4.z * s2.y, gelu_tanh(z.w * rs * s3.x) * g4.w * s3.y);
  }
}

template <bool FINAL>
DI void peer_s2(const Params& p, int layer, float* ss_out, const XcdSlot sl) {
  const int tid = opaque_tid(), lane = tid & 63, w = tid >> 6;
  unsigned char* ws = p.ws;
  const int* EX = (const int*)(ws + OFF_EX);
  const float* ACT = (const float*)(ws + OFF_ACT);
  const unsigned char* V8 = ws + (layer ? OFF_UV1 : OFF_UV0) + 16 * MiB;
  u16* HBT = (u16*)(ws + OFF_HBT);
  float* out = p.out;
  float* ssd = ss_out ? ss_out : (float*)(ws + OFF_DUMMY);
  const int c8 = lane & 7, rg = lane >> 3;
  const bool b5 = (lane & 32) != 0, b4 = (lane & 16) != 0, b3 = (lane & 8) != 0;
  const int first = sl.rank * 4 + w, stride = sl.cnt * 4;
  const int nT = (T_TOK - first + stride - 1) / stride;
  const int nparts = (8 - sl.part0 + sl.pstride - 1) / sl.pstride;
  const int total = nT * nparts;
  if (total <= 0) return;
#define S2_ITEM(IT, X, T) do { int it_ = (IT) < total ? (IT) : total - 1; const int xi_ = it_ / nT; X = sl.part0 + xi_ * sl.pstride; T = first + (it_ - xi_ * nT) * stride; } while (0)
  int ev[16];
  float avX[16], avY[16];
  u32x4 qX[16], qY[16];
  unsigned hX, hY;
  int xC, tC, xN, tN, x2, t2;
#define S2_LOAD_EV(T) do { _Pragma("unroll") for (int q = 0; q < 4; ++q) { const int4 e4 = *(const int4*)(EX + (size_t)(T) * 128 + rg * 16 + 4 * q); \
      ev[4 * q] = e4.x; ev[4 * q + 1] = e4.y; ev[4 * q + 2] = e4.z; ev[4 * q + 3] = e4.w; } } while (0)
#define S2_ISSUE(Q, AV, H, X, T) do { const unsigned char* vb_ = V8 + (size_t)(X) * 16384 * 128 + c8 * 16; \
      _Pragma("unroll") for (int j = 0; j < 16; ++j) Q[j] = *(const u32x4*)(vb_ + (size_t)ev[j] * 128); \
      H = *(const unsigned*)(HBT + tiledA((T), (X) * 128 + c8 * 16 + 2 * rg, 1024)); \
      _Pragma("unroll") for (int q = 0; q < 4; ++q) { const float4 a4 = *(const float4*)(ACT + (size_t)(T) * 128 + rg * 16 + 4 * q); \
        AV[4 * q] = a4.x; AV[4 * q + 1] = a4.y; AV[4 * q + 2] = a4.z; AV[4 * q + 3] = a4.w; } } while (0)
  S2_ITEM(0, xC, tC);
  S2_LOAD_EV(tC);
  S2_ISSUE(qX, avX, hX, xC, tC);
  S2_ITEM(1, xN, tN);
  S2_LOAD_EV(tN);
#define S2_BODY(QC, AVC, HC, QN, AVN, HN, IT) do { \
    S2_ISSUE(QN, AVN, HN, xN, tN);              \
    S2_ITEM((IT) + 2, x2, t2); \
    S2_LOAD_EV(t2);                             \
    float acc[16]; \
    _Pragma("unroll") for (int i = 0; i < 16; ++i) acc[i] = 0.f; \
    _Pragma("unroll") for (int j = 0; j < 16; ++j) { \
      const f32x2 a2 = {AVC[j], AVC[j]}; \
      _Pragma("unroll") for (int d = 0; d < 4; ++d) { \
        const f32x2 lo = __builtin_amdgcn_cvt_pk_f32_fp8((int)QC[j][d], false), hi = __builtin_amdgcn_cvt_pk_f32_fp8((int)QC[j][d], true); \
        f32x2 c0 = {acc[4 * d], acc[4 * d + 1]}, c1 = {acc[4 * d + 2], acc[4 * d + 3]}; \
        c0 = __builtin_elementwise_fma(lo, a2, c0); c1 = __builtin_elementwise_fma(hi, a2, c1); \
        acc[4 * d] = c0[0]; acc[4 * d + 1] = c0[1]; acc[4 * d + 2] = c1[0]; acc[4 * d + 3] = c1[1]; } } \
      \
    float r1[8], r2[4], r3[2]; \
    _Pragma("unroll") for (int i = 0; i < 8; ++i) { const float send = b5 ? acc[i] : acc[8 + i], mine = b5 ? acc[8 + i] : acc[i]; r1[i] = mine + __shfl_xor(send, 32); } \
    _Pragma("unroll") for (int i = 0; i < 4; ++i) { const float send = b4 ? r1[i] : r1[4 + i], mine = b4 ? r1[4 + i] : r1[i]; r2[i] = mine + __shfl_xor(send, 16); } \
    _Pragma("unroll") for (int i = 0; i < 2; ++i) { const float send = b3 ? r2[i] : r2[2 + i], mine = b3 ? r2[2 + i] : r2[i]; r3[i] = mine + __shfl_xor(send, 8); } \
    const float n0 = bflo(HC) + r3[0], n1 = bfhi(HC) + r3[1]; \
    if (FINAL) *(float2*)(out + (size_t)tC * 1024 + xC * 128 + c8 * 16 + 2 * rg) = make_float2(n0, n1); \
    else { float ssq = n0 * n0 + n1 * n1; \
      _Pragma("unroll") for (int o = 32; o >= 1; o >>= 1) ssq += __shfl_xor(ssq, o); \
      *(unsigned*)(HBT + tiledA(tC, xC * 128 + c8 * 16 + 2 * rg, 1024)) = pack2(n0, n1); ssd[(size_t)tC * 8 + xC] = ssq; } \
    xC = xN; tC = tN; xN = x2; tN = t2; } while (0)
  for (int it = 0; it < total; it += 2) {
    S2_BODY(qX, avX, hX, qY, avY, hY, it);
    if (it + 1 < total) S2_BODY(qY, avY, hY, qX, avX, hX, it + 1);
  }
#undef S2_LOAD_EV
#undef S2_ISSUE
#undef S2_BODY
#undef S2_ITEM
}

constexpr int VT_STRIDE = 392;
DI void attn_phase(const Params& p, unsigned char* lds) {
  const int tid = opaque_tid(), lane = tid & 63, w = tid >> 6, l31 = lane & 31, half = lane >> 5;
  unsigned char* ws = p.ws;
  const u16* Kb = (const u16*)(ws + OFF_K);
  const u16* Vb = (const u16*)(ws + OFF_V);
  const u16* Qb = (const u16*)(ws + OFF_Q);
  u16* OGA = (u16*)(ws + OFF_OGA);
  float* LG = (float*)(ws + OFF_LG);
  const float Mx = ((const float*)(ws + OFF_MISC))[0];
  const float scale = 0.08838834764831845f;
  for (int item = blockIdx.x; item < 1536; item += gridDim.x) {
    const int qb = item & 127, rest = item >> 7, kvh = rest & 1, gi = (rest >> 1) % 3, b = rest / 6;
    const int dl = (gi == 0) ? 1 : (gi == 1 ? 4 : 16);
    const int bpr = (SEQ / dl) / 64;
    const int rho = qb / bpr, tau0 = (qb % bpr) * 64;
#pragma unroll 4
    for (int j = 0; j < 12; ++j) {
      const int id = tid + 256 * j, row = id >> 4, c = id & 15;
      const int tk = tau0 - 128 + row;
      const int tokk = rho + dl * (tk < 0 ? 0 : tk);
      *(uint4*)(lds + off256(row, c)) = *(const uint4*)(Kb + ((size_t)(b * SEQ + tokk)) * 768 + gi * 256 + kvh * 128 + c * 8);
    }
    const int r = w & 1, qh = w >> 1;
    const int tauq = tau0 + qh * 32 + l31;
    const int tq = b * SEQ + rho + dl * tauq;
    bf16x8 qf[8];
    {
      const u16* qsrc = Qb + (size_t)tq * 1536 + ((gi * 2 + kvh) * 2 + r) * 128;
#pragma unroll
      for (int kk = 0; kk < 8; ++kk) qf[kk] = *(const bf16x8*)(qsrc + (2 * kk + half) * 8);
    }
    __syncthreads();
    float lsum = 0.f;
    bf16x8 pf[5][2];
#pragma unroll
    for (int jl = 0; jl < 5; ++jl) {
      f32x16 pt;
#pragma unroll
      for (int rr = 0; rr < 16; ++rr) pt[rr] = 0.f;
#pragma unroll
      for (int kk = 0; kk < 8; ++kk) {
        const bf16x8 ak = *(const bf16x8*)(lds + off256((qh + jl) * 32 + l31, 2 * kk + half));
        pt = MFMA32(ak, qf[kk], pt);
      }
#pragma unroll
      for (int rr = 0; rr < 16; ++rr) {
        const int tk = tau0 - 128 + (qh + jl) * 32 + crow(rr, half);
        const bool valid = (tk >= 0) && (tk <= tauq) && (tk >= tauq - 128);
        const float pv = valid ? __expf(pt[rr] * scale - Mx) : 0.f;
        lsum += pv;
        pt[rr] = pv;
      }
#pragma unroll
      for (int s = 0; s < 2; ++s) {
        const uint4 u0 = make_uint4(pack2(pt[8 * s], pt[8 * s + 1]), pack2(pt[8 * s + 2], pt[8 * s + 3]),
                                    pack2(pt[8 * s + 4], pt[8 * s + 5]), pack2(pt[8 * s + 6], pt[8 * s + 7]));
        pf[jl][s] = __builtin_bit_cast(bf16x8, u0);
      }
    }
    lsum += __shfl_xor(lsum, 32);
    __syncthreads();
#pragma unroll 4
    for (int j = 0; j < 12; ++j) {
      const int id = tid + 256 * j, row = id >> 4, c = id & 15;
      const int tk = tau0 - 128 + row;
      const int tokk = rho + dl * (tk < 0 ? 0 : tk);
      const uint4 vv = *(const uint4*)(Vb + ((size_t)(b * SEQ + tokk)) * 768 + gi * 256 + kvh * 128 + c * 8);
      unsigned char* dstc = lds + (size_t)(c * 8) * VT_STRIDE + row * 2;
      *(u16*)(dstc + 0 * VT_STRIDE) = (u16)(vv.x & 0xffff); *(u16*)(dstc + 1 * VT_STRIDE) = (u16)(vv.x >> 16);
      *(u16*)(dstc + 2 * VT_STRIDE) = (u16)(vv.y & 0xffff); *(u16*)(dstc + 3 * VT_STRIDE) = (u16)(vv.y >> 16);
      *(u16*)(dstc + 4 * VT_STRIDE) = (u16)(vv.z & 0xffff); *(u16*)(dstc + 5 * VT_STRIDE) = (u16)(vv.z >> 16);
      *(u16*)(dstc + 6 * VT_STRIDE) = (u16)(vv.w & 0xffff); *(u16*)(dstc + 7 * VT_STRIDE) = (u16)(vv.w >> 16);
    }
    __syncthreads();
    f32x16 acc[4];
#pragma unroll
    for (int i = 0; i < 4; ++i)
#pragma unroll
      for (int rr = 0; rr < 16; ++rr) acc[i][rr] = 0.f;
#pragma unroll
    for (int et = 0; et < 4; ++et) {
      const unsigned char* vrow = lds + (size_t)(et * 32 + l31) * VT_STRIDE;
#pragma unroll
      for (int jl = 0; jl < 5; ++jl)
#pragma unroll
        for (int s = 0; s < 2; ++s) {
          const int j0 = (qh + jl) * 32 + 16 * s + 4 * half;
          const uint2 lo = *(const uint2*)(vrow + j0 * 2);
          const uint2 hi = *(const uint2*)(vrow + (j0 + 8) * 2);
          const bf16x8 av = __builtin_bit_cast(bf16x8, make_uint4(lo.x, lo.y, hi.x, hi.y));
          acc[et] = MFMA32(av, pf[jl][s], acc[et]);
        }
    }
    const int hd = kvh * 2 + r;
    const int tglob = tq;
    u16* od = OGA + ((size_t)gi * T_TOK + tglob) * 512 + hd * 128;
#pragma unroll
    for (int et = 0; et < 4; ++et)
#pragma unroll
      for (int g = 0; g < 4; ++g)
        *(uint2*)(od + et * 32 + 8 * g + 4 * half) = make_uint2(pack2(acc[et][4 * g], acc[et][4 * g + 1]), pack2(acc[et][4 * g + 2], acc[et][4 * g + 3]));
    if (half == 0) LG[((size_t)gi * T_TOK + tglob) * 4 + hd] = lsum;
    __syncthreads();
  }
}

DI void attn_combine(const Params& p) {
  unsigned char* ws = p.ws;
  const u16* OGA = (const u16*)(ws + OFF_OGA);
  const float* LG = (const float*)(ws + OFF_LG);
  u16* AO = (u16*)(ws + OFF_AO);
  const int nchunk = T_TOK * 512 / 8;
  for (int i = blockIdx.x * NTHREADS + opaque_tid(); i < nchunk; i += gridDim.x * NTHREADS) {
    const int t = i >> 6, c = i & 63, hd = c >> 4;
    float num[8];
#pragma unroll
    for (int k = 0; k < 8; ++k) num[k] = 0.f;
    float den = 0.f;
#pragma unroll
    for (int gi = 0; gi < 3; ++gi) {
      const uint4 v = *(const uint4*)(OGA + ((size_t)gi * T_TOK + t) * 512 + c * 8);
      num[0] += bflo(v.x); num[1] += bfhi(v.x); num[2] += bflo(v.y); num[3] += bfhi(v.y);
      num[4] += bflo(v.z); num[5] += bfhi(v.z); num[6] += bflo(v.w); num[7] += bfhi(v.w);
      den += LG[((size_t)gi * T_TOK + t) * 4 + hd];
    }
    const float inv = 1.f / den;
    *(uint4*)(AO + tiledA(t, c * 8, 512)) = make_uint4(pack2(num[0] * inv, num[1] * inv), pack2(num[2] * inv, num[3] * inv),
                                                        pack2(num[4] * inv, num[5] * inv), pack2(num[6] * inv, num[7] * inv));
  }
}

#define XB_TMO      128
#define XB_XCNT(j)  (256  + 64 * (j))
#define XB_XSUB(j)  (1280 + 64 * (j))
#define XB_XGEN(j)  (2304 + 64 * (j))
#define XB_TOP      3328
#define XB_TOPGEN   3392
#define XCD_BAR_WORDS 3456
#define XB_SPIN_CAP (1u << 18)
#define LAS __attribute__((address_space(3)))

__device__ __forceinline__ unsigned xb_ld(unsigned* p)              { return __hip_atomic_load(p, __ATOMIC_RELAXED, __HIP_MEMORY_SCOPE_AGENT); }
__device__ __forceinline__ unsigned xb_add(unsigned* p, unsigned v) { return __hip_atomic_fetch_add(p, v, __ATOMIC_RELAXED, __HIP_MEMORY_SCOPE_AGENT); }
__device__ __forceinline__ unsigned xb_xcc_id() { return (unsigned)__builtin_amdgcn_s_getreg((3 << 11) | 20) & 0xFu; }
#define XB_SPIN(cond, bar) do { unsigned _sp = 0; while (cond) { __builtin_amdgcn_s_sleep(1); \
    if ((++_sp & 255u) == 0u) { if (xb_ld(&(bar)[XB_TMO])) break; if (_sp > XB_SPIN_CAP) { atomicAdd(&(bar)[XB_TMO], 1u); break; } } } } while (0)

struct XcdBarrier {
    unsigned* bar; unsigned x;
    volatile LAS unsigned* st;
};

__device__ __forceinline__ XcdBarrier xcd_barrier_post(unsigned* bar, volatile LAS unsigned* st) {
    XcdBarrier b; b.bar = bar; b.x = xb_xcc_id(); b.st = st;
    if (threadIdx.x == 0) (void)xb_add(&bar[XB_XCNT(b.x)], 1u);
    return b;
}
__device__ __forceinline__ void xcd_barrier_complete(unsigned* bar, unsigned x, unsigned& nloc, unsigned& nx) {
    const unsigned G = gridDim.x * gridDim.y * gridDim.z;
    unsigned sum, cnt, mine, sp = 0u;
    for (;;) {
        sum = 0u; cnt = 0u; mine = 0u;
#pragma unroll
        for (unsigned j = 0; j < 16; ++j) { const unsigned c = xb_ld(&bar[XB_XCNT(j)]); sum += c; cnt += (c > 0u) ? 1u : 0u; mine = (j == x) ? c : mine; }
        if (sum == G) break;
        __builtin_amdgcn_s_sleep(1);
        if ((++sp & 255u) == 0u) { if (xb_ld(&bar[XB_TMO])) break; if (sp > XB_SPIN_CAP) { atomicAdd(&bar[XB_TMO], 1u); break; } }
    }
    nloc = mine > 0u ? mine : 1u; nx = cnt > 0u ? cnt : 1u;
}

__device__ __forceinline__ void xcd_barrier(const XcdBarrier& b) {
    asm volatile("s_waitcnt vmcnt(0)" ::: "memory");
    __syncthreads();
    if (threadIdx.x == 0) {
        unsigned* bar = b.bar;
        __builtin_amdgcn_s_waitcnt(0);
        unsigned nloc = b.st[0], nx = b.st[1];
        if (nloc == 0u) { xcd_barrier_complete(bar, b.x, nloc, nx); b.st[0] = nloc; b.st[1] = nx; }
        const unsigned old = xb_add(&bar[XB_XSUB(b.x)], 1u);
        const unsigned gen = old / nloc;
        if (old + 1u == (gen + 1u) * nloc) {
            __builtin_amdgcn_fence(__ATOMIC_RELEASE, "agent");
            asm volatile("s_waitcnt vmcnt(0)" ::: "memory");
            const unsigned og = xb_add(&bar[XB_TOP], 1u);
            const unsigned tg = og / nx;
            if (og + 1u == (tg + 1u) * nx) xb_add(&bar[XB_TOPGEN], 1u);
            else XB_SPIN(xb_ld(&bar[XB_TOPGEN]) == tg, bar);
            __builtin_amdgcn_fence(__ATOMIC_ACQUIRE, "agent");
            xb_add(&bar[XB_XGEN(b.x)], 1u);
            asm volatile("s_waitcnt vmcnt(0)" ::: "memory");
        } else {
            XB_SPIN(xb_ld(&bar[XB_XGEN(b.x)]) == gen, bar);
            __builtin_amdgcn_fence(__ATOMIC_ACQUIRE, "agent");
            asm volatile("s_waitcnt vmcnt(0)" ::: "memory");
        }
    }
    __syncthreads();
}


constexpr int N_PHASES = 18;
template <int ph>
DI void run_phase(const Params& p, unsigned char* lds, unsigned myrank) {
  unsigned char* ws = p.ws;
  switch (ph) {
    case 0: p0_prep(p, lds); break;
    case 1: {
      EpiHgrnIn e{(const float*)(ws + OFF_RSTD0), (const float*)(ws + OFF_LB), (u16*)(ws + OFF_QG), (u16*)(ws + OFF_VG), (u16*)(ws + OFF_GG), (_Float16*)(ws + OFF_LOGF)};
      gemm_phase<EpiHgrnIn, 1>(p, (const u16*)(ws + OFF_HB), 1024, (const u16*)(ws + OFF_WIN), 1024, 128, 32, 16, e, lds);
    } break;
    case 2: gla_g1(p, lds); break;
    case 3: gla_g2(p); break;
    case 4: gla_g3(p, lds); break;
    case 5: {
      EpiResidual<false> e{p.x, (u16*)(ws + OFF_HBT), (float*)(ws + OFF_SS1)};
      gemm_phase(p, (const u16*)(ws + OFF_OG), 1024, (const u16*)(ws + OFF_WOUT), 1024, 128, 8, 16, e, lds);
    } break;
    case 6: {
      EpiTopk e{(const float*)(ws + OFF_SS1), (int*)(ws + OFF_EX), (float*)(ws + OFF_GT), lds + 32768 + (opaque_tid() >> 6) * 6144};
      gemm_phase<EpiTopk, 0, true>(p, (const u16*)(ws + OFF_HBT), 1024, (const u16*)(ws + OFF_WPQ0), 1024, 128, 16, 16, e, lds);
    } break;
    case 7: peer_s1(p, 0, xcd_slot(p, myrank)); break;
    case 8: peer_zmerge(p, 0, (const float*)(ws + OFF_SS1)); break;
    case 9: peer_s2<false>(p, 0, (float*)(ws + OFF_SS2), xcd_slot(p, myrank)); break;
    case 10: {
      EpiKVQ e{(const float*)(ws + OFF_SS2), p.k_norm, p.q_norm, (const float2*)(ws + OFF_ROPE), (u16*)(ws + OFF_K), (u16*)(ws + OFF_V), (u16*)(ws + OFF_Q), lds + 32768};
      gemm_phase<EpiKVQ, 2>(p, (const u16*)(ws + OFF_HBT), 1024, (const u16*)(ws + OFF_WKVQ), 1024, 128, 24, 16, e, lds);
    } break;
    case 11: attn_phase(p, lds); break;
    case 12: attn_combine(p); break;
    case 13: {
      EpiResidual<true> e{nullptr, (u16*)(ws + OFF_HBT), (float*)(ws + OFF_SS3)};
      gemm_phase(p, (const u16*)(ws + OFF_AO), 512, (const u16*)(ws + OFF_WO), 512, 128, 8, 8, e, lds);
    } break;
    case 14: {
      EpiTopk e{(const float*)(ws + OFF_SS3), (int*)(ws + OFF_EX), (float*)(ws + OFF_GT), lds + 32768 + (opaque_tid() >> 6) * 6144};
      gemm_phase<EpiTopk, 0, true>(p, (const u16*)(ws + OFF_HBT), 1024, (const u16*)(ws + OFF_WPQ1), 1024, 128, 16, 16, e, lds);
    } break;
    case 15: peer_s1(p, 1, xcd_slot(p, myrank)); break;
    case 16: peer_zmerge(p, 1, (const float*)(ws + OFF_SS3)); break;
    case 17: peer_s2<true>(p, 1, nullptr, xcd_slot(p, myrank)); break;
    default: break;
  }
}

#if MEGA
#ifndef PROBE_MASK
#define PROBE_MASK 0
#endif
__global__ void __launch_bounds__(NTHREADS, 2) yoco_mega(Params p) {
  __shared__ __attribute__((aligned(16))) unsigned char lds[LDS_BYTES];
  __shared__ uint4 xb_words;
  if (threadIdx.x == 0) {
    const unsigned myx = (unsigned)__builtin_amdgcn_s_getreg((3 << 11) | 20) & 0xFu;
    const unsigned rk = __hip_atomic_fetch_add((unsigned*)(p.ws + OFF_CENSUS) + myx, 1u, __ATOMIC_RELAXED, __HIP_MEMORY_SCOPE_AGENT);
    xb_words = make_uint4(0u, 0u, rk, 0u);
  }
  __syncthreads();
  (void)xcd_barrier_post((unsigned*)p.ws, (volatile LAS unsigned*)&xb_words);
#define GRID_BAR() do { XcdBarrier b_; b_.bar = (unsigned*)p.ws; b_.x = xb_xcc_id(); b_.st = (volatile LAS unsigned*)&xb_words; xcd_barrier(b_); } while (0)
#define MYRANK() (((volatile unsigned*)&xb_words)[2])
#define PHASE(n) do { run_phase<n>(p, lds, MYRANK()); GRID_BAR(); if (PROBE_MASK & (1 << n)) { run_phase<n>(p, lds, MYRANK()); GRID_BAR(); } } while (0)
  PHASE(0); PHASE(1); PHASE(2); PHASE(3); PHASE(4); PHASE(5); PHASE(6); PHASE(7); PHASE(8); PHASE(9);
  PHASE(10); PHASE(11); PHASE(12); PHASE(13); PHASE(14); PHASE(15); PHASE(16);
  run_phase<17>(p, lds, MYRANK());
}
#endif

extern "C" void kernel_launch(void* const* d_in, const int* in_sizes, int n_in, void* d_out, int out_size, void* d_ws, size_t ws_size,
                              hipStream_t stream) {
  if (n_in != 18 || ws_size < WS_NEED) {
    fprintf(stderr, "kernel_launch: unexpected inputs (n_in %d, ws %zu, need %zu)\n", n_in, ws_size, (size_t)WS_NEED);
    return;
  }
  Params p{};
  p.x = (const float*)d_in[0]; p.hgrn_norm = (const float*)d_in[1]; p.hgrn_w_in = (const float*)d_in[2]; p.hgrn_lb = (const float*)d_in[3];
  p.hgrn_out_norm = (const float*)d_in[4]; p.hgrn_w_out = (const float*)d_in[5]; p.kv_norm = (const float*)d_in[6]; p.w_kv = (const float*)d_in[7];
  p.k_norm = (const float*)d_in[8]; p.attn_norm = (const float*)d_in[9]; p.w_q = (const float*)d_in[10]; p.q_norm = (const float*)d_in[11];
  p.w_o = (const float*)d_in[12]; p.ffn_norm = (const float*)d_in[13]; p.peer_w_q = (const float*)d_in[14]; p.peer_sub_keys = (const float*)d_in[15];
  p.peer_u = (const float*)d_in[16]; p.peer_v = (const float*)d_in[17];
  p.out = (float*)d_out; p.ws = (unsigned char*)d_ws;
#if MEGA
  static int grid_blocks = 0;
  if (!grid_blocks) {
    int dev = 0, cus = 0, per_cu = 0;
    (void)hipGetDevice(&dev);
    (void)hipDeviceGetAttribute(&cus, hipDeviceAttributeMultiprocessorCount, dev);
    (void)hipOccupancyMaxActiveBlocksPerMultiprocessor(&per_cu, yoco_mega, NTHREADS, 0);
    if (per_cu > 2) per_cu = 2;
    if (per_cu < 1) per_cu = 1;
    grid_blocks = cus * per_cu;
  }
  if (hipMemsetAsync(d_ws, 0, 16384, stream) != hipSuccess) { fprintf(stderr, "kernel_launch: memset of barrier words failed\n"); return; }
  void* args[] = {&p};
  hipError_t e = hipLaunchCooperativeKernel((void*)yoco_mega, dim3(grid_blocks), dim3(NTHREADS), args, 0, stream);
  if (e != hipSuccess) fprintf(stderr, "cooperative launch failed: %s (grid %d)\n", hipGetErrorString(e), grid_blocks);
#endif
}
```

```cpp
#include <hip/hip_runtime.h>
#include <hip/hip_cooperative_groups.h>
#include <cstdio>
#include <cstdint>
namespace cg = cooperative_groups;

#ifndef MEGA
#define MEGA 1
#endif

#define DI __device__ __forceinline__
typedef unsigned short u16;
typedef __attribute__((ext_vector_type(8))) short bf16x8;
typedef __attribute__((ext_vector_type(16))) float f32x16;
typedef __attribute__((ext_vector_type(2))) float f32x2;
typedef __attribute__((ext_vector_type(2))) __bf16 bf16x2_t;
typedef __attribute__((ext_vector_type(4))) unsigned u32x4;
typedef __attribute__((ext_vector_type(2))) unsigned u32x2;

#define MFMA32(a, b, c) __builtin_amdgcn_mfma_f32_32x32x16_bf16((a), (b), (c), 0, 0, 0)

constexpr int T_TOK = 16384;
constexpr int DM = 1024;
constexpr int SEQ = 8192;
constexpr float EPS = 1e-6f;
constexpr int NTHREADS = 256;
constexpr int LDS_BYTES = 65536;

constexpr size_t MiB = 1u << 20;
constexpr size_t OFF_LB = 64 * 1024;
constexpr size_t OFF_MISC = 68 * 1024;
constexpr size_t OFF_RSTD0 = 128 * 1024;
constexpr size_t OFF_SS1 = 29 * MiB;
constexpr size_t OFF_RSTD2 = 256 * 1024;
constexpr size_t OFF_SS3 = 30 * MiB;
constexpr size_t OFF_LG = 1 * MiB;
constexpr size_t OFF_ROPE = 2 * MiB;
constexpr size_t OFF_ACH = 3 * MiB;
constexpr size_t OFF_WIN = 4 * MiB;
constexpr size_t OFF_WOUT = 12 * MiB;
constexpr size_t OFF_WPQ0 = 14 * MiB;
constexpr size_t OFF_WKVQ = 18 * MiB;
constexpr size_t OFF_WO = 24 * MiB;
constexpr size_t OFF_WPQ1 = 25 * MiB;
constexpr size_t OFF_UV0 = 32 * MiB;
constexpr size_t OFF_UV1 = 64 * MiB;
constexpr size_t OFF_SC0 = 31 * MiB;
constexpr size_t OFF_SC1 = 31 * MiB + 256 * 1024;
constexpr size_t OFF_HB = 160 * MiB;
constexpr size_t OFF_QG = 192 * MiB;
constexpr size_t OFF_KG = 224 * MiB;
constexpr size_t OFF_LOGF = 256 * MiB;
constexpr size_t OFF_VG = 320 * MiB;
constexpr size_t OFF_GG = 352 * MiB;
constexpr size_t OFF_UT = 384 * MiB;
constexpr size_t OFF_OG = 448 * MiB;
constexpr size_t WS_NEED = 480 * MiB;
constexpr size_t OFF_K = 208 * MiB;
constexpr size_t OFF_V = 232 * MiB;
constexpr size_t OFF_Q = 256 * MiB;
constexpr size_t OFF_OGA = 304 * MiB;
constexpr size_t OFF_AO = 352 * MiB;
constexpr size_t OFF_EX = 368 * MiB;
constexpr size_t OFF_GT = 376 * MiB;
constexpr size_t OFF_ACT = 384 * MiB;
constexpr size_t OFF_SS2 = 30 * MiB + 512 * 1024;
constexpr size_t OFF_HBT = OFF_HB;
constexpr size_t OFF_ZP = 392 * MiB;
constexpr size_t OFF_DUMMY = 512 * 1024;
constexpr size_t OFF_CENSUS = 15 * 1024;

struct Params {
  const float *x, *hgrn_norm, *hgrn_w_in, *hgrn_lb, *hgrn_out_norm, *hgrn_w_out, *kv_norm, *w_kv, *k_norm, *attn_norm, *w_q,
      *q_norm, *w_o, *ffn_norm, *peer_w_q, *peer_sub_keys, *peer_u, *peer_v;
  float* out;
  unsigned char* ws;
};

DI int opaque_tid() { int t = threadIdx.x; asm volatile("" : "+v"(t)); return t; }
DI int crow(int r, int h) { return (r & 3) + 8 * (r >> 2) + 4 * h; }
DI unsigned pack2(float a, float b) {
  f32x2 v = {a, b};
  return __builtin_bit_cast(unsigned, __builtin_convertvector(v, bf16x2_t));
}
DI u16 f2bf(float f) { return (u16)(pack2(f, 0.f) & 0xffffu); }
DI float bf2f(u16 h) { return __uint_as_float(((unsigned)h) << 16); }
DI float bflo(unsigned u) { return __uint_as_float(u << 16); }
DI float bfhi(unsigned u) { return __uint_as_float(u & 0xffff0000u); }
DI float sigmoidf_(float v) { return 1.f / (1.f + __expf(-v)); }
DI float siluf_(float v) { return v / (1.f + __expf(-v)); }
DI float gelu_tanh(float z) {
  const float y = 0.7978845608028654f * (z + 0.044715f * z * z * z);
  const float t = 1.f - 2.f / (1.f + __expf(2.f * y));
  return 0.5f * z * (1.f + t);
}
DI size_t tiledA(int t, int col, int K) {
  return (size_t)(t >> 5) * (32 * (size_t)K) + (size_t)((((col >> 6) * 4 + ((col >> 4) & 3)) * 64 + ((col >> 3) & 1) * 32 + (t & 31)) * 8 + (col & 7));
}
DI int off128(int row, int c) { return row * 128 + ((c ^ ((row >> 1) & 7)) << 4); }
DI int off256(int row, int c) { return row * 256 + ((c ^ (row & 15)) << 4); }
DI int key_of(float f) { int k = __float_as_int(f); k ^= (k >> 31) & 0x7fffffff; return k; }
DI float val_of(int k) { k ^= (k >> 31) & 0x7fffffff; return __int_as_float(k); }
DI float rstd_from_partials(const float* ss, int m) {
  const float4 a = *(const float4*)(ss + (size_t)m * 8), b = *(const float4*)(ss + (size_t)m * 8 + 4);
  const float t = ((a.x + a.y) + (a.z + a.w)) + ((b.x + b.y) + (b.z + b.w));
  return rsqrtf(t * (1.f / 1024.f) + EPS);
}

template <int N>
DI void bitonic_sort_desc(int (&a)[N]) {
#pragma unroll
  for (int k = 2; k <= N; k <<= 1)
#pragma unroll
    for (int j = k >> 1; j > 0; j >>= 1)
#pragma unroll
      for (int i = 0; i < N; ++i) {
        const int l = i ^ j;
        if (l > i) {
          const int hi = max(a[i], a[l]), lo = min(a[i], a[l]);
          if ((i & k) == 0) { a[i] = hi; a[l] = lo; } else { a[i] = lo; a[l] = hi; }
        }
      }
}
DI void merge_top16(int (&a)[16], const int (&b)[16]) {
#pragma unroll
  for (int i = 0; i < 16; ++i) a[i] = max(a[i], b[15 - i]);
#pragma unroll
  for (int j = 8; j > 0; j >>= 1)
#pragma unroll
    for (int i = 0; i < 16; ++i) {
      const int l = i ^ j;
      if (l > i) { const int hi = max(a[i], a[l]), lo = min(a[i], a[l]); a[i] = hi; a[l] = lo; }
    }
}
#define TOPK_INSERT(a, xk) do { int _x = (xk); _Pragma("unroll") for (int _j = 0; _j < 16; ++_j) { int _t = max(a[_j], _x); _x = min(a[_j], _x); a[_j] = _t; } } while (0)

constexpr int N_TR = 1024 + 256 + 384 + 384 + 128;
constexpr int N_CP = 1024;
constexpr int N_UV = 8192;
constexpr int N_X = 512;
constexpr int N_ROPE = 512;
constexpr int N_MISC = 64;
constexpr int N_P0 = N_TR + N_CP + N_X + N_ROPE + N_MISC;

DI void p0_transpose_tile(const float* src, int N, const float* gain, u16* dst, int ld, int rowoff, int kt, int ntile, float* tile) {
  const int tid = opaque_tid();
  const int k0 = kt * 64, n0 = ntile * 64;
#pragma unroll
  for (int i = 0; i < 4; ++i) {
    const int k = i * 16 + (tid >> 4), n = (tid & 15) * 4;
    float4 v = *(const float4*)(src + (size_t)(k0 + k) * N + n0 + n);
    if (gain) { const float gk = gain[k0 + k]; v.x *= gk; v.y *= gk; v.z *= gk; v.w *= gk; }
    tile[k * 65 + n] = v.x; tile[k * 65 + n + 1] = v.y; tile[k * 65 + n + 2] = v.z; tile[k * 65 + n + 3] = v.w;
  }
  __syncthreads();
  {
    const int n = tid >> 2, kq = (tid & 3) * 16;
    unsigned pk[8];
#pragma unroll
    for (int i = 0; i < 8; ++i) pk[i] = pack2(tile[(kq + 2 * i) * 65 + n], tile[(kq + 2 * i + 1) * 65 + n]);
    uint4* d = (uint4*)(dst + (size_t)(rowoff + n0 + n) * ld + k0 + kq);
    d[0] = make_uint4(pk[0], pk[1], pk[2], pk[3]);
    d[1] = make_uint4(pk[4], pk[5], pk[6], pk[7]);
  }
  __syncthreads();
}

DI void p0_prep(const Params& p, unsigned char* lds) {
  const int tid = opaque_tid(), lane = tid & 63, w = tid >> 6;
  unsigned char* ws = p.ws;
  for (int item = blockIdx.x; item < N_P0; item += gridDim.x) {
    int it = item;
    if (it < N_TR) {
      float* tile = (float*)lds;
      if (it < 1024) p0_transpose_tile(p.hgrn_w_in, 4096, p.hgrn_norm, (u16*)(ws + OFF_WIN), 1024, 0, it / 64, it % 64, tile);
      else if (it < 1280) { it -= 1024; p0_transpose_tile(p.hgrn_w_out, 1024, nullptr, (u16*)(ws + OFF_WOUT), 1024, 0, it / 16, it % 16, tile); }
      else if (it < 1664) { it -= 1280; p0_transpose_tile(p.w_kv, 1536, p.kv_norm, (u16*)(ws + OFF_WKVQ), 1024, 0, it / 24, it % 24, tile); }
      else if (it < 2048) { it -= 1664; p0_transpose_tile(p.w_q, 1536, p.attn_norm, (u16*)(ws + OFF_WKVQ), 1024, 1536, it / 24, it % 24, tile); }
      else { it -= 2048; p0_transpose_tile(p.w_o, 1024, nullptr, (u16*)(ws + OFF_WO), 512, 0, it / 16, it % 16, tile); }
      continue;
    }
    it -= N_TR;
    if (it < N_CP) {
      const int l = it >> 9, rem = it & 511, h = rem >> 6, wsel = (rem >> 5) & 1, nh = (rem >> 4) & 1;
      const int c0 = (rem & 15) * 64;
      float* Ws = (float*)lds;
      float* Ks = (float*)(lds + 64 * 65 * 4);
      const float* keys = p.peer_sub_keys + ((size_t)(l * 2 + wsel) * 128 + nh * 64) * 128;
      const float* Wp = p.peer_w_q + (size_t)l * 1024 * 2048 + (size_t)c0 * 2048 + h * 256 + wsel * 128;
      const int ci = w & 1, ni = w >> 1, r31 = lane & 31, kh = lane >> 5;
      f32x16 acc;
#pragma unroll
      for (int r = 0; r < 16; ++r) acc[r] = 0.f;
      for (int ps = 0; ps < 2; ++ps) {
#pragma unroll 4
        for (int i = 0; i < 16; ++i) {
          const int idx = tid + 256 * i, rr = idx >> 6, d = idx & 63;
          Ws[rr * 65 + d] = Wp[(size_t)rr * 2048 + ps * 64 + d] * p.ffn_norm[l * 1024 + c0 + rr];
          Ks[rr * 65 + d] = keys[rr * 128 + ps * 64 + d];
        }
        __syncthreads();
#pragma unroll 8
        for (int s2 = 0; s2 < 32; ++s2)
          acc = __builtin_amdgcn_mfma_f32_32x32x2f32(Ws[(ci * 32 + r31) * 65 + 2 * s2 + kh], Ks[(ni * 32 + r31) * 65 + 2 * s2 + kh], acc, 0, 0, 0);
        __syncthreads();
      }
      u16* dst = (u16*)(ws + (l ? OFF_WPQ1 : OFF_WPQ0)) + (size_t)(h * 256 + wsel * 128 + nh * 64 + ni * 32 + r31) * 1024 + c0 + ci * 32;
#pragma unroll
      for (int g = 0; g < 4; ++g) *(uint2*)(dst + 8 * g + 4 * kh) = make_uint2(pack2(acc[4 * g], acc[4 * g + 1]), pack2(acc[4 * g + 2], acc[4 * g + 3]));
      continue;
    }
    it -= N_CP;
    if (it < N_X) {
      float* xt = (float*)lds;
      const int t0 = it * 32;
      u16* dst = (u16*)(ws + OFF_HB) + (size_t)it * 32768;
      float ssr[8];
#pragma unroll
      for (int i = 0; i < 8; ++i) ssr[i] = 0.f;
      typedef float v4f __attribute__((ext_vector_type(4)));
      v4f xa[8], xb[8];
#define X_LOAD(R, CH) do { _Pragma("unroll") for (int i = 0; i < 8; ++i) R[i] = *(const v4f*)(p.x + (size_t)(t0 + w + 4 * i) * 1024 + (CH) * 256 + lane * 4); } while (0)
#define X_CHUNK(R, CH) do { \
        _Pragma("unroll") for (int i = 0; i < 8; ++i) { ssr[i] += R[i][0] * R[i][0] + R[i][1] * R[i][1] + R[i][2] * R[i][2] + R[i][3] * R[i][3]; *(v4f*)(xt + (w + 4 * i) * 260 + lane * 4) = R[i]; } \
        __syncthreads(); \
        _Pragma("unroll") for (int sl = 0; sl < 4; ++sl) {     \
          const int slot = w * 4 + sl, l31 = lane & 31, hf = lane >> 5; \
          const float4 v0 = *(const float4*)(xt + l31 * 260 + slot * 16 + hf * 8), v1 = *(const float4*)(xt + l31 * 260 + slot * 16 + hf * 8 + 4); \
          *(uint4*)(dst + (size_t)(((CH) * 16 + slot) * 64 + lane) * 8) = make_uint4(pack2(v0.x, v0.y), pack2(v0.z, v0.w), pack2(v1.x, v1.y), pack2(v1.z, v1.w)); } \
        __syncthreads(); } while (0)
      X_LOAD(xa, 0);
      X_LOAD(xb, 1);
      X_CHUNK(xa, 0);
      X_LOAD(xa, 2);
      X_CHUNK(xb, 1);
      X_LOAD(xb, 3);
      X_CHUNK(xa, 2);
      X_CHUNK(xb, 3);
#undef X_LOAD
#undef X_CHUNK
#pragma unroll
      for (int i = 0; i < 8; ++i) {
        float ss = ssr[i];
#pragma unroll
        for (int o = 32; o >= 1; o >>= 1) ss += __shfl_xor(ss, o);
        if (lane == 0) ((float*)(ws + OFF_RSTD0))[t0 + w + 4 * i] = rsqrtf(ss * (1.f / 1024.f) + EPS);
      }
      continue;
    }
    it -= N_X;
    if (it < N_ROPE) {
      const int idx = it * 256 + tid; const int pos = idx >> 4, i = idx & 15;
      const float inv = powf(500000.f, -(float)i * (1.f / 16.f));
      const float ang = (float)pos * inv;
      float s, c; sincosf(ang, &s, &c);
      ((float2*)(ws + OFF_ROPE))[idx] = make_float2(c, s);
      continue;
    }
    it -= N_ROPE;
    {
      const int idx = it * 256 + tid;
      if (idx < 1024) {
        const float l0 = p.hgrn_lb[idx], l1 = p.hgrn_lb[1024 + idx];
        ((float*)(ws + OFF_LB))[idx] = 1.f / (1.f + __expf(l1 - l0));
      }
      if (idx == 0) {
        float mq = 0.f, mk = 0.f;
        for (int i = 0; i < 128; ++i) { mq = fmaxf(mq, fabsf(p.q_norm[i])); mk = fmaxf(mk, fabsf(p.k_norm[i])); }
        ((float*)(ws + OFF_MISC))[0] = 11.313708499f * mq * mk;
      }
    }
  }
}

DI void peer_tables(const Params& p, int l, int ibeg, int iend) {
  const int tid = opaque_tid(), lane = tid & 63, w = tid >> 6;
  unsigned char* ws = p.ws;
  for (int i = ibeg; i < iend; ++i) {
    const int e = (int)(blockIdx.x * 4 + w) + (int)(gridDim.x * 4) * i;
    if (e >= 16384) break;
    const float* su = p.peer_u + ((size_t)l * 16384 + e) * 1024 + lane * 4;
    const float* sv = p.peer_v + ((size_t)l * 16384 + e) * 1024 + lane * 4;
    const float* g = p.ffn_norm + l * 1024 + lane * 4;
    float uu[16], vv[16];
#pragma unroll
    for (int k = 0; k < 4; ++k) {
      const float4 a = *(const float4*)(su + 256 * k); const float4 gg = *(const float4*)(g + 256 * k); const float4 bq = *(const float4*)(sv + 256 * k);
      uu[4 * k] = a.x * gg.x; uu[4 * k + 1] = a.y * gg.y; uu[4 * k + 2] = a.z * gg.z; uu[4 * k + 3] = a.w * gg.w;
      vv[4 * k] = bq.x; vv[4 * k + 1] = bq.y; vv[4 * k + 2] = bq.z; vv[4 * k + 3] = bq.w;
    }
    float mu = 0.f, mv = 0.f;
#pragma unroll
    for (int k = 0; k < 16; ++k) { mu = fmaxf(mu, fabsf(uu[k])); mv = fmaxf(mv, fabsf(vv[k])); }
#pragma unroll
    for (int o = 32; o >= 1; o >>= 1) { mu = fmaxf(mu, __shfl_xor(mu, o)); mv = fmaxf(mv, __shfl_xor(mv, o)); }
    const float scu = mu > 0.f ? mu * (1.f / 448.f) : 1.f, scv = mv > 0.f ? mv * (1.f / 448.f) : 1.f;
    const float iu = 1.f / scu, iv = 1.f / scv;
    unsigned char* base = ws + (l ? OFF_UV1 : OFF_UV0);
#pragma unroll
    for (int k = 0; k < 4; ++k) {
      int pk = 0;
      pk = __builtin_amdgcn_cvt_pk_fp8_f32(uu[4 * k] * iu, uu[4 * k + 1] * iu, pk, false);
      pk = __builtin_amdgcn_cvt_pk_fp8_f32(uu[4 * k + 2] * iu, uu[4 * k + 3] * iu, pk, true);
      int pv = 0;
      pv = __builtin_amdgcn_cvt_pk_fp8_f32(vv[4 * k] * iv, vv[4 * k + 1] * iv, pv, false);
      pv = __builtin_amdgcn_cvt_pk_fp8_f32(vv[4 * k + 2] * iv, vv[4 * k + 3] * iv, pv, true);
      const size_t off = ((size_t)(2 * k + (lane >> 5)) * 16384 + e) * 128 + (lane & 31) * 4;
      *(int*)(base + off) = pk;
      *(int*)(base + 16 * MiB + off) = pv;
    }
    if (lane == 0) ((float2*)(ws + (l ? OFF_SC1 : OFF_SC0)))[e] = make_float2(scu, scv);
  }
}

template <class Epi, int SIDE = 0, bool PAIR = false>
DI void gemm_phase(const Params& p, const u16* __restrict__ A, int lda, const u16* __restrict__ Bt, int ldb, int MT, int NT, int nk, Epi& epi, unsigned char* lds) {
  const int ntl = 0;
  const int nrw = (16384 + (int)gridDim.x * 4 - 1) / ((int)gridDim.x * 4);
  int seq = 0;
  const bool side_first = SIDE && (blockIdx.x * 2 >= gridDim.x);
  if (side_first) peer_tables(p, SIDE - 1, 0, nrw);
  const int Gx = (int)gridDim.x, bxx = (int)blockIdx.x;
  const bool two = Gx >= 2;
  const int Gl = two ? (Gx + 1) >> 1 : Gx;
  const bool upper = two && bxx >= Gl;
  const int NU = PAIR ? NT / 2 : NT;
  const int NH = two ? (upper ? NU - (NU >> 1) : (NU >> 1)) : NU;
  const int ubase = upper ? (NU >> 1) : 0;
  const int ustride = upper ? Gx - Gl : Gl;
  for (int u = upper ? bxx - Gl : bxx; u < MT * NH; u += ustride)
  for (int sub = 0; sub < (PAIR ? 2 : 1); ++sub) {
    const int mt = u / NH, unit = (u - mt * NH) + ubase;
    const int tid = opaque_tid(), lane = tid & 63, w = tid >> 6, l31 = lane & 31, half = lane >> 5;
    const int goffB0 = (tid >> 3) * ldb + (tid & 7) * 8;
    const int loffB0 = off128(tid >> 3, tid & 7);
    const int goffA = w * 32 * lda + lane * 8;
    const int lrowF = l31 * 128, lxF = (half ^ ((l31 >> 1) & 7)) << 4;
    const int nt = PAIR ? 2 * unit + sub : unit;
    const int m0 = mt * 128, n0 = nt * 128;
    f32x16 acc[4];
#pragma unroll
    for (int i = 0; i < 4; ++i)
#pragma unroll
      for (int r = 0; r < 16; ++r) acc[i][r] = 0.f;
    const u16* Ab = A + (size_t)m0 * lda + goffA;
    const u16* Bb = Bt + (size_t)n0 * ldb;
    bf16x8 aR[2][4];
    u32x4 bR[4][4];
#define LOAD_A(slot, ks) do { _Pragma("unroll") for (int kk = 0; kk < 4; ++kk) aR[slot][kk] = *(const bf16x8*)(Ab + ((ks) * 4 + kk) * 512); } while (0)
#define LOAD_B(slot, ks) do { _Pragma("unroll") for (int j = 0; j < 4; ++j) bR[slot][j] = *(const u32x4*)(Bb + goffB0 + j * 32 * ldb + (ks) * 64); } while (0)
#define STORE_B(slot, buf) do { _Pragma("unroll") for (int j = 0; j < 4; ++j) *(u32x4*)(lds + (buf) * 16384 + loffB0 + j * 4096) = bR[slot][j]; } while (0)
#define GEMM_STEP(ks, sa, sb) do { \
      const unsigned char* base_ = lds + ((sa) & 1) * 16384; \
      _Pragma("unroll") for (int kk = 0; kk < 4; ++kk) { \
        _Pragma("unroll") for (int n4 = 0; n4 < 4; ++n4) { \
          const bf16x8 wf = *(const bf16x8*)(base_ + n4 * 4096 + lrowF + (lxF ^ (kk << 5))); \
          acc[n4] = MFMA32(wf, aR[(sa) & 1][kk], acc[n4]); } } \
      if ((ks) + 2 < nk) LOAD_A((sa) & 1, (ks) + 2); \
      if ((ks) + 1 < nk) STORE_B(sb, (sb) & 1); \
      if ((ks) + 5 < nk) LOAD_B(sb, (ks) + 5); \
      __syncthreads(); } while (0)
    LOAD_B(0, 0); LOAD_B(1, 1); LOAD_B(2, 2); LOAD_B(3, 3);
    LOAD_A(0, 0); LOAD_A(1, 1);
    STORE_B(0, 0);
    LOAD_B(0, 4);
    __syncthreads();
#pragma unroll 1
    for (int ks = 0; ks < nk; ks += 4) {
      GEMM_STEP(ks, 0, 1);
      GEMM_STEP(ks + 1, 1, 2);
      GEMM_STEP(ks + 2, 2, 3);
      GEMM_STEP(ks + 3, 3, 0);
    }
    epi(acc, m0 + w * 32 + l31, n0, half);
    ++seq;
  }
  if (SIDE && !side_first) peer_tables(p, SIDE - 1, 0, nrw);
  (void)ntl; (void)seq;
#undef LOAD_A
#undef LOAD_B
#undef STORE_B
#undef GEMM_STEP
}

template <class Epi, int SIDE = 0>
DI void gemm_phase64(const Params& p, const u16* __restrict__ A, int lda, const u16* __restrict__ Bt, int ldb, int MT, int NT, int nk, Epi& epi, unsigned char* lds) {
  const int nrw = (16384 + (int)gridDim.x * 4 - 1) / ((int)gridDim.x * 4);
  const bool side_first = SIDE && (blockIdx.x * 2 >= gridDim.x);
  if (side_first) peer_tables(p, SIDE - 1, 0, nrw);
  const int Gx = (int)gridDim.x, bxx = (int)blockIdx.x;
  const bool two = Gx >= 2;
  const int Gl = two ? (Gx + 1) >> 1 : Gx;
  const bool upper = two && bxx >= Gl;
  const int NH = two ? (upper ? NT - (NT >> 1) : (NT >> 1)) : NT;
  const int ubase = upper ? (NT >> 1) : 0;
  const int ustride = upper ? Gx - Gl : Gl;
  for (int u = upper ? bxx - Gl : bxx; u < MT * NH; u += ustride) {
    const int mt = u / NH, nt = (u - mt * NH) + ubase;
    const int tid = opaque_tid(), lane = tid & 63, w = tid >> 6, l31 = lane & 31, half = lane >> 5;
    const int goffB0 = (tid >> 3) * ldb + (tid & 7) * 8;
    const int loffB0 = off128(tid >> 3, tid & 7);
    const int goffA = w * 64 * lda + lane * 8;
    const int lrowF = l31 * 128, lxF = (half ^ ((l31 >> 1) & 7)) << 4;
    const int m0 = mt * 256, n0 = nt * 128;
    f32x16 acc0[4], acc1[4];
#pragma unroll
    for (int i = 0; i < 4; ++i)
#pragma unroll
      for (int r = 0; r < 16; ++r) { acc0[i][r] = 0.f; acc1[i][r] = 0.f; }
    const u16* Ab = A + (size_t)m0 * lda + goffA;
    const u16* Ab1 = Ab + 32 * lda;
    const u16* Bb = Bt + (size_t)n0 * ldb;
    bf16x8 aR0[4], aR1[4];
    u32x4 bR[2][4];
#define LOAD_B64(slot, ks) do { _Pragma("unroll") for (int j = 0; j < 4; ++j) bR[slot][j] = *(const u32x4*)(Bb + goffB0 + j * 32 * ldb + (ks) * 64); } while (0)
#define STORE_B64(slot, buf) do { _Pragma("unroll") for (int j = 0; j < 4; ++j) *(u32x4*)(lds + (buf) * 16384 + loffB0 + j * 4096) = bR[slot][j]; } while (0)
#define STEP64(ks, buf, st) do { \
      const unsigned char* base_ = lds + (buf) * 16384; \
      const int kn_ = min((ks) + 1, nk - 1), kb_ = min((ks) + 3, nk - 1); \
      _Pragma("unroll") for (int kk = 0; kk < 4; ++kk) { \
        _Pragma("unroll") for (int n4 = 0; n4 < 4; ++n4) { \
          const bf16x8 wf = *(const bf16x8*)(base_ + n4 * 4096 + lrowF + (lxF ^ (kk << 5))); \
          acc0[n4] = MFMA32(wf, aR0[kk], acc0[n4]); \
          acc1[n4] = MFMA32(wf, aR1[kk], acc1[n4]); } \
        aR0[kk] = *(const bf16x8*)(Ab + (kn_ * 4 + kk) * 512); \
        aR1[kk] = *(const bf16x8*)(Ab1 + (kn_ * 4 + kk) * 512); } \
      STORE_B64(st, (buf) ^ 1); \
      LOAD_B64(st, kb_); \
      __syncthreads(); } while (0)
    LOAD_B64(0, 0); LOAD_B64(1, 1);
#pragma unroll
    for (int kk = 0; kk < 4; ++kk) { aR0[kk] = *(const bf16x8*)(Ab + kk * 512); aR1[kk] = *(const bf16x8*)(Ab1 + kk * 512); }
    STORE_B64(0, 0);
    LOAD_B64(0, min(2, nk - 1));
    __syncthreads();
#pragma unroll 1
    for (int ks = 0; ks < nk; ks += 2) {
      STEP64(ks, 0, 1);
      STEP64(ks + 1, 1, 0);
    }
    epi(acc0, m0 + w * 64 + l31, n0, half);
    epi(acc1, m0 + w * 64 + 32 + l31, n0, half);
  }
  if (SIDE && !side_first) peer_tables(p, SIDE - 1, 0, nrw);
#undef LOAD_B64
#undef STORE_B64
#undef STEP64
}

struct EpiNull {
  DI void operator()(f32x16 (&acc)[4], int m, int n0, int half) const {
#pragma unroll
    for (int i = 0; i < 4; ++i)
#pragma unroll
      for (int r = 0; r < 16; ++r) asm volatile("" :: "v"(acc[i][r]));
  }
};
struct EpiHgrnIn {
  const float* rstd; const float* lb; u16 *Qg, *Vg, *Gg; _Float16* LOGF;
  DI void operator()(f32x16 (&acc)[4], int m, int n0, int half) const {
    const float rs = rstd[m];
    const int sec = n0 >> 10, colb = n0 & 1023;
    const int pos = m & (SEQ - 1);
    const size_t tb0 = ((size_t)(((m >> 13) * 8 + (colb >> 7)) * 128 + (pos >> 6))) * 8192 + (size_t)(pos & 63) * 4;
#pragma unroll
    for (int n4 = 0; n4 < 4; ++n4)
#pragma unroll
      for (int g = 0; g < 4; ++g) {
        const int dl = n4 * 32 + 8 * g + 4 * half;
        const size_t to = tb0 + (size_t)(dl >> 2) * 256;
        float v[4];
#pragma unroll
        for (int j = 0; j < 4; ++j) v[j] = acc[n4][4 * g + j] * rs;
        if (sec == 0) {
          *(uint2*)(Qg + to) = make_uint2(pack2(siluf_(v[0]), siluf_(v[1])), pack2(siluf_(v[2]), siluf_(v[3])));
        } else if (sec == 1) {
          const float4 lbv = *(const float4*)(lb + colb + dl);
          const float lbs[4] = {lbv.x, lbv.y, lbv.z, lbv.w};
          typedef _Float16 h4 __attribute__((ext_vector_type(4)));
          h4 lf;
#pragma unroll
          for (int j = 0; j < 4; ++j) lf[j] = (_Float16)__logf(lbs[j] + (1.f - lbs[j]) * sigmoidf_(v[j]));
          *(h4*)(LOGF + to) = lf;
        } else if (sec == 2) {
          *(uint2*)(Vg + to) = make_uint2(pack2(v[0], v[1]), pack2(v[2], v[3]));
        } else {
          *(uint2*)(Gg + to) = make_uint2(pack2(siluf_(v[0]), siluf_(v[1])), pack2(siluf_(v[2]), siluf_(v[3])));
        }
      }
  }
};

template <bool RES_TILED>
struct EpiResidual {
  const float* res; u16* hbt; float* ss;
  DI void operator()(f32x16 (&acc)[4], int m, int n0, int half) const {
    float s = 0.f;
#pragma unroll
    for (int n4 = 0; n4 < 4; ++n4)
#pragma unroll
      for (int g = 0; g < 4; ++g) {
        const int col = n0 + n4 * 32 + 8 * g + 4 * half;
        u16* dst = hbt + tiledA(m, col, 1024);
        float r0, r1, r2, r3;
        if (RES_TILED) { const uint2 rv = *(const uint2*)dst; r0 = bflo(rv.x); r1 = bfhi(rv.x); r2 = bflo(rv.y); r3 = bfhi(rv.y); }
        else { const float4 rv = *(const float4*)(res + (size_t)m * 1024 + col); r0 = rv.x; r1 = rv.y; r2 = rv.z; r3 = rv.w; }
        const float v0 = acc[n4][4 * g] + r0, v1 = acc[n4][4 * g + 1] + r1, v2 = acc[n4][4 * g + 2] + r2, v3 = acc[n4][4 * g + 3] + r3;
        *(uint2*)dst = make_uint2(pack2(v0, v1), pack2(v2, v3));
        s += v0 * v0 + v1 * v1 + v2 * v2 + v3 * v3;
      }
    s += __shfl_xor(s, 32);
    if (half == 0) ss[(size_t)m * 8 + (n0 >> 7)] = s;
  }
};

struct EpiTopk {
  const float* ss; int* EX; float* GT; unsigned char* sel_lds;
  DI void operator()(f32x16 (&acc)[4], int m, int n0, int half) {
    const float rs = rstd_from_partials(ss, m);
    int k0[16], k1[16];
#pragma unroll
    for (int r = 0; r < 16; ++r) {
      k0[r] = (key_of(acc[0][r] * rs) & ~0x7f) | (crow(r, half));
      k1[r] = (key_of(acc[1][r] * rs) & ~0x7f) | (32 + crow(r, half));
    }
    bitonic_sort_desc<16>(k0);
    __builtin_amdgcn_sched_barrier(0);
    bitonic_sort_desc<16>(k1);
    merge_top16(k0, k1);
    __builtin_amdgcn_sched_barrier(0);
#pragma unroll
    for (int r = 0; r < 16; ++r) k1[r] = (key_of(acc[2][r] * rs) & ~0x7f) | (64 + crow(r, half));
    bitonic_sort_desc<16>(k1);
    merge_top16(k0, k1);
    __builtin_amdgcn_sched_barrier(0);
#pragma unroll
    for (int r = 0; r < 16; ++r) k1[r] = (key_of(acc[3][r] * rs) & ~0x7f) | (96 + crow(r, half));
    bitonic_sort_desc<16>(k1);
    merge_top16(k0, k1);
    __builtin_amdgcn_sched_barrier(0);
    int b[16];
#pragma unroll
    for (int j = 0; j < 16; ++j) b[j] = __shfl_xor(k0[j], 32);
    merge_top16(k0, b);
    volatile int* stash = (volatile int*)(sel_lds + 2048 + (threadIdx.x & 63) * 64);
    if (((n0 >> 7) & 1) == 0) {
#pragma unroll
      for (int j = 0; j < 16; ++j) stash[j] = k0[j];
      return;
    }
    int kprev[16];
#pragma unroll
    for (int j = 0; j < 16; ++j) kprev[j] = stash[j];
#define F1(i) val_of(kprev[i] & ~0x7f)
#define F2(j) val_of(k0[j] & ~0x7f)
    int a[16];
#pragma unroll
    for (int j = 0; j < 16; ++j) a[j] = (int)0x80000000;
#define SEL_PAIR(IA, JA, IB, JB) do { const int ka_ = (key_of(F1(IA) + F2(JA)) & ~0xff) | ((IA) * 16 + (JA)), kb_ = (key_of(F1(IB) + F2(JB)) & ~0xff) | ((IB) * 16 + (JB)); \
      const int kk_ = half ? kb_ : ka_; TOPK_INSERT(a, kk_); } while (0)
      SEL_PAIR(0, 0, 0, 1);
      SEL_PAIR(0, 2, 0, 3);
      SEL_PAIR(0, 4, 0, 5);
      SEL_PAIR(0, 6, 0, 7);
      SEL_PAIR(0, 8, 0, 9);
      SEL_PAIR(0, 10, 0, 11);
      SEL_PAIR(0, 12, 0, 13);
      SEL_PAIR(0, 14, 0, 15);
      SEL_PAIR(1, 0, 1, 1);
      SEL_PAIR(1, 2, 1, 3);
      SEL_PAIR(1, 4, 1, 5);
      SEL_PAIR(1, 6, 1, 7);
      SEL_PAIR(2, 0, 2, 1);
      SEL_PAIR(2, 2, 2, 3);
      SEL_PAIR(2, 4, 3, 0);
      SEL_PAIR(3, 1, 3, 2);
      SEL_PAIR(3, 3, 4, 0);
      SEL_PAIR(4, 1, 4, 2);
      SEL_PAIR(5, 0, 5, 1);
      SEL_PAIR(6, 0, 6, 1);
      SEL_PAIR(7, 0, 7, 1);
      SEL_PAIR(8, 0, 9, 0);
      SEL_PAIR(10, 0, 11, 0);
      SEL_PAIR(12, 0, 13, 0);
      SEL_PAIR(14, 0, 15, 0);
#undef SEL_PAIR
#undef F1
#undef F2
#pragma unroll
    for (int j = 0; j < 16; ++j) b[j] = __shfl_xor(a[j], 32);
    merge_top16(a, b);
    unsigned char* my = sel_lds + (m & 31) * 36;
    {
      unsigned pk4[4];
#pragma unroll
      for (int q = 0; q < 4; ++q) {
        const int s0 = half ? k0[4 * q] : kprev[4 * q], s1 = half ? k0[4 * q + 1] : kprev[4 * q + 1], s2 = half ? k0[4 * q + 2] : kprev[4 * q + 2], s3 = half ? k0[4 * q + 3] : kprev[4 * q + 3];
        pk4[q] = (unsigned)(s0 & 0x7f) | ((unsigned)(s1 & 0x7f) << 8) | ((unsigned)(s2 & 0x7f) << 16) | ((unsigned)(s3 & 0x7f) << 24);
      }
#pragma unroll
      for (int q = 0; q < 4; ++q) *(volatile unsigned*)(my + half * 16 + 4 * q) = pk4[q];
    }
    asm volatile("s_waitcnt lgkmcnt(0)" ::: "memory");
    float cs[16];
    float sum = 0.f;
    const float mx = val_of(a[0] & ~0xff);
#pragma unroll
    for (int k = 0; k < 16; ++k) { cs[k] = __expf(val_of(a[k] & ~0xff) - mx); sum += cs[k]; }
    const float inv = 1.f / sum;
    const int hcol = (n0 >> 8) * 16;
    if (half == 0) {
      int eo[16];
#pragma unroll
      for (int k = 0; k < 16; ++k) { const int ij = a[k] & 0xff; eo[k] = (int)((volatile unsigned char*)my)[ij >> 4] * 128 + (int)((volatile unsigned char*)my)[16 + (ij & 15)]; }
      int4* de = (int4*)(EX + (size_t)m * 128 + hcol);
#pragma unroll
      for (int q = 0; q < 4; ++q) de[q] = make_int4(eo[4 * q], eo[4 * q + 1], eo[4 * q + 2], eo[4 * q + 3]);
    } else {
      float4* dg = (float4*)(GT + (size_t)m * 128 + hcol);
#pragma unroll
      for (int q = 0; q < 4; ++q) dg[q] = make_float4(cs[4 * q] * inv, cs[4 * q + 1] * inv, cs[4 * q + 2] * inv, cs[4 * q + 3] * inv);
    }
  }
};

struct EpiKVQ {
  const float* ss; const float *k_norm, *q_norm; const float2* rope; u16 *Kb, *Vb, *Qb; unsigned char* stage;
  DI void operator()(f32x16 (&acc)[4], int m, int n0, int half) const {
    const float rs = rstd_from_partials(ss, m);
    u16* dst; const float* gain = nullptr; int ld;
    if (n0 < 768) { dst = Kb + (size_t)m * 768 + n0; gain = k_norm; ld = 768; }
    else if (n0 < 1536) { dst = Vb + (size_t)m * 768 + (n0 - 768); ld = 768; }
    else { dst = Qb + (size_t)m * 1536 + (n0 - 1536); gain = q_norm; ld = 1536; }
#pragma unroll
    for (int n4 = 0; n4 < 4; ++n4)
#pragma unroll
      for (int r = 0; r < 16; ++r) acc[n4][r] *= rs;
    if (gain) {
      float s = 0.f;
#pragma unroll
      for (int n4 = 0; n4 < 4; ++n4)
#pragma unroll
        for (int r = 0; r < 16; ++r) s += acc[n4][r] * acc[n4][r];
      s += __shfl_xor(s, 32);
      const float rn = rsqrtf(s * (1.f / 128.f) + EPS);
#pragma unroll
      for (int n4 = 0; n4 < 4; ++n4)
#pragma unroll
        for (int g = 0; g < 4; ++g) {
          const float4 gv = *(const float4*)(gain + n4 * 32 + 8 * g + 4 * half);
          acc[n4][4 * g] *= rn * gv.x; acc[n4][4 * g + 1] *= rn * gv.y; acc[n4][4 * g + 2] *= rn * gv.z; acc[n4][4 * g + 3] *= rn * gv.w;
        }
      const int pos = m & (SEQ - 1);
#pragma unroll
      for (int r = 0; r < 8; ++r) {
        const float2 cs = rope[pos * 16 + crow(r, half)];
        const float x1 = acc[0][r], x2 = acc[0][r + 8];
        acc[0][r] = x1 * cs.x - x2 * cs.y;
        acc[0][r + 8] = x2 * cs.x + x1 * cs.y;
      }
    }
    unsigned char* st = stage + (threadIdx.x >> 6) * 4352;
    const int l31 = threadIdx.x & 31;
    const int rr = (threadIdx.x & 63) >> 3, cc = threadIdx.x & 7;
    u16* dbase = dst - (size_t)l31 * ld;
#pragma unroll
    for (int ps = 0; ps < 2; ++ps) {
#pragma unroll
      for (int n2 = 0; n2 < 2; ++n2)
#pragma unroll
        for (int g = 0; g < 4; ++g)
          *(uint2*)(st + l31 * 136 + (n2 * 32 + 8 * g + 4 * half) * 2) = make_uint2(pack2(acc[ps * 2 + n2][4 * g], acc[ps * 2 + n2][4 * g + 1]), pack2(acc[ps * 2 + n2][4 * g + 2], acc[ps * 2 + n2][4 * g + 3]));
      asm volatile("s_waitcnt lgkmcnt(0)" ::: "memory");
#pragma unroll
      for (int i = 0; i < 4; ++i) {
        const uint2 a = *(const uint2*)(st + (rr + 8 * i) * 136 + cc * 16), b = *(const uint2*)(st + (rr + 8 * i) * 136 + cc * 16 + 8);
        *(uint4*)(dbase + (size_t)(rr + 8 * i) * ld + ps * 64 + cc * 8) = make_uint4(a.x, a.y, b.x, b.y);
      }
      asm volatile("s_waitcnt lgkmcnt(0)" ::: "memory");
    }
  }
};

DI void gla_g1(const Params& p, unsigned char* lds) {
  const int tid = opaque_tid(), lane = tid & 63, w = tid >> 6, l31 = lane & 31, half = lane >> 5;
  unsigned char* ws = p.ws;
  const _Float16* LOGF = (const _Float16*)(ws + OFF_LOGF);
  const u16* Vg = (const u16*)(ws + OFF_VG);
  u16* UT = (u16*)(ws + OFF_UT);
  float* ACH = (float*)(ws + OFF_ACH);
  unsigned char* KT = lds;
  unsigned char* VT = lds + 16384;
  float* tot = (float*)(lds + 32768);
  for (int item = blockIdx.x; item < 2048; item += gridDim.x) {
    const int bh = item >> 7, c = item & 127, b = bh >> 3, h = bh & 7;
    (void)b; (void)h;
    const int dg = tid & 31, jr = tid >> 5, d0 = dg * 4;
    const size_t tb = (size_t)item * 8192 + (size_t)(dg * 64 + jr * 8) * 4;
    float lfv[8][4], bl[8][4];
    {
      typedef _Float16 h8 __attribute__((ext_vector_type(8)));
      float run[4] = {0.f, 0.f, 0.f, 0.f};
#pragma unroll
      for (int q = 0; q < 4; ++q) {
        const h8 lf = *(const h8*)(LOGF + tb + 8 * q);
#pragma unroll
        for (int i = 0; i < 8; ++i) { const int jj = 2 * q + (i >> 2), dd = i & 3; lfv[jj][dd] = (float)lf[i]; run[dd] += lfv[jj][dd]; bl[jj][dd] = run[dd]; }
      }
      *(float4*)(tot + jr * 128 + d0) = make_float4(run[0], run[1], run[2], run[3]);
    }
    __syncthreads();
    float pre[4] = {0.f, 0.f, 0.f, 0.f}, blast[4] = {0.f, 0.f, 0.f, 0.f};
#pragma unroll
    for (int r = 0; r < 8; ++r) {
      const float4 tv = *(const float4*)(tot + r * 128 + d0);
      const float m_ = (r < jr) ? 1.f : 0.f;
      pre[0] += m_ * tv.x; pre[1] += m_ * tv.y; pre[2] += m_ * tv.z; pre[3] += m_ * tv.w;
      blast[0] += tv.x; blast[1] += tv.y; blast[2] += tv.z; blast[3] += tv.w;
    }
#pragma unroll
    for (int dd = 0; dd < 4; ++dd) {
      unsigned pk[4];
#pragma unroll
      for (int i = 0; i < 4; ++i)
        pk[i] = pack2((1.f - __expf(lfv[2 * i][dd])) * __expf(blast[dd] - (bl[2 * i][dd] + pre[dd])), (1.f - __expf(lfv[2 * i + 1][dd])) * __expf(blast[dd] - (bl[2 * i + 1][dd] + pre[dd])));
      *(uint4*)(KT + off128(d0 + dd, jr)) = make_uint4(pk[0], pk[1], pk[2], pk[3]);
    }
    {
      uint4 vq[4];
#pragma unroll
      for (int q = 0; q < 4; ++q) vq[q] = *(const uint4*)(Vg + tb + 8 * q);
      *(uint4*)(VT + off128(d0 + 0, jr)) = make_uint4((vq[0].x & 0xffffu) | (vq[0].z << 16), (vq[1].x & 0xffffu) | (vq[1].z << 16), (vq[2].x & 0xffffu) | (vq[2].z << 16), (vq[3].x & 0xffffu) | (vq[3].z << 16));
      *(uint4*)(VT + off128(d0 + 1, jr)) = make_uint4((vq[0].x >> 16) | (vq[0].z & 0xffff0000u), (vq[1].x >> 16) | (vq[1].z & 0xffff0000u), (vq[2].x >> 16) | (vq[2].z & 0xffff0000u), (vq[3].x >> 16) | (vq[3].z & 0xffff0000u));
      *(uint4*)(VT + off128(d0 + 2, jr)) = make_uint4((vq[0].y & 0xffffu) | (vq[0].w << 16), (vq[1].y & 0xffffu) | (vq[1].w << 16), (vq[2].y & 0xffffu) | (vq[2].w << 16), (vq[3].y & 0xffffu) | (vq[3].w << 16));
      *(uint4*)(VT + off128(d0 + 3, jr)) = make_uint4((vq[0].y >> 16) | (vq[0].w & 0xffff0000u), (vq[1].y >> 16) | (vq[1].w & 0xffff0000u), (vq[2].y >> 16) | (vq[2].w & 0xffff0000u), (vq[3].y >> 16) | (vq[3].w & 0xffff0000u));
    }
    if (jr == 0) *(float4*)(ACH + item * 128 + d0) = make_float4(__expf(blast[0]), __expf(blast[1]), __expf(blast[2]), __expf(blast[3]));
    __syncthreads();
    f32x16 acc[4];
#pragma unroll
    for (int i = 0; i < 4; ++i)
#pragma unroll
      for (int r = 0; r < 16; ++r) acc[i][r] = 0.f;
#pragma unroll
    for (int s = 0; s < 4; ++s) {
      const bf16x8 af = *(const bf16x8*)(KT + off128(w * 32 + l31, 2 * s + half));
#pragma unroll
      for (int et = 0; et < 4; ++et) {
        const bf16x8 bfr = *(const bf16x8*)(VT + off128(et * 32 + l31, 2 * s + half));
        acc[et] = MFMA32(af, bfr, acc[et]);
      }
    }
#pragma unroll
    for (int et = 0; et < 4; ++et)
#pragma unroll
      for (int g = 0; g < 4; ++g) {
        const int e = et * 32 + l31, d0 = w * 32 + 8 * g + 4 * half;
        *(uint2*)(UT + ((size_t)item * 128 + e) * 128 + d0) = make_uint2(pack2(acc[et][4 * g], acc[et][4 * g + 1]), pack2(acc[et][4 * g + 2], acc[et][4 * g + 3]));
      }
    __syncthreads();
  }
}

DI void gla_g2(const Params& p) {
  const int tid = opaque_tid();
  unsigned char* ws = p.ws;
  u16* UT = (u16*)(ws + OFF_UT);
  const float* ACH = (const float*)(ws + OFF_ACH);
  for (int u = blockIdx.x; u < 1024; u += gridDim.x) {
    const int bh = u >> 6, e = (u & 63) * 2 + (tid >> 7), d = tid & 127;
    float S = 0.f;
    size_t idx = ((size_t)bh * 128) * 16384 + (size_t)e * 128 + d;
    size_t aidx = (size_t)bh * 128 * 128 + d;
    for (int c = 0; c < 128; c += 32) {
      float uv[32], av[32];
#pragma unroll
      for (int k = 0; k < 32; ++k) { uv[k] = bf2f(UT[idx + (size_t)k * 16384]); av[k] = ACH[aidx + (size_t)k * 128]; }
#pragma unroll
      for (int k = 0; k < 32; ++k) { UT[idx + (size_t)k * 16384] = f2bf(S); S = av[k] * S + uv[k]; }
      idx += (size_t)32 * 16384; aidx += 32 * 128;
    }
  }
}

DI void gla_g3(const Params& p, unsigned char* lds) {
  const int tid = opaque_tid(), lane = tid & 63, w = tid >> 6, l31 = lane & 31, half = lane >> 5;
  unsigned char* ws = p.ws;
  const _Float16* LOGF = (const _Float16*)(ws + OFF_LOGF);
  const u16* Qg = (const u16*)(ws + OFF_QG);
  const u16* Vg = (const u16*)(ws + OFF_VG);
  const u16* Gg = (const u16*)(ws + OFF_GG);
  const u16* ST = (const u16*)(ws + OFF_UT);
  u16* OG = (u16*)(ws + OFF_OG);
  unsigned char* QP = lds;
  unsigned char* KP = lds + 16384;
  unsigned char* VT = lds + 32768;
  unsigned char* STs = lds + 16384;
  float* tot = (float*)(lds + 49152);
  float* red = (float*)(lds + 49152 + 4096);
  for (int item = blockIdx.x; item < 2048; item += gridDim.x) {
    const int bh = item >> 7, c = item & 127, b = bh >> 3, h = bh & 7;
    const int t0 = b * SEQ + c * 64;
    u32x4 stq[8];
    {
      const u16* src = ST + (size_t)item * 16384;
#pragma unroll
      for (int j = 0; j < 8; ++j) { const int id = tid + 256 * j; stq[j] = *(const u32x4*)(src + (size_t)(id >> 4) * 128 + (id & 15) * 8); }
    }
    u32x2 ggq[2][4];
    {
      const int tq_ = t0 + (w & 1) * 32 + l31;
#pragma unroll
      for (int ee = 0; ee < 2; ++ee)
#pragma unroll
        for (int g = 0; g < 4; ++g) ggq[ee][g] = *(const u32x2*)(Gg + (size_t)item * 8192 + (size_t)(((((w >> 1) * 2 + ee) * 32 + 8 * g + 4 * half) >> 2) * 64 + (w & 1) * 32 + l31) * 4);
    }
    const int dg = tid & 31, jr = tid >> 5, d0 = dg * 4;
    const size_t tb = (size_t)item * 8192 + (size_t)(dg * 64 + jr * 8) * 4;
    float lfv[8][4], bl[8][4];
    {
      typedef _Float16 h8 __attribute__((ext_vector_type(8)));
      float run[4] = {0.f, 0.f, 0.f, 0.f};
#pragma unroll
      for (int q = 0; q < 4; ++q) {
        const h8 lf = *(const h8*)(LOGF + tb + 8 * q);
#pragma unroll
        for (int i = 0; i < 8; ++i) { const int jj = 2 * q + (i >> 2), dd = i & 3; lfv[jj][dd] = (float)lf[i]; run[dd] += lfv[jj][dd]; bl[jj][dd] = run[dd]; }
      }
      *(float4*)(tot + jr * 128 + d0) = make_float4(run[0], run[1], run[2], run[3]);
    }
    __syncthreads();
    float pre[4] = {0.f, 0.f, 0.f, 0.f}, blast[4] = {0.f, 0.f, 0.f, 0.f};
#pragma unroll
    for (int r = 0; r < 8; ++r) {
      const float4 tv = *(const float4*)(tot + r * 128 + d0);
      const float m_ = (r < jr) ? 1.f : 0.f;
      pre[0] += m_ * tv.x; pre[1] += m_ * tv.y; pre[2] += m_ * tv.z; pre[3] += m_ * tv.w;
      blast[0] += tv.x; blast[1] += tv.y; blast[2] += tv.z; blast[3] += tv.w;
    }
    {
      uint4 qq[4];
#pragma unroll
      for (int q = 0; q < 4; ++q) qq[q] = *(const uint4*)(Qg + tb + 8 * q);
#pragma unroll
      for (int jj = 0; jj < 8; ++jj) {
        const int i = jr * 8 + jj;
        const unsigned q01 = (jj & 1) ? qq[jj >> 1].z : qq[jj >> 1].x, q23 = (jj & 1) ? qq[jj >> 1].w : qq[jj >> 1].y;
        const float qf[4] = {bflo(q01), bfhi(q01), bflo(q23), bfhi(q23)};
        float qv[4], kv[4];
#pragma unroll
        for (int dd = 0; dd < 4; ++dd) { const float bv = bl[jj][dd] + pre[dd]; qv[dd] = qf[dd] * __expf(bv); kv[dd] = (1.f - __expf(lfv[jj][dd])) * __expf(-bv); }
        const int o = i * 256 + (((d0 >> 3) ^ (i & 15)) << 4) + (d0 & 7) * 2;
        *(uint2*)(QP + o) = make_uint2(pack2(qv[0], qv[1]), pack2(qv[2], qv[3]));
        *(uint2*)(KP + o) = make_uint2(pack2(kv[0], kv[1]), pack2(kv[2], kv[3]));
      }
    }
    {
      uint4 vq[4];
#pragma unroll
      for (int q = 0; q < 4; ++q) vq[q] = *(const uint4*)(Vg + tb + 8 * q);
      *(uint4*)(VT + off128(d0 + 0, jr)) = make_uint4((vq[0].x & 0xffffu) | (vq[0].z << 16), (vq[1].x & 0xffffu) | (vq[1].z << 16), (vq[2].x & 0xffffu) | (vq[2].z << 16), (vq[3].x & 0xffffu) | (vq[3].z << 16));
      *(uint4*)(VT + off128(d0 + 1, jr)) = make_uint4((vq[0].x >> 16) | (vq[0].z & 0xffff0000u), (vq[1].x >> 16) | (vq[1].z & 0xffff0000u), (vq[2].x >> 16) | (vq[2].z & 0xffff0000u), (vq[3].x >> 16) | (vq[3].z & 0xffff0000u));
      *(uint4*)(VT + off128(d0 + 2, jr)) = make_uint4((vq[0].y & 0xffffu) | (vq[0].w << 16), (vq[1].y & 0xffffu) | (vq[1].w << 16), (vq[2].y & 0xffffu) | (vq[2].w << 16), (vq[3].y & 0xffffu) | (vq[3].w << 16));
      *(uint4*)(VT + off128(d0 + 3, jr)) = make_uint4((vq[0].y >> 16) | (vq[0].w & 0xffff0000u), (vq[1].y >> 16) | (vq[1].w & 0xffff0000u), (vq[2].y >> 16) | (vq[2].w & 0xffff0000u), (vq[3].y >> 16) | (vq[3].w & 0xffff0000u));
    }
    __syncthreads();
    const int it = w & 1, eh = w >> 1;
    f32x16 pt0, pt1;
#pragma unroll
    for (int r = 0; r < 16; ++r) { pt0[r] = 0.f; pt1[r] = 0.f; }
#pragma unroll
    for (int kk = 0; kk < 8; ++kk) {
      const bf16x8 bq = *(const bf16x8*)(QP + off256(it * 32 + l31, 2 * kk + half));
      const bf16x8 a0 = *(const bf16x8*)(KP + off256(l31, 2 * kk + half));
      pt0 = MFMA32(a0, bq, pt0);
      if (it) {
        const bf16x8 a1 = *(const bf16x8*)(KP + off256(32 + l31, 2 * kk + half));
        pt1 = MFMA32(a1, bq, pt1);
      }
    }
    if (it == 0) {
#pragma unroll
      for (int r = 0; r < 16; ++r) if (crow(r, half) > l31) pt0[r] = 0.f;
    } else {
#pragma unroll
      for (int r = 0; r < 16; ++r) if (crow(r, half) > l31) pt1[r] = 0.f;
    }
    bf16x8 pf[2][2];
#pragma unroll
    for (int s = 0; s < 2; ++s) {
      uint4 u0 = make_uint4(pack2(pt0[8 * s], pt0[8 * s + 1]), pack2(pt0[8 * s + 2], pt0[8 * s + 3]), pack2(pt0[8 * s + 4], pt0[8 * s + 5]), pack2(pt0[8 * s + 6], pt0[8 * s + 7]));
      uint4 u1 = make_uint4(pack2(pt1[8 * s], pt1[8 * s + 1]), pack2(pt1[8 * s + 2], pt1[8 * s + 3]), pack2(pt1[8 * s + 4], pt1[8 * s + 5]), pack2(pt1[8 * s + 6], pt1[8 * s + 7]));
      pf[0][s] = __builtin_bit_cast(bf16x8, u0);
      pf[1][s] = __builtin_bit_cast(bf16x8, u1);
    }
    f32x16 acc[2];
#pragma unroll
    for (int i = 0; i < 2; ++i)
#pragma unroll
      for (int r = 0; r < 16; ++r) acc[i][r] = 0.f;
#pragma unroll
    for (int ee = 0; ee < 2; ++ee) {
      const int e = (eh * 2 + ee) * 32 + l31;
#pragma unroll
      for (int jt = 0; jt < 2; ++jt) {
        if (jt <= it) {
#pragma unroll
          for (int s = 0; s < 2; ++s) {
            const int cA = 4 * jt + 2 * s;
            const uint2 lo = *(const uint2*)(VT + off128(e, cA) + 8 * half);
            const uint2 hi = *(const uint2*)(VT + off128(e, cA + 1) + 8 * half);
            const bf16x8 av = __builtin_bit_cast(bf16x8, make_uint4(lo.x, lo.y, hi.x, hi.y));
            acc[ee] = MFMA32(av, pf[jt][s], acc[ee]);
          }
        }
      }
    }
    __syncthreads();
    {
#pragma unroll
      for (int j = 0; j < 8; ++j) {
        const int id = tid + 256 * j, e = id >> 4, cc = id & 15;
        *(u32x4*)(STs + off256(e, cc)) = stq[j];
      }
    }
    __syncthreads();
#pragma unroll
    for (int kk = 0; kk < 8; ++kk) {
      const bf16x8 bq = *(const bf16x8*)(QP + off256(it * 32 + l31, 2 * kk + half));
#pragma unroll
      for (int ee = 0; ee < 2; ++ee) {
        const bf16x8 as = *(const bf16x8*)(STs + off256((eh * 2 + ee) * 32 + l31, 2 * kk + half));
        acc[ee] = MFMA32(as, bq, acc[ee]);
      }
    }
    float ssq = 0.f;
#pragma unroll
    for (int ee = 0; ee < 2; ++ee)
#pragma unroll
      for (int r = 0; r < 16; ++r) ssq += acc[ee][r] * acc[ee][r];
    ssq += __shfl_xor(ssq, 32);
    if (half == 0) red[w * 32 + l31] = ssq;
    __syncthreads();
    const float rn = rsqrtf((red[w * 32 + l31] + red[(w ^ 2) * 32 + l31]) * (1.f / 128.f) + EPS);
    const int t = t0 + it * 32 + l31;
#pragma unroll
    for (int ee = 0; ee < 2; ++ee)
#pragma unroll
      for (int g = 0; g < 4; ++g) {
        const int e0 = (eh * 2 + ee) * 32 + 8 * g + 4 * half;
        const size_t o = (size_t)t * 1024 + h * 128 + e0;
        const uint2 gg = make_uint2(ggq[ee][g][0], ggq[ee][g][1]);
        const float4 og = *(const float4*)(p.hgrn_out_norm + e0);
        const float v0 = acc[ee][4 * g] * rn * og.x * bflo(gg.x), v1 = acc[ee][4 * g + 1] * rn * og.y * bfhi(gg.x);
        const float v2 = acc[ee][4 * g + 2] * rn * og.z * bflo(gg.y), v3 = acc[ee][4 * g + 3] * rn * og.w * bfhi(gg.y);
        *(uint2*)(OG + tiledA(t, h * 128 + e0, 1024)) = make_uint2(pack2(v0, v1), pack2(v2, v3));
      }
    __syncthreads();
  }
}

struct XcdSlot { int part0, pstride, rank, cnt; };
DI XcdSlot xcd_slot(const Params& p, unsigned myrank) {
  const unsigned* census = (const unsigned*)(p.ws + OFF_CENSUS);
  const unsigned myx = (unsigned)__builtin_amdgcn_s_getreg((3 << 11) | 20) & 0xFu;
  int nx = 0, ix = 0, cnt = 1;
#pragma unroll
  for (int j = 0; j < 16; ++j) {
    const unsigned c = __builtin_amdgcn_readfirstlane(census[j]);
    if (c) { if ((unsigned)j == myx) { ix = nx; cnt = (int)c; } ++nx; }
  }
  XcdSlot sl; sl.part0 = ix; sl.pstride = nx > 0 ? nx : 1; sl.rank = (int)myrank; sl.cnt = cnt;
  return sl;
}

DI void peer_s1(const Params& p, int layer, const XcdSlot sl) {
  const int tid = opaque_tid(), lane = tid & 63, w = tid >> 6;
  unsigned char* ws = p.ws;
  const int* EX = (const int*)(ws + OFF_EX);
  const unsigned char* U8 = ws + (layer ? OFF_UV1 : OFF_UV0);
  const u16* HB = (const u16*)(ws + OFF_HBT);
  float* ZP = (float*)(ws + OFF_ZP);
  const int c8 = lane & 7, rg = lane >> 3;
  const bool b2 = (lane & 4) != 0, b1 = (lane & 2) != 0, b0 = (lane & 1) != 0;
  const int first = sl.rank * 4 + w, stride = sl.cnt * 4;
  const int nT = (T_TOK - first + stride - 1) / stride;
  const int nparts = (8 - sl.part0 + sl.pstride - 1) / sl.pstride;
  const int total = nT * nparts;
  if (total <= 0) return;
#define Z1_ITEM(IT, X, T) do { int it_ = (IT) < total ? (IT) : total - 1; const int xi_ = it_ / nT; X = sl.part0 + xi_ * sl.pstride; T = first + (it_ - xi_ * nT) * stride; } while (0)
#define Z1_LOAD_EH(EV, H0, H1, X, T) do { _Pragma("unroll") for (int q = 0; q < 4; ++q) { \
      const int4 e4 = *(const int4*)(EX + (size_t)(T) * 128 + rg * 16 + 4 * q); EV[4 * q] = e4.x; EV[4 * q + 1] = e4.y; EV[4 * q + 2] = e4.z; EV[4 * q + 3] = e4.w; } \
      H0 = *(const uint4*)(HB + tiledA((T), (X) * 128 + c8 * 16, 1024)); H1 = *(const uint4*)(HB + tiledA((T), (X) * 128 + c8 * 16 + 8, 1024)); } while (0)
#define Z1_LOAD_ROWS(EV, X) do { const unsigned char* ub_ = U8 + (size_t)(X) * 16384 * 128 + c8 * 16; \
      _Pragma("unroll") for (int j = 0; j < 16; ++j) q8[j] = *(const uint4*)(ub_ + (size_t)EV[j] * 128); } while (0)
  int evA[16], evB[16]; uint4 hA0, hA1, hB0, hB1;
  uint4 q8[16];
  int xC, tC, xN, tN, x2, t2;
  Z1_ITEM(0, xC, tC);
  Z1_LOAD_EH(evA, hA0, hA1, xC, tC);
  Z1_LOAD_ROWS(evA, xC);
  Z1_ITEM(1, xN, tN);
  Z1_LOAD_EH(evB, hB0, hB1, xN, tN);
#define Z1_BODY(EVC, HC0, HC1, EVN, IT) do { \
    f32x2 hf[8]; \
    { const unsigned hw[8] = {HC0.x, HC0.y, HC0.z, HC0.w, HC1.x, HC1.y, HC1.z, HC1.w}; \
      _Pragma("unroll") for (int k = 0; k < 8; ++k) { hf[k][0] = bflo(hw[k]); hf[k][1] = bfhi(hw[k]); } } \
    float pz[16]; \
    _Pragma("unroll") for (int j = 0; j < 16; ++j) { \
      const unsigned wd[4] = {q8[j].x, q8[j].y, q8[j].z, q8[j].w}; \
      f32x2 a2 = {0.f, 0.f}; \
      _Pragma("unroll") for (int d = 0; d < 4; ++d) { \
        const f32x2 lo = __builtin_amdgcn_cvt_pk_f32_fp8((int)wd[d], false), hi = __builtin_amdgcn_cvt_pk_f32_fp8((int)wd[d], true); \
        a2 = __builtin_elementwise_fma(lo, hf[2 * d], a2); a2 = __builtin_elementwise_fma(hi, hf[2 * d + 1], a2); } \
      pz[j] = a2[0] + a2[1]; } \
      \
    float r1[8], r2[4], r3[2]; \
    _Pragma("unroll") for (int i = 0; i < 8; ++i) { const float send = b2 ? pz[i] : pz[8 + i], mine = b2 ? pz[8 + i] : pz[i]; r1[i] = mine + __shfl_xor(send, 4); } \
    _Pragma("unroll") for (int i = 0; i < 4; ++i) { const float send = b1 ? r1[i] : r1[4 + i], mine = b1 ? r1[4 + i] : r1[i]; r2[i] = mine + __shfl_xor(send, 2); } \
    _Pragma("unroll") for (int i = 0; i < 2; ++i) { const float send = b0 ? r2[i] : r2[2 + i], mine = b0 ? r2[2 + i] : r2[i]; r3[i] = mine + __shfl_xor(send, 1); } \
      \
    Z1_LOAD_ROWS(EVN, xN); \
    Z1_ITEM((IT) + 2, x2, t2); \
    Z1_LOAD_EH(EVC, HC0, HC1, x2, t2); \
      \
    *(float2*)(ZP + ((size_t)xC * T_TOK + tC) * 128 + rg * 16 + 2 * c8) = make_float2(r3[0], r3[1]); \
    xC = xN; tC = tN; xN = x2; tN = t2; } while (0)
  for (int it = 0; it < total; it += 2) {
    Z1_BODY(evA, hA0, hA1, evB, it);
    if (it + 1 < total) Z1_BODY(evB, hB0, hB1, evA, it + 1);
  }
#undef Z1_BODY
#undef Z1_ITEM
#undef Z1_LOAD_EH
#undef Z1_LOAD_ROWS
}

DI void peer_zmerge(const Params& p, int layer, const float* ss_in) {
  unsigned char* ws = p.ws;
  const int* EX = (const int*)(ws + OFF_EX);
  const float* GT = (const float*)(ws + OFF_GT);
  const float* ZP = (const float*)(ws + OFF_ZP);
  const float2* SC = (const float2*)(ws + (layer ? OFF_SC1 : OFF_SC0));
  float* ACT = (float*)(ws + OFF_ACT);
  for (int i4 = blockIdx.x * NTHREADS + opaque_tid(); i4 < T_TOK * 32; i4 += gridDim.x * NTHREADS) {
    const int idx = i4 * 4, t = idx >> 7;
    float4 z = make_float4(0.f, 0.f, 0.f, 0.f);
#pragma unroll
    for (int x = 0; x < 8; ++x) { const float4 v = *(const float4*)(ZP + (size_t)x * T_TOK * 128 + idx); z.x += v.x; z.y += v.y; z.z += v.z; z.w += v.w; }
    const int4 e4 = *(const int4*)(EX + idx);
    const float4 g4 = *(const float4*)(GT + idx);
    const float2 s0 = SC[e4.x], s1 = SC[e4.y], s2 = SC[e4.z], s3 = SC[e4.w];
    const float rs = rstd_from_partials(ss_in, t);
    *(float4*)(ACT + idx) = make_float4(gelu_tanh(z.x * rs * s0.x) * g4.x * s0.y, gelu_tanh(z.y * rs * s1.x) * g4.y * s1.y,
                                        gelu_tanh(z.z * rs * s2.x) * g4.z * s2.y, gelu_tanh(z.w * rs * s3.x) * g4.w * s3.y);
  }
}

template <bool FINAL>
DI void peer_s2(const Params& p, int layer, float* ss_out, const XcdSlot sl) {
  const int tid = opaque_tid(), lane = tid & 63, w = tid >> 6;
  unsigned char* ws = p.ws;
  const int* EX = (const int*)(ws + OFF_EX);
  const float* ACT = (const float*)(ws + OFF_ACT);
  const unsigned char* V8 = ws + (layer ? OFF_UV1 : OFF_UV0) + 16 * MiB;
  u16* HBT = (u16*)(ws + OFF_HBT);
  float* out = p.out;
  float* ssd = ss_out ? ss_out : (float*)(ws + OFF_DUMMY);
  const int c8 = lane & 7, rg = lane >> 3;
  const bool b5 = (lane & 32) != 0, b4 = (lane & 16) != 0, b3 = (lane & 8) != 0;
  const int first = sl.rank * 4 + w, stride = sl.cnt * 4;
  const int nT = (T_TOK - first + stride - 1) / stride;
  const int nparts = (8 - sl.part0 + sl.pstride - 1) / sl.pstride;
  const int total = nT * nparts;
  if (total <= 0) return;
#define S2_ITEM(IT, X, T) do { int it_ = (IT) < total ? (IT) : total - 1; const int xi_ = it_ / nT; X = sl.part0 + xi_ * sl.pstride; T = first + (it_ - xi_ * nT) * stride; } while (0)
  int ev[16];
  float avX[16], avY[16];
  u32x4 qX[16], qY[16];
  unsigned hX, hY;
  int xC, tC, xN, tN, x2, t2;
#define S2_LOAD_EV(T) do { _Pragma("unroll") for (int q = 0; q < 4; ++q) { const int4 e4 = *(const int4*)(EX + (size_t)(T) * 128 + rg * 16 + 4 * q); \
      ev[4 * q] = e4.x; ev[4 * q + 1] = e4.y; ev[4 * q + 2] = e4.z; ev[4 * q + 3] = e4.w; } } while (0)
#define S2_ISSUE(Q, AV, H, X, T) do { const unsigned char* vb_ = V8 + (size_t)(X) * 16384 * 128 + c8 * 16; \
      _Pragma("unroll") for (int j = 0; j < 16; ++j) Q[j] = *(const u32x4*)(vb_ + (size_t)ev[j] * 128); \
      H = *(const unsigned*)(HBT + tiledA((T), (X) * 128 + c8 * 16 + 2 * rg, 1024)); \
      _Pragma("unroll") for (int q = 0; q < 4; ++q) { const float4 a4 = *(const float4*)(ACT + (size_t)(T) * 128 + rg * 16 + 4 * q); \
        AV[4 * q] = a4.x; AV[4 * q + 1] = a4.y; AV[4 * q + 2] = a4.z; AV[4 * q + 3] = a4.w; } } while (0)
  S2_ITEM(0, xC, tC);
  S2_LOAD_EV(tC);
  S2_ISSUE(qX, avX, hX, xC, tC);
  S2_ITEM(1, xN, tN);
  S2_LOAD_EV(tN);
#define S2_BODY(QC, AVC, HC, QN, AVN, HN, IT) do { \
    S2_ISSUE(QN, AVN, HN, xN, tN);              \
    S2_ITEM((IT) + 2, x2, t2); \
    S2_LOAD_EV(t2);                             \
    float acc[16]; \
    _Pragma("unroll") for (int i = 0; i < 16; ++i) acc[i] = 0.f; \
    _Pragma("unroll") for (int j = 0; j < 16; ++j) { \
      const f32x2 a2 = {AVC[j], AVC[j]}; \
      _Pragma("unroll") for (int d = 0; d < 4; ++d) { \
        const f32x2 lo = __builtin_amdgcn_cvt_pk_f32_fp8((int)QC[j][d], false), hi = __builtin_amdgcn_cvt_pk_f32_fp8((int)QC[j][d], true); \
        f32x2 c0 = {acc[4 * d], acc[4 * d + 1]}, c1 = {acc[4 * d + 2], acc[4 * d + 3]}; \
        c0 = __builtin_elementwise_fma(lo, a2, c0); c1 = __builtin_elementwise_fma(hi, a2, c1); \
        acc[4 * d] = c0[0]; acc[4 * d + 1] = c0[1]; acc[4 * d + 2] = c1[0]; acc[4 * d + 3] = c1[1]; } } \
      \
    float r1[8], r2[4], r3[2]; \
    _Pragma("unroll") for (int i = 0; i < 8; ++i) { const float send = b5 ? acc[i] : acc[8 + i], mine = b5 ? acc[8 + i] : acc[i]; r1[i] = mine + __shfl_xor(send, 32); } \
    _Pragma("unroll") for (int i = 0; i < 4; ++i) { const float send = b4 ? r1[i] : r1[4 + i], mine = b4 ? r1[4 + i] : r1[i]; r2[i] = mine + __shfl_xor(send, 16); } \
    _Pragma("unroll") for (int i = 0; i < 2; ++i) { const float send = b3 ? r2[i] : r2[2 + i], mine = b3 ? r2[2 + i] : r2[i]; r3[i] = mine + __shfl_xor(send, 8); } \
    const float n0 = bflo(HC) + r3[0], n1 = bfhi(HC) + r3[1]; \
    if (FINAL) *(float2*)(out + (size_t)tC * 1024 + xC * 128 + c8 * 16 + 2 * rg) = make_float2(n0, n1); \
    else { float ssq = n0 * n0 + n1 * n1; \
      _Pragma("unroll") for (int o = 32; o >= 1; o >>= 1) ssq += __shfl_xor(ssq, o); \
      *(unsigned*)(HBT + tiledA(tC, xC * 128 + c8 * 16 + 2 * rg, 1024)) = pack2(n0, n1); ssd[(size_t)tC * 8 + xC] = ssq; } \
    xC = xN; tC = tN; xN = x2; tN = t2; } while (0)
  for (int it = 0; it < total; it += 2) {
    S2_BODY(qX, avX, hX, qY, avY, hY, it);
    if (it + 1 < total) S2_BODY(qY, avY, hY, qX, avX, hX, it + 1);
  }
#undef S2_LOAD_EV
#undef S2_ISSUE
#undef S2_BODY
#undef S2_ITEM
}

constexpr int VT_STRIDE = 392;
DI void attn_phase(const Params& p, unsigned char* lds) {
  const int tid = opaque_tid(), lane = tid & 63, w = tid >> 6, l31 = lane & 31, half = lane >> 5;
  unsigned char* ws = p.ws;
  const u16* Kb = (const u16*)(ws + OFF_K);
  const u16* Vb = (const u16*)(ws + OFF_V);
  const u16* Qb = (const u16*)(ws + OFF_Q);
  u16* OGA = (u16*)(ws + OFF_OGA);
  float* LG = (float*)(ws + OFF_LG);
  const float Mx = ((const float*)(ws + OFF_MISC))[0];
  const float scale = 0.08838834764831845f;
  for (int item = blockIdx.x; item < 1536; item += gridDim.x) {
    const int qb = item & 127, rest = item >> 7, kvh = rest & 1, gi = (rest >> 1) % 3, b = rest / 6;
    const int dl = (gi == 0) ? 1 : (gi == 1 ? 4 : 16);
    const int bpr = (SEQ / dl) / 64;
    const int rho = qb / bpr, tau0 = (qb % bpr) * 64;
#pragma unroll 4
    for (int j = 0; j < 12; ++j) {
      const int id = tid + 256 * j, row = id >> 4, c = id & 15;
      const int tk = tau0 - 128 + row;
      const int tokk = rho + dl * (tk < 0 ? 0 : tk);
      *(uint4*)(lds + off256(row, c)) = *(const uint4*)(Kb + ((size_t)(b * SEQ + tokk)) * 768 + gi * 256 + kvh * 128 + c * 8);
    }
    const int r = w & 1, qh = w >> 1;
    const int tauq = tau0 + qh * 32 + l31;
    const int tq = b * SEQ + rho + dl * tauq;
    bf16x8 qf[8];
    {
      const u16* qsrc = Qb + (size_t)tq * 1536 + ((gi * 2 + kvh) * 2 + r) * 128;
#pragma unroll
      for (int kk = 0; kk < 8; ++kk) qf[kk] = *(const bf16x8*)(qsrc + (2 * kk + half) * 8);
    }
    __syncthreads();
    float lsum = 0.f;
    bf16x8 pf[5][2];
#pragma unroll
    for (int jl = 0; jl < 5; ++jl) {
      f32x16 pt;
#pragma unroll
      for (int rr = 0; rr < 16; ++rr) pt[rr] = 0.f;
#pragma unroll
      for (int kk = 0; kk < 8; ++kk) {
        const bf16x8 ak = *(const bf16x8*)(lds + off256((qh + jl) * 32 + l31, 2 * kk + half));
        pt = MFMA32(ak, qf[kk], pt);
      }
#pragma unroll
      for (int rr = 0; rr < 16; ++rr) {
        const int tk = tau0 - 128 + (qh + jl) * 32 + crow(rr, half);
        const bool valid = (tk >= 0) && (tk <= tauq) && (tk >= tauq - 128);
        const float pv = valid ? __expf(pt[rr] * scale - Mx) : 0.f;
        lsum += pv;
        pt[rr] = pv;
      }
#pragma unroll
      for (int s = 0; s < 2; ++s) {
        const uint4 u0 = make_uint4(pack2(pt[8 * s], pt[8 * s + 1]), pack2(pt[8 * s + 2], pt[8 * s + 3]),
                                    pack2(pt[8 * s + 4], pt[8 * s + 5]), pack2(pt[8 * s + 6], pt[8 * s + 7]));
        pf[jl][s] = __builtin_bit_cast(bf16x8, u0);
      }
    }
    lsum += __shfl_xor(lsum, 32);
    __syncthreads();
#pragma unroll 4
    for (int j = 0; j < 12; ++j) {
      const int id = tid + 256 * j, row = id >> 4, c = id & 15;
      const int tk = tau0 - 128 + row;
      const int tokk = rho + dl * (tk < 0 ? 0 : tk);
      const uint4 vv = *(const uint4*)(Vb + ((size_t)(b * SEQ + tokk)) * 768 + gi * 256 + kvh * 128 + c * 8);
      unsigned char* dstc = lds + (size_t)(c * 8) * VT_STRIDE + row * 2;
      *(u16*)(dstc + 0 * VT_STRIDE) = (u16)(vv.x & 0xffff); *(u16*)(dstc + 1 * VT_STRIDE) = (u16)(vv.x >> 16);
      *(u16*)(dstc + 2 * VT_STRIDE) = (u16)(vv.y & 0xffff); *(u16*)(dstc + 3 * VT_STRIDE) = (u16)(vv.y >> 16);
      *(u16*)(dstc + 4 * VT_STRIDE) = (u16)(vv.z & 0xffff); *(u16*)(dstc + 5 * VT_STRIDE) = (u16)(vv.z >> 16);
      *(u16*)(dstc + 6 * VT_STRIDE) = (u16)(vv.w & 0xffff); *(u16*)(dstc + 7 * VT_STRIDE) = (u16)(vv.w >> 16);
    }
    __syncthreads();
    f32x16 acc[4];
#pragma unroll
    for (int i = 0; i < 4; ++i)
#pragma unroll
      for (int rr = 0; rr < 16; ++rr) acc[i][rr] = 0.f;
#pragma unroll
    for (int et = 0; et < 4; ++et) {
      const unsigned char* vrow = lds + (size_t)(et * 32 + l31) * VT_STRIDE;
#pragma unroll
      for (int jl = 0; jl < 5; ++jl)
#pragma unroll
        for (int s = 0; s < 2; ++s) {
          const int j0 = (qh + jl) * 32 + 16 * s + 4 * half;
          const uint2 lo = *(const uint2*)(vrow + j0 * 2);
          const uint2 hi = *(const uint2*)(vrow + (j0 + 8) * 2);
          const bf16x8 av = __builtin_bit_cast(bf16x8, make_uint4(lo.x, lo.y, hi.x, hi.y));
          acc[et] = MFMA32(av, pf[jl][s], acc[et]);
        }
    }
    const int hd = kvh * 2 + r;
    const int tglob = tq;
    u16* od = OGA + ((size_t)gi * T_TOK + tglob) * 512 + hd * 128;
#pragma unroll
    for (int et = 0; et < 4; ++et)
#pragma unroll
      for (int g = 0; g < 4; ++g)
        *(uint2*)(od + et * 32 + 8 * g + 4 * half) = make_uint2(pack2(acc[et][4 * g], acc[et][4 * g + 1]), pack2(acc[et][4 * g + 2], acc[et][4 * g + 3]));
    if (half == 0) LG[((size_t)gi * T_TOK + tglob) * 4 + hd] = lsum;
    __syncthreads();
  }
}

DI void attn_combine(const Params& p) {
  unsigned char* ws = p.ws;
  const u16* OGA = (const u16*)(ws + OFF_OGA);
  const float* LG = (const float*)(ws + OFF_LG);
  u16* AO = (u16*)(ws + OFF_AO);
  const int nchunk = T_TOK * 512 / 8;
  for (int i = blockIdx.x * NTHREADS + opaque_tid(); i < nchunk; i += gridDim.x * NTHREADS) {
    const int t = i >> 6, c = i & 63, hd = c >> 4;
    float num[8];
#pragma unroll
    for (int k = 0; k < 8; ++k) num[k] = 0.f;
    float den = 0.f;
#pragma unroll
    for (int gi = 0; gi < 3; ++gi) {
      const uint4 v = *(const uint4*)(OGA + ((size_t)gi * T_TOK + t) * 512 + c * 8);
      num[0] += bflo(v.x); num[1] += bfhi(v.x); num[2] += bflo(v.y); num[3] += bfhi(v.y);
      num[4] += bflo(v.z); num[5] += bfhi(v.z); num[6] += bflo(v.w); num[7] += bfhi(v.w);
      den += LG[((size_t)gi * T_TOK + t) * 4 + hd];
    }
    const float inv = 1.f / den;
    *(uint4*)(AO + tiledA(t, c * 8, 512)) = make_uint4(pack2(num[0] * inv, num[1] * inv), pack2(num[2] * inv, num[3] * inv),
                                                        pack2(num[4] * inv, num[5] * inv), pack2(num[6] * inv, num[7] * inv));
  }
}

#define XB_TMO      128
#define XB_XCNT(j)  (256  + 64 * (j))
#define XB_XSUB(j)  (1280 + 64 * (j))
#define XB_XGEN(j)  (2304 + 64 * (j))
#define XB_TOP      3328
#define XB_TOPGEN   3392
#define XCD_BAR_WORDS 3456
#define XB_SPIN_CAP (1u << 18)
#define LAS __attribute__((address_space(3)))

__device__ __forceinline__ unsigned xb_ld(unsigned* p)              { return __hip_atomic_load(p, __ATOMIC_RELAXED, __HIP_MEMORY_SCOPE_AGENT); }
__device__ __forceinline__ unsigned xb_add(unsigned* p, unsigned v) { return __hip_atomic_fetch_add(p, v, __ATOMIC_RELAXED, __HIP_MEMORY_SCOPE_AGENT); }
__device__ __forceinline__ unsigned xb_xcc_id() { return (unsigned)__builtin_amdgcn_s_getreg((3 << 11) | 20) & 0xFu; }
#define XB_SPIN(cond, bar) do { unsigned _sp = 0; while (cond) { __builtin_amdgcn_s_sleep(1); \
    if ((++_sp & 255u) == 0u) { if (xb_ld(&(bar)[XB_TMO])) break; if (_sp > XB_SPIN_CAP) { atomicAdd(&(bar)[XB_TMO], 1u); break; } } } } while (0)

struct XcdBarrier {
    unsigned* bar; unsigned x;
    volatile LAS unsigned* st;
};

__device__ __forceinline__ XcdBarrier xcd_barrier_post(unsigned* bar, volatile LAS unsigned* st) {
    XcdBarrier b; b.bar = bar; b.x = xb_xcc_id(); b.st = st;
    if (threadIdx.x == 0) (void)xb_add(&bar[XB_XCNT(b.x)], 1u);
    return b;
}
__device__ __forceinline__ void xcd_barrier_complete(unsigned* bar, unsigned x, unsigned& nloc, unsigned& nx) {
    const unsigned G = gridDim.x * gridDim.y * gridDim.z;
    unsigned sum, cnt, mine, sp = 0u;
    for (;;) {
        sum = 0u; cnt = 0u; mine = 0u;
#pragma unroll
        for (unsigned j = 0; j < 16; ++j) { const unsigned c = xb_ld(&bar[XB_XCNT(j)]); sum += c; cnt += (c > 0u) ? 1u : 0u; mine = (j == x) ? c : mine; }
        if (sum == G) break;
        __builtin_amdgcn_s_sleep(1);
        if ((++sp & 255u) == 0u) { if (xb_ld(&bar[XB_TMO])) break; if (sp > XB_SPIN_CAP) { atomicAdd(&bar[XB_TMO], 1u); break; } }
    }
    nloc = mine > 0u ? mine : 1u; nx = cnt > 0u ? cnt : 1u;
}

__device__ __forceinline__ void xcd_barrier(const XcdBarrier& b) {
    asm volatile("s_waitcnt vmcnt(0)" ::: "memory");
    __syncthreads();
    if (threadIdx.x == 0) {
        unsigned* bar = b.bar;
        __builtin_amdgcn_s_waitcnt(0);
        unsigned nloc = b.st[0], nx = b.st[1];
        if (nloc == 0u) { xcd_barrier_complete(bar, b.x, nloc, nx); b.st[0] = nloc; b.st[1] = nx; }
        const unsigned old = xb_add(&bar[XB_XSUB(b.x)], 1u);
        const unsigned gen = old / nloc;
        if (old + 1u == (gen + 1u) * nloc) {
            __builtin_amdgcn_fence(__ATOMIC_RELEASE, "agent");
            asm volatile("s_waitcnt vmcnt(0)" ::: "memory");
            const unsigned og = xb_add(&bar[XB_TOP], 1u);
            const unsigned tg = og / nx;
            if (og + 1u == (tg + 1u) * nx) xb_add(&bar[XB_TOPGEN], 1u);
            else XB_SPIN(xb_ld(&bar[XB_TOPGEN]) == tg, bar);
            __builtin_amdgcn_fence(__ATOMIC_ACQUIRE, "agent");
            xb_add(&bar[XB_XGEN(b.x)], 1u);
            asm volatile("s_waitcnt vmcnt(0)" ::: "memory");
        } else {
            XB_SPIN(xb_ld(&bar[XB_XGEN(b.x)]) == gen, bar);
            __builtin_amdgcn_fence(__ATOMIC_ACQUIRE, "agent");
            asm volatile("s_waitcnt vmcnt(0)" ::: "memory");
        }
    }
    __syncthreads();
}


constexpr int N_PHASES = 18;
template <int ph>
DI void run_phase(const Params& p, unsigned char* lds, unsigned myrank) {
  unsigned char* ws = p.ws;
  switch (ph) {
    case 0: p0_prep(p, lds); break;
    case 1: {
      EpiHgrnIn e{(const float*)(ws + OFF_RSTD0), (const float*)(ws + OFF_LB), (u16*)(ws + OFF_QG), (u16*)(ws + OFF_VG), (u16*)(ws + OFF_GG), (_Float16*)(ws + OFF_LOGF)};
      gemm_phase64<EpiHgrnIn, 1>(p, (const u16*)(ws + OFF_HB), 1024, (const u16*)(ws + OFF_WIN), 1024, 64, 32, 16, e, lds);
    } break;
    case 2: gla_g1(p, lds); break;
    case 3: gla_g2(p); break;
    case 4: gla_g3(p, lds); break;
    case 5: {
      EpiResidual<false> e{p.x, (u16*)(ws + OFF_HBT), (float*)(ws + OFF_SS1)};
      gemm_phase64(p, (const u16*)(ws + OFF_OG), 1024, (const u16*)(ws + OFF_WOUT), 1024, 64, 8, 16, e, lds);
    } break;
    case 6: {
      EpiTopk e{(const float*)(ws + OFF_SS1), (int*)(ws + OFF_EX), (float*)(ws + OFF_GT), lds + 32768 + (opaque_tid() >> 6) * 6144};
      gemm_phase<EpiTopk, 0, true>(p, (const u16*)(ws + OFF_HBT), 1024, (const u16*)(ws + OFF_WPQ0), 1024, 128, 16, 16, e, lds);
    } break;
    case 7: peer_s1(p, 0, xcd_slot(p, myrank)); break;
    case 8: peer_zmerge(p, 0, (const float*)(ws + OFF_SS1)); break;
    case 9: peer_s2<false>(p, 0, (float*)(ws + OFF_SS2), xcd_slot(p, myrank)); break;
    case 10: {
      EpiKVQ e{(const float*)(ws + OFF_SS2), p.k_norm, p.q_norm, (const float2*)(ws + OFF_ROPE), (u16*)(ws + OFF_K), (u16*)(ws + OFF_V), (u16*)(ws + OFF_Q), lds + 32768};
      gemm_phase64<EpiKVQ, 2>(p, (const u16*)(ws + OFF_HBT), 1024, (const u16*)(ws + OFF_WKVQ), 1024, 64, 24, 16, e, lds);
    } break;
    case 11: attn_phase(p, lds); break;
    case 12: attn_combine(p); break;
    case 13: {
      EpiResidual<true> e{nullptr, (u16*)(ws + OFF_HBT), (float*)(ws + OFF_SS3)};
      gemm_phase64(p, (const u16*)(ws + OFF_AO), 512, (const u16*)(ws + OFF_WO), 512, 64, 8, 8, e, lds);
    } break;
    case 14: {
      EpiTopk e{(const float*)(ws + OFF_SS3), (int*)(ws + OFF_EX), (float*)(ws + OFF_GT), lds + 32768 + (opaque_tid() >> 6) * 6144};
      gemm_phase<EpiTopk, 0, true>(p, (const u16*)(ws + OFF_HBT), 1024, (const u16*)(ws + OFF_WPQ1), 1024, 128, 16, 16, e, lds);
    } break;
    case 15: peer_s1(p, 1, xcd_slot(p, myrank)); break;
    case 16: peer_zmerge(p, 1, (const float*)(ws + OFF_SS3)); break;
    case 17: peer_s2<true>(p, 1, nullptr, xcd_slot(p, myrank)); break;
    default: break;
  }
}

#if MEGA
#ifndef PROBE_MASK
#define PROBE_MASK 0
#endif
__global__ void __launch_bounds__(NTHREADS, 2) yoco_mega(Params p) {
  __shared__ __attribute__((aligned(16))) unsigned char lds[LDS_BYTES];
  __shared__ uint4 xb_words;
  if (threadIdx.x == 0) {
    const unsigned myx = (unsigned)__builtin_amdgcn_s_getreg((3 << 11) | 20) & 0xFu;
    const unsigned rk = __hip_atomic_fetch_add((unsigned*)(p.ws + OFF_CENSUS) + myx, 1u, __ATOMIC_RELAXED, __HIP_MEMORY_SCOPE_AGENT);
    xb_words = make_uint4(0u, 0u, rk, 0u);
  }
  __syncthreads();
  (void)xcd_barrier_post((unsigned*)p.ws, (volatile LAS unsigned*)&xb_words);
#define GRID_BAR() do { XcdBarrier b_; b_.bar = (unsigned*)p.ws; b_.x = xb_xcc_id(); b_.st = (volatile LAS unsigned*)&xb_words; xcd_barrier(b_); } while (0)
#define MYRANK() (((volatile unsigned*)&xb_words)[2])
#define PHASE(n) do { run_phase<n>(p, lds, MYRANK()); GRID_BAR(); if (PROBE_MASK & (1 << n)) { run_phase<n>(p, lds, MYRANK()); GRID_BAR(); } } while (0)
  PHASE(0); PHASE(1); PHASE(2); PHASE(3); PHASE(4); PHASE(5); PHASE(6); PHASE(7); PHASE(8); PHASE(9);
  PHASE(10); PHASE(11); PHASE(12); PHASE(13); PHASE(14); PHASE(15); PHASE(16);
  run_phase<17>(p, lds, MYRANK());
}
#endif

extern "C" void kernel_launch(void* const* d_in, const int* in_sizes, int n_in, void* d_out, int out_size, void* d_ws, size_t ws_size,
                              hipStream_t stream) {
  if (n_in != 18 || ws_size < WS_NEED) {
    fprintf(stderr, "kernel_launch: unexpected inputs (n_in %d, ws %zu, need %zu)\n", n_in, ws_size, (size_t)WS_NEED);
    return;
  }
  Params p{};
  p.x = (const float*)d_in[0]; p.hgrn_norm = (const float*)d_in[1]; p.hgrn_w_in = (const float*)d_in[2]; p.hgrn_lb = (const float*)d_in[3];
  p.hgrn_out_norm = (const float*)d_in[4]; p.hgrn_w_out = (const float*)d_in[5]; p.kv_norm = (const float*)d_in[6]; p.w_kv = (const float*)d_in[7];
  p.k_norm = (const float*)d_in[8]; p.attn_norm = (const float*)d_in[9]; p.w_q = (const float*)d_in[10]; p.q_norm = (const float*)d_in[11];
  p.w_o = (const float*)d_in[12]; p.ffn_norm = (const float*)d_in[13]; p.peer_w_q = (const float*)d_in[14]; p.peer_sub_keys = (const float*)d_in[15];
  p.peer_u = (const float*)d_in[16]; p.peer_v = (const float*)d_in[17];
  p.out = (float*)d_out; p.ws = (unsigned char*)d_ws;
#if MEGA
  static int grid_blocks = 0;
  if (!grid_blocks) {
    int dev = 0, cus = 0, per_cu = 0;
    (void)hipGetDevice(&dev);
    (void)hipDeviceGetAttribute(&cus, hipDeviceAttributeMultiprocessorCount, dev);
    (void)hipOccupancyMaxActiveBlocksPerMultiprocessor(&per_cu, yoco_mega, NTHREADS, 0);
    if (per_cu > 2) per_cu = 2;
    if (per_cu < 1) per_cu = 1;
    grid_blocks = cus * per_cu;
  }
  if (hipMemsetAsync(d_ws, 0, 16384, stream) != hipSuccess) { fprintf(stderr, "kernel_launch: memset of barrier words failed\n"); return; }
  void* args[] = {&p};
  hipError_t e = hipLaunchCooperativeKernel((void*)yoco_mega, dim3(grid_blocks), dim3(NTHREADS), args, 0, stream);
  if (e != hipSuccess) fprintf(stderr, "cooperative launch failed: %s (grid %d)\n", hipGetErrorString(e), grid_blocks);
#endif
}
```

```cpp
#include <hip/hip_runtime.h>
#include <hip/hip_cooperative_groups.h>
#include <cstdio>
#include <cstdint>
namespace cg = cooperative_groups;

#ifndef MEGA
#define MEGA 1
#endif

#define DI __device__ __forceinline__
#define LAS __attribute__((address_space(3)))
typedef unsigned short u16;
typedef __attribute__((ext_vector_type(8))) short bf16x8;
typedef __attribute__((ext_vector_type(16))) float f32x16;
typedef __attribute__((ext_vector_type(2))) float f32x2;
typedef __attribute__((ext_vector_type(2))) __bf16 bf16x2_t;
typedef __attribute__((ext_vector_type(4))) unsigned u32x4;
typedef __attribute__((ext_vector_type(2))) unsigned u32x2;

#define MFMA32(a, b, c) __builtin_amdgcn_mfma_f32_32x32x16_bf16((a), (b), (c), 0, 0, 0)

constexpr int T_TOK = 16384;
constexpr int DM = 1024;
constexpr int SEQ = 8192;
constexpr float EPS = 1e-6f;
constexpr int NTHREADS = 256;
constexpr int LDS_BYTES = 65536;

constexpr size_t MiB = 1u << 20;
constexpr size_t OFF_LB = 64 * 1024;
constexpr size_t OFF_MISC = 68 * 1024;
constexpr size_t OFF_RSTD0 = 128 * 1024;
constexpr size_t OFF_SS1 = 29 * MiB;
constexpr size_t OFF_RSTD2 = 256 * 1024;
constexpr size_t OFF_SS3 = 30 * MiB;
constexpr size_t OFF_LG = 1 * MiB;
constexpr size_t OFF_ROPE = 2 * MiB;
constexpr size_t OFF_ACH = 3 * MiB;
constexpr size_t OFF_WIN = 4 * MiB;
constexpr size_t OFF_WOUT = 12 * MiB;
constexpr size_t OFF_WPQ0 = 14 * MiB;
constexpr size_t OFF_WKVQ = 18 * MiB;
constexpr size_t OFF_WO = 24 * MiB;
constexpr size_t OFF_WPQ1 = 25 * MiB;
constexpr size_t OFF_UV0 = 32 * MiB;
constexpr size_t OFF_UV1 = 64 * MiB;
constexpr size_t OFF_SC0 = 31 * MiB;
constexpr size_t OFF_SC1 = 31 * MiB + 256 * 1024;
constexpr size_t OFF_HB = 160 * MiB;
constexpr size_t OFF_QG = 192 * MiB;
constexpr size_t OFF_KG = 224 * MiB;
constexpr size_t OFF_LOGF = 256 * MiB;
constexpr size_t OFF_VG = 320 * MiB;
constexpr size_t OFF_GG = 352 * MiB;
constexpr size_t OFF_UT = 384 * MiB;
constexpr size_t OFF_OG = 448 * MiB;
constexpr size_t WS_NEED = 480 * MiB;
constexpr size_t OFF_K = 208 * MiB;
constexpr size_t OFF_V = 232 * MiB;
constexpr size_t OFF_Q = 256 * MiB;
constexpr size_t OFF_OGA = 304 * MiB;
constexpr size_t OFF_AO = 352 * MiB;
constexpr size_t OFF_EX = 368 * MiB;
constexpr size_t OFF_GT = 376 * MiB;
constexpr size_t OFF_ACT = 384 * MiB;
constexpr size_t OFF_SS2 = 30 * MiB + 512 * 1024;
constexpr size_t OFF_HBT = OFF_HB;
constexpr size_t OFF_HQ = 192 * MiB;
constexpr size_t OFF_HS = 31 * MiB + 512 * 1024;
constexpr size_t OFF_ZP = 392 * MiB;
constexpr size_t OFF_DUMMY = 512 * 1024;
constexpr size_t OFF_CENSUS = 15 * 1024;

struct Params {
  const float *x, *hgrn_norm, *hgrn_w_in, *hgrn_lb, *hgrn_out_norm, *hgrn_w_out, *kv_norm, *w_kv, *k_norm, *attn_norm, *w_q,
      *q_norm, *w_o, *ffn_norm, *peer_w_q, *peer_sub_keys, *peer_u, *peer_v;
  float* out;
  unsigned char* ws;
};

DI int opaque_tid() { int t = threadIdx.x; asm volatile("" : "+v"(t)); return t; }
DI int crow(int r, int h) { return (r & 3) + 8 * (r >> 2) + 4 * h; }
DI unsigned pack2(float a, float b) {
  f32x2 v = {a, b};
  return __builtin_bit_cast(unsigned, __builtin_convertvector(v, bf16x2_t));
}
DI u16 f2bf(float f) { return (u16)(pack2(f, 0.f) & 0xffffu); }
DI float bf2f(u16 h) { return __uint_as_float(((unsigned)h) << 16); }
DI float bflo(unsigned u) { return __uint_as_float(u << 16); }
DI float bfhi(unsigned u) { return __uint_as_float(u & 0xffff0000u); }
DI float sigmoidf_(float v) { return 1.f / (1.f + __expf(-v)); }
DI float siluf_(float v) { return v / (1.f + __expf(-v)); }
DI float gelu_tanh(float z) {
  const float y = 0.7978845608028654f * (z + 0.044715f * z * z * z);
  const float t = 1.f - 2.f / (1.f + __expf(2.f * y));
  return 0.5f * z * (1.f + t);
}
DI size_t tiledA(int t, int col, int K) {
  return (size_t)(t >> 5) * (32 * (size_t)K) + (size_t)((((col >> 6) * 4 + ((col >> 4) & 3)) * 64 + ((col >> 3) & 1) * 32 + (t & 31)) * 8 + (col & 7));
}
DI int off128(int row, int c) { return row * 128 + ((c ^ ((row >> 1) & 7)) << 4); }
DI int off256(int row, int c) { return row * 256 + ((c ^ (row & 15)) << 4); }
DI int key_of(float f) { int k = __float_as_int(f); k ^= (k >> 31) & 0x7fffffff; return k; }
DI float val_of(int k) { k ^= (k >> 31) & 0x7fffffff; return __int_as_float(k); }
DI unsigned pack_i8x4(float a, float b, float c, float d) {
  const float M = 12582912.f;
  const unsigned ua = __float_as_uint(a + M), ub = __float_as_uint(b + M), uc = __float_as_uint(c + M), ud = __float_as_uint(d + M);
  return __builtin_amdgcn_perm(ub, ua, 0x0c0c0400u) | __builtin_amdgcn_perm(ud, uc, 0x04000c0cu);
}
DI float rstd_from_partials(const float* ss, int m) {
  const float4 a = *(const float4*)(ss + (size_t)m * 8), b = *(const float4*)(ss + (size_t)m * 8 + 4);
  const float t = ((a.x + a.y) + (a.z + a.w)) + ((b.x + b.y) + (b.z + b.w));
  return rsqrtf(t * (1.f / 1024.f) + EPS);
}

template <int N>
DI void bitonic_sort_desc(int (&a)[N]) {
#pragma unroll
  for (int k = 2; k <= N; k <<= 1)
#pragma unroll
    for (int j = k >> 1; j > 0; j >>= 1)
#pragma unroll
      for (int i = 0; i < N; ++i) {
        const int l = i ^ j;
        if (l > i) {
          const int hi = max(a[i], a[l]), lo = min(a[i], a[l]);
          if ((i & k) == 0) { a[i] = hi; a[l] = lo; } else { a[i] = lo; a[l] = hi; }
        }
      }
}
DI void merge_top16(int (&a)[16], const int (&b)[16]) {
#pragma unroll
  for (int i = 0; i < 16; ++i) a[i] = max(a[i], b[15 - i]);
#pragma unroll
  for (int j = 8; j > 0; j >>= 1)
#pragma unroll
    for (int i = 0; i < 16; ++i) {
      const int l = i ^ j;
      if (l > i) { const int hi = max(a[i], a[l]), lo = min(a[i], a[l]); a[i] = hi; a[l] = lo; }
    }
}
#define TOPK_INSERT(a, xk) do { int _x = (xk); _Pragma("unroll") for (int _j = 0; _j < 16; ++_j) { int _t = max(a[_j], _x); _x = min(a[_j], _x); a[_j] = _t; } } while (0)

constexpr int N_TR = 1024 + 256 + 384 + 384 + 128;
constexpr int N_CP = 1024;
constexpr int N_UV = 8192;
constexpr int N_X = 512;
constexpr int N_ROPE = 512;
constexpr int N_MISC = 64;
constexpr int N_P0 = N_TR + N_CP + N_X + N_ROPE + N_MISC;

DI void p0_transpose_tile(const float* src, int N, const float* gain, u16* dst, int ld, int rowoff, int kt, int ntile, float* tile) {
  const int tid = opaque_tid();
  const int k0 = kt * 64, n0 = ntile * 64;
#pragma unroll
  for (int i = 0; i < 4; ++i) {
    const int k = i * 16 + (tid >> 4), n = (tid & 15) * 4;
    float4 v = *(const float4*)(src + (size_t)(k0 + k) * N + n0 + n);
    if (gain) { const float gk = gain[k0 + k]; v.x *= gk; v.y *= gk; v.z *= gk; v.w *= gk; }
    tile[k * 65 + n] = v.x; tile[k * 65 + n + 1] = v.y; tile[k * 65 + n + 2] = v.z; tile[k * 65 + n + 3] = v.w;
  }
  __syncthreads();
  {
    const int n = tid >> 2, kq = (tid & 3) * 16;
    unsigned pk[8];
#pragma unroll
    for (int i = 0; i < 8; ++i) pk[i] = pack2(tile[(kq + 2 * i) * 65 + n], tile[(kq + 2 * i + 1) * 65 + n]);
    uint4* d = (uint4*)(dst + (size_t)(rowoff + n0 + n) * ld + k0 + kq);
    d[0] = make_uint4(pk[0], pk[1], pk[2], pk[3]);
    d[1] = make_uint4(pk[4], pk[5], pk[6], pk[7]);
  }
  __syncthreads();
}

DI void p0_prep(const Params& p, unsigned char* lds) {
  const int tid = opaque_tid(), lane = tid & 63, w = tid >> 6;
  unsigned char* ws = p.ws;
  for (int item = blockIdx.x; item < N_P0; item += gridDim.x) {
    int it = item;
    if (it < N_TR) {
      float* tile = (float*)lds;
      if (it < 1024) p0_transpose_tile(p.hgrn_w_in, 4096, p.hgrn_norm, (u16*)(ws + OFF_WIN), 1024, 0, it / 64, it % 64, tile);
      else if (it < 1280) { it -= 1024; p0_transpose_tile(p.hgrn_w_out, 1024, nullptr, (u16*)(ws + OFF_WOUT), 1024, 0, it / 16, it % 16, tile); }
      else if (it < 1664) { it -= 1280; p0_transpose_tile(p.w_kv, 1536, p.kv_norm, (u16*)(ws + OFF_WKVQ), 1024, 0, it / 24, it % 24, tile); }
      else if (it < 2048) { it -= 1664; p0_transpose_tile(p.w_q, 1536, p.attn_norm, (u16*)(ws + OFF_WKVQ), 1024, 1536, it / 24, it % 24, tile); }
      else { it -= 2048; p0_transpose_tile(p.w_o, 1024, nullptr, (u16*)(ws + OFF_WO), 512, 0, it / 16, it % 16, tile); }
      continue;
    }
    it -= N_TR;
    if (it < N_CP) {
      const int l = it >> 9, rem = it & 511, h = rem >> 6, wsel = (rem >> 5) & 1, nh = (rem >> 4) & 1;
      const int c0 = (rem & 15) * 64;
      float* Ws = (float*)lds;
      float* Ks = (float*)(lds + 64 * 65 * 4);
      const float* keys = p.peer_sub_keys + ((size_t)(l * 2 + wsel) * 128 + nh * 64) * 128;
      const float* Wp = p.peer_w_q + (size_t)l * 1024 * 2048 + (size_t)c0 * 2048 + h * 256 + wsel * 128;
      const int ci = w & 1, ni = w >> 1, r31 = lane & 31, kh = lane >> 5;
      f32x16 acc;
#pragma unroll
      for (int r = 0; r < 16; ++r) acc[r] = 0.f;
      for (int ps = 0; ps < 2; ++ps) {
#pragma unroll 4
        for (int i = 0; i < 16; ++i) {
          const int idx = tid + 256 * i, rr = idx >> 6, d = idx & 63;
          Ws[rr * 65 + d] = Wp[(size_t)rr * 2048 + ps * 64 + d] * p.ffn_norm[l * 1024 + c0 + rr];
          Ks[rr * 65 + d] = keys[rr * 128 + ps * 64 + d];
        }
        __syncthreads();
#pragma unroll 8
        for (int s2 = 0; s2 < 32; ++s2)
          acc = __builtin_amdgcn_mfma_f32_32x32x2f32(Ws[(ci * 32 + r31) * 65 + 2 * s2 + kh], Ks[(ni * 32 + r31) * 65 + 2 * s2 + kh], acc, 0, 0, 0);
        __syncthreads();
      }
      u16* dst = (u16*)(ws + (l ? OFF_WPQ1 : OFF_WPQ0)) + (size_t)(h * 256 + wsel * 128 + nh * 64 + ni * 32 + r31) * 1024 + c0 + ci * 32;
#pragma unroll
      for (int g = 0; g < 4; ++g) *(uint2*)(dst + 8 * g + 4 * kh) = make_uint2(pack2(acc[4 * g], acc[4 * g + 1]), pack2(acc[4 * g + 2], acc[4 * g + 3]));
      continue;
    }
    it -= N_CP;
    if (it < N_X) {
      float* xt = (float*)lds;
      const int t0 = it * 32;
      u16* dst = (u16*)(ws + OFF_HB) + (size_t)it * 32768;
      float ssr[8];
#pragma unroll
      for (int i = 0; i < 8; ++i) ssr[i] = 0.f;
      typedef float v4f __attribute__((ext_vector_type(4)));
      v4f xa[8], xb[8];
#define X_LOAD(R, CH) do { _Pragma("unroll") for (int i = 0; i < 8; ++i) R[i] = *(const v4f*)(p.x + (size_t)(t0 + w + 4 * i) * 1024 + (CH) * 256 + lane * 4); } while (0)
#define X_CHUNK(R, CH) do { \
        _Pragma("unroll") for (int i = 0; i < 8; ++i) { ssr[i] += R[i][0] * R[i][0] + R[i][1] * R[i][1] + R[i][2] * R[i][2] + R[i][3] * R[i][3]; *(v4f*)(xt + (w + 4 * i) * 260 + lane * 4) = R[i]; } \
        __syncthreads(); \
        _Pragma("unroll") for (int sl = 0; sl < 4; ++sl) {     \
          const int slot = w * 4 + sl, l31 = lane & 31, hf = lane >> 5; \
          const float4 v0 = *(const float4*)(xt + l31 * 260 + slot * 16 + hf * 8), v1 = *(const float4*)(xt + l31 * 260 + slot * 16 + hf * 8 + 4); \
          *(uint4*)(dst + (size_t)(((CH) * 16 + slot) * 64 + lane) * 8) = make_uint4(pack2(v0.x, v0.y), pack2(v0.z, v0.w), pack2(v1.x, v1.y), pack2(v1.z, v1.w)); } \
        __syncthreads(); } while (0)
      X_LOAD(xa, 0);
      X_LOAD(xb, 1);
      X_CHUNK(xa, 0);
      X_LOAD(xa, 2);
      X_CHUNK(xb, 1);
      X_LOAD(xb, 3);
      X_CHUNK(xa, 2);
      X_CHUNK(xb, 3);
#undef X_LOAD
#undef X_CHUNK
#pragma unroll
      for (int i = 0; i < 8; ++i) {
        float ss = ssr[i];
#pragma unroll
        for (int o = 32; o >= 1; o >>= 1) ss += __shfl_xor(ss, o);
        if (lane == 0) ((float*)(ws + OFF_RSTD0))[t0 + w + 4 * i] = rsqrtf(ss * (1.f / 1024.f) + EPS);
      }
      continue;
    }
    it -= N_X;
    if (it < N_ROPE) {
      const int idx = it * 256 + tid; const int pos = idx >> 4, i = idx & 15;
      const float inv = powf(500000.f, -(float)i * (1.f / 16.f));
      const float ang = (float)pos * inv;
      float s, c; sincosf(ang, &s, &c);
      ((float2*)(ws + OFF_ROPE))[idx] = make_float2(c, s);
      continue;
    }
    it -= N_ROPE;
    {
      const int idx = it * 256 + tid;
      if (idx < 1024) {
        const float l0 = p.hgrn_lb[idx], l1 = p.hgrn_lb[1024 + idx];
        ((float*)(ws + OFF_LB))[idx] = 1.f / (1.f + __expf(l1 - l0));
      }
      if (idx == 0) {
        float mq = 0.f, mk = 0.f;
        for (int i = 0; i < 128; ++i) { mq = fmaxf(mq, fabsf(p.q_norm[i])); mk = fmaxf(mk, fabsf(p.k_norm[i])); }
        ((float*)(ws + OFF_MISC))[0] = 11.313708499f * mq * mk;
      }
    }
  }
}

DI void peer_tables(const Params& p, int l, int ibeg, int iend) {
  const int tid = opaque_tid(), lane = tid & 63, w = tid >> 6;
  unsigned char* ws = p.ws;
  for (int i = ibeg; i < iend; ++i) {
    const int e = (int)(blockIdx.x * 4 + w) + (int)(gridDim.x * 4) * i;
    if (e >= 16384) break;
    const float* su = p.peer_u + ((size_t)l * 16384 + e) * 1024 + lane * 4;
    const float* sv = p.peer_v + ((size_t)l * 16384 + e) * 1024 + lane * 4;
    const float* g = p.ffn_norm + l * 1024 + lane * 4;
    float uu[16], vv[16];
#pragma unroll
    for (int k = 0; k < 4; ++k) {
      const float4 a = *(const float4*)(su + 256 * k); const float4 gg = *(const float4*)(g + 256 * k); const float4 bq = *(const float4*)(sv + 256 * k);
      uu[4 * k] = a.x * gg.x; uu[4 * k + 1] = a.y * gg.y; uu[4 * k + 2] = a.z * gg.z; uu[4 * k + 3] = a.w * gg.w;
      vv[4 * k] = bq.x; vv[4 * k + 1] = bq.y; vv[4 * k + 2] = bq.z; vv[4 * k + 3] = bq.w;
    }
    float mu = 0.f, mv = 0.f;
#pragma unroll
    for (int k = 0; k < 16; ++k) { mu = fmaxf(mu, fabsf(uu[k])); mv = fmaxf(mv, fabsf(vv[k])); }
#pragma unroll
    for (int o = 32; o >= 1; o >>= 1) { mu = fmaxf(mu, __shfl_xor(mu, o)); mv = fmaxf(mv, __shfl_xor(mv, o)); }
    const float scu = mu > 0.f ? mu * (1.f / 127.f) : 1.f, scv = mv > 0.f ? mv * (1.f / 448.f) : 1.f;
    const float iu = 1.f / scu, iv = 1.f / scv;
    unsigned char* base = ws + (l ? OFF_UV1 : OFF_UV0);
#pragma unroll
    for (int k = 0; k < 4; ++k) {
      const int pk = (int)pack_i8x4(uu[4 * k] * iu, uu[4 * k + 1] * iu, uu[4 * k + 2] * iu, uu[4 * k + 3] * iu);
      int pv = 0;
      pv = __builtin_amdgcn_cvt_pk_fp8_f32(vv[4 * k] * iv, vv[4 * k + 1] * iv, pv, false);
      pv = __builtin_amdgcn_cvt_pk_fp8_f32(vv[4 * k + 2] * iv, vv[4 * k + 3] * iv, pv, true);
      const size_t off = ((size_t)(2 * k + (lane >> 5)) * 16384 + e) * 128 + (lane & 31) * 4;
      *(int*)(base + off) = pk;
      *(int*)(base + 16 * MiB + off) = pv;
    }
    if (lane == 0) ((float2*)(ws + (l ? OFF_SC1 : OFF_SC0)))[e] = make_float2(scu, scv);
  }
}

template <class Epi, int SIDE = 0, bool PAIR = false>
DI void gemm_phase(const Params& p, const u16* __restrict__ A, int lda, const u16* __restrict__ Bt, int ldb, int MT, int NT, int nk, Epi& epi, unsigned char* lds) {
  const int ntl = 0;
  const int nrw = (16384 + (int)gridDim.x * 4 - 1) / ((int)gridDim.x * 4);
  int seq = 0;
  const bool side_first = SIDE && (blockIdx.x * 2 >= gridDim.x);
  if (side_first) peer_tables(p, SIDE - 1, 0, nrw);
  const int Gx = (int)gridDim.x, bxx = (int)blockIdx.x;
  const bool two = Gx >= 2;
  const int Gl = two ? (Gx + 1) >> 1 : Gx;
  const bool upper = two && bxx >= Gl;
  const int NU = PAIR ? NT / 2 : NT;
  const int NH = two ? (upper ? NU - (NU >> 1) : (NU >> 1)) : NU;
  const int ubase = upper ? (NU >> 1) : 0;
  const int ustride = upper ? Gx - Gl : Gl;
  for (int u = upper ? bxx - Gl : bxx; u < MT * NH; u += ustride)
  for (int sub = 0; sub < (PAIR ? 2 : 1); ++sub) {
    const int mt = u / NH, unit = (u - mt * NH) + ubase;
    const int tid = opaque_tid(), lane = tid & 63, w = tid >> 6, l31 = lane & 31, half = lane >> 5;
    const int goffB0 = (tid >> 3) * ldb + (tid & 7) * 8;
    const int loffB0 = off128(tid >> 3, tid & 7);
    const int goffA = w * 32 * lda + lane * 8;
    const int lrowF = l31 * 128, lxF = (half ^ ((l31 >> 1) & 7)) << 4;
    const int nt = PAIR ? 2 * unit + sub : unit;
    const int m0 = mt * 128, n0 = nt * 128;
    f32x16 acc[4];
#pragma unroll
    for (int i = 0; i < 4; ++i)
#pragma unroll
      for (int r = 0; r < 16; ++r) acc[i][r] = 0.f;
    const u16* Ab = A + (size_t)m0 * lda + goffA;
    const u16* Bb = Bt + (size_t)n0 * ldb;
    bf16x8 aR[2][4];
    u32x4 bR[4][4];
#define LOAD_A(slot, ks) do { _Pragma("unroll") for (int kk = 0; kk < 4; ++kk) aR[slot][kk] = *(const bf16x8*)(Ab + ((ks) * 4 + kk) * 512); } while (0)
#define LOAD_B(slot, ks) do { _Pragma("unroll") for (int j = 0; j < 4; ++j) bR[slot][j] = *(const u32x4*)(Bb + goffB0 + j * 32 * ldb + (ks) * 64); } while (0)
#define STORE_B(slot, buf) do { _Pragma("unroll") for (int j = 0; j < 4; ++j) *(u32x4*)(lds + (buf) * 16384 + loffB0 + j * 4096) = bR[slot][j]; } while (0)
#define GEMM_STEP(ks, sa, sb) do { \
      const unsigned char* base_ = lds + ((sa) & 1) * 16384; \
      _Pragma("unroll") for (int kk = 0; kk < 4; ++kk) { \
        _Pragma("unroll") for (int n4 = 0; n4 < 4; ++n4) { \
          const bf16x8 wf = *(const bf16x8*)(base_ + n4 * 4096 + lrowF + (lxF ^ (kk << 5))); \
          acc[n4] = MFMA32(wf, aR[(sa) & 1][kk], acc[n4]); } } \
      if ((ks) + 2 < nk) LOAD_A((sa) & 1, (ks) + 2); \
      if ((ks) + 1 < nk) STORE_B(sb, (sb) & 1); \
      if ((ks) + 5 < nk) LOAD_B(sb, (ks) + 5); \
      __syncthreads(); } while (0)
    LOAD_B(0, 0); LOAD_B(1, 1); LOAD_B(2, 2); LOAD_B(3, 3);
    LOAD_A(0, 0); LOAD_A(1, 1);
    STORE_B(0, 0);
    LOAD_B(0, 4);
    __syncthreads();
#pragma unroll 1
    for (int ks = 0; ks < nk; ks += 4) {
      GEMM_STEP(ks, 0, 1);
      GEMM_STEP(ks + 1, 1, 2);
      GEMM_STEP(ks + 2, 2, 3);
      GEMM_STEP(ks + 3, 3, 0);
    }
    epi(acc, m0 + w * 32 + l31, n0, half);
    ++seq;
  }
  if (SIDE && !side_first) peer_tables(p, SIDE - 1, 0, nrw);
  (void)ntl; (void)seq;
#undef LOAD_A
#undef LOAD_B
#undef STORE_B
#undef GEMM_STEP
}

template <class Epi, int SIDE = 0>
DI void gemm_phase64(const Params& p, const u16* __restrict__ A, int lda, const u16* __restrict__ Bt, int ldb, int MT, int NT, int nk, Epi& epi, unsigned char* lds) {
  const int nrw = (16384 + (int)gridDim.x * 4 - 1) / ((int)gridDim.x * 4);
  const bool side_first = SIDE && (blockIdx.x * 2 >= gridDim.x);
  if (side_first) peer_tables(p, SIDE - 1, 0, nrw);
  const int Gx = (int)gridDim.x, bxx = (int)blockIdx.x;
  const bool two = Gx >= 2;
  const int Gl = two ? (Gx + 1) >> 1 : Gx;
  const bool upper = two && bxx >= Gl;
  const int NH = two ? (upper ? NT - (NT >> 1) : (NT >> 1)) : NT;
  const int ubase = upper ? (NT >> 1) : 0;
  const int ustride = upper ? Gx - Gl : Gl;
  for (int u = upper ? bxx - Gl : bxx; u < MT * NH; u += ustride) {
    const int mt = u / NH, nt = (u - mt * NH) + ubase;
    const int tid = opaque_tid(), lane = tid & 63, w = tid >> 6, l31 = lane & 31, half = lane >> 5;
    const int goffB0 = (tid >> 3) * ldb + (tid & 7) * 8;
    const int loffB0 = off128(tid >> 3, tid & 7);
    const int goffA = w * 64 * lda + lane * 8;
    const int lrowF = l31 * 128, lxF = (half ^ ((l31 >> 1) & 7)) << 4;
    const int m0 = mt * 256, n0 = nt * 128;
    f32x16 acc0[4], acc1[4];
#pragma unroll
    for (int i = 0; i < 4; ++i)
#pragma unroll
      for (int r = 0; r < 16; ++r) { acc0[i][r] = 0.f; acc1[i][r] = 0.f; }
    const u16* Ab = A + (size_t)m0 * lda + goffA;
    const u16* Ab1 = Ab + 32 * lda;
    const u16* Bb = Bt + (size_t)n0 * ldb;
    bf16x8 aR0[4], aR1[4];
    u32x4 bR[2][4];
#define LOAD_B64(slot, ks) do { _Pragma("unroll") for (int j = 0; j < 4; ++j) bR[slot][j] = *(const u32x4*)(Bb + goffB0 + j * 32 * ldb + (ks) * 64); } while (0)
#define STORE_B64(slot, buf) do { _Pragma("unroll") for (int j = 0; j < 4; ++j) *(u32x4*)(lds + (buf) * 16384 + loffB0 + j * 4096) = bR[slot][j]; } while (0)
#define STEP64(ks, buf, st) do { \
      const unsigned char* base_ = lds + (buf) * 16384; \
      const int kn_ = min((ks) + 1, nk - 1), kb_ = min((ks) + 3, nk - 1); \
      _Pragma("unroll") for (int kk = 0; kk < 4; ++kk) { \
        _Pragma("unroll") for (int n4 = 0; n4 < 4; ++n4) { \
          const bf16x8 wf = *(const bf16x8*)(base_ + n4 * 4096 + lrowF + (lxF ^ (kk << 5))); \
          acc0[n4] = MFMA32(wf, aR0[kk], acc0[n4]); \
          acc1[n4] = MFMA32(wf, aR1[kk], acc1[n4]); } \
        aR0[kk] = *(const bf16x8*)(Ab + (kn_ * 4 + kk) * 512); \
        aR1[kk] = *(const bf16x8*)(Ab1 + (kn_ * 4 + kk) * 512); } \
      STORE_B64(st, (buf) ^ 1); \
      LOAD_B64(st, kb_); \
      __syncthreads(); } while (0)
    LOAD_B64(0, 0); LOAD_B64(1, 1);
#pragma unroll
    for (int kk = 0; kk < 4; ++kk) { aR0[kk] = *(const bf16x8*)(Ab + kk * 512); aR1[kk] = *(const bf16x8*)(Ab1 + kk * 512); }
    STORE_B64(0, 0);
    LOAD_B64(0, min(2, nk - 1));
    __syncthreads();
#pragma unroll 1
    for (int ks = 0; ks < nk; ks += 2) {
      STEP64(ks, 0, 1);
      STEP64(ks + 1, 1, 0);
    }
    epi(acc0, m0 + w * 64 + l31, n0, half);
    epi(acc1, m0 + w * 64 + 32 + l31, n0, half);
  }
  if (SIDE && !side_first) peer_tables(p, SIDE - 1, 0, nrw);
#undef LOAD_B64
#undef STORE_B64
#undef STEP64
}

struct EpiNull {
  DI void operator()(f32x16 (&acc)[4], int m, int n0, int half) const {
#pragma unroll
    for (int i = 0; i < 4; ++i)
#pragma unroll
      for (int r = 0; r < 16; ++r) asm volatile("" :: "v"(acc[i][r]));
  }
};
struct EpiHgrnIn {
  const float* rstd; const float* lb; u16 *Qg, *Vg, *Gg; _Float16* LOGF;
  DI void operator()(f32x16 (&acc)[4], int m, int n0, int half) const {
    const float rs = rstd[m];
    const int sec = n0 >> 10, colb = n0 & 1023;
    const int pos = m & (SEQ - 1);
    const size_t tb0 = ((size_t)(((m >> 13) * 8 + (colb >> 7)) * 128 + (pos >> 6))) * 8192 + (size_t)(pos & 63) * 4;
#pragma unroll
    for (int n4 = 0; n4 < 4; ++n4)
#pragma unroll
      for (int g = 0; g < 4; ++g) {
        const int dl = n4 * 32 + 8 * g + 4 * half;
        const size_t to = tb0 + (size_t)(dl >> 2) * 256;
        float v[4];
#pragma unroll
        for (int j = 0; j < 4; ++j) v[j] = acc[n4][4 * g + j] * rs;
        if (sec == 0) {
          *(uint2*)(Qg + to) = make_uint2(pack2(siluf_(v[0]), siluf_(v[1])), pack2(siluf_(v[2]), siluf_(v[3])));
        } else if (sec == 1) {
          const float4 lbv = *(const float4*)(lb + colb + dl);
          const float lbs[4] = {lbv.x, lbv.y, lbv.z, lbv.w};
          typedef _Float16 h4 __attribute__((ext_vector_type(4)));
          h4 lf;
#pragma unroll
          for (int j = 0; j < 4; ++j) lf[j] = (_Float16)__logf(lbs[j] + (1.f - lbs[j]) * sigmoidf_(v[j]));
          *(h4*)(LOGF + to) = lf;
        } else if (sec == 2) {
          *(uint2*)(Vg + to) = make_uint2(pack2(v[0], v[1]), pack2(v[2], v[3]));
        } else {
          *(uint2*)(Gg + to) = make_uint2(pack2(siluf_(v[0]), siluf_(v[1])), pack2(siluf_(v[2]), siluf_(v[3])));
        }
      }
  }
};

template <bool RES_TILED>
struct EpiResidual {
  const float* res; u16* hbt; float* ss; unsigned char* hq; float* hs;
  DI void operator()(f32x16 (&acc)[4], int m, int n0, int half) const {
    float s = 0.f, amax = 0.f;
#pragma unroll
    for (int n4 = 0; n4 < 4; ++n4)
#pragma unroll
      for (int g = 0; g < 4; ++g) {
        const int col = n0 + n4 * 32 + 8 * g + 4 * half;
        u16* dst = hbt + tiledA(m, col, 1024);
        float r0, r1, r2, r3;
        if (RES_TILED) { const uint2 rv = *(const uint2*)dst; r0 = bflo(rv.x); r1 = bfhi(rv.x); r2 = bflo(rv.y); r3 = bfhi(rv.y); }
        else { const float4 rv = *(const float4*)(res + (size_t)m * 1024 + col); r0 = rv.x; r1 = rv.y; r2 = rv.z; r3 = rv.w; }
        const float v0 = acc[n4][4 * g] + r0, v1 = acc[n4][4 * g + 1] + r1, v2 = acc[n4][4 * g + 2] + r2, v3 = acc[n4][4 * g + 3] + r3;
        const unsigned p01 = pack2(v0, v1), p23 = pack2(v2, v3);
        *(uint2*)dst = make_uint2(p01, p23);
        s += v0 * v0 + v1 * v1 + v2 * v2 + v3 * v3;
        acc[n4][4 * g] = bflo(p01); acc[n4][4 * g + 1] = bfhi(p01); acc[n4][4 * g + 2] = bflo(p23); acc[n4][4 * g + 3] = bfhi(p23);
        amax = fmaxf(fmaxf(amax, fmaxf(fabsf(acc[n4][4 * g]), fabsf(acc[n4][4 * g + 1]))), fmaxf(fabsf(acc[n4][4 * g + 2]), fabsf(acc[n4][4 * g + 3])));
      }
    s += __shfl_xor(s, 32);
    amax = fmaxf(amax, __shfl_xor(amax, 32));
    const float qi = amax > 0.f ? 127.f / amax : 0.f;
    unsigned char* hrow = hq + ((size_t)(n0 >> 7) * T_TOK + m) * 128 + 4 * half;
#pragma unroll
    for (int n4 = 0; n4 < 4; ++n4)
#pragma unroll
      for (int g = 0; g < 4; ++g)
        *(unsigned*)(hrow + n4 * 32 + 8 * g) = pack_i8x4(acc[n4][4 * g] * qi, acc[n4][4 * g + 1] * qi, acc[n4][4 * g + 2] * qi, acc[n4][4 * g + 3] * qi);
    if (half == 0) hs[(size_t)(n0 >> 7) * T_TOK + m] = amax * (1.f / 127.f);
    if (half == 0) ss[(size_t)m * 8 + (n0 >> 7)] = s;
  }
};

struct EpiTopk {
  const float* ss; int* EX; float* GT; unsigned char* sel_lds;
  DI void operator()(f32x16 (&acc)[4], int m, int n0, int half) {
    const float rs = rstd_from_partials(ss, m);
    int k0[16], k1[16];
#pragma unroll
    for (int r = 0; r < 16; ++r) {
      k0[r] = (key_of(acc[0][r] * rs) & ~0x7f) | (crow(r, half));
      k1[r] = (key_of(acc[1][r] * rs) & ~0x7f) | (32 + crow(r, half));
    }
    bitonic_sort_desc<16>(k0);
    __builtin_amdgcn_sched_barrier(0);
    bitonic_sort_desc<16>(k1);
    merge_top16(k0, k1);
    __builtin_amdgcn_sched_barrier(0);
#pragma unroll
    for (int r = 0; r < 16; ++r) k1[r] = (key_of(acc[2][r] * rs) & ~0x7f) | (64 + crow(r, half));
    bitonic_sort_desc<16>(k1);
    merge_top16(k0, k1);
    __builtin_amdgcn_sched_barrier(0);
#pragma unroll
    for (int r = 0; r < 16; ++r) k1[r] = (key_of(acc[3][r] * rs) & ~0x7f) | (96 + crow(r, half));
    bitonic_sort_desc<16>(k1);
    merge_top16(k0, k1);
    __builtin_amdgcn_sched_barrier(0);
    int b[16];
#pragma unroll
    for (int j = 0; j < 16; ++j) b[j] = __shfl_xor(k0[j], 32);
    merge_top16(k0, b);
    volatile LAS int* stash = (volatile LAS int*)(sel_lds + 2048 + (threadIdx.x & 63) * 64);
    if (((n0 >> 7) & 1) == 0) {
#pragma unroll
      for (int j = 0; j < 16; ++j) stash[j] = k0[j];
      return;
    }
    int kprev[16];
#pragma unroll
    for (int j = 0; j < 16; ++j) kprev[j] = stash[j];
#define F1(i) val_of(kprev[i] & ~0x7f)
#define F2(j) val_of(k0[j] & ~0x7f)
    int a[16];
#pragma unroll
    for (int j = 0; j < 16; ++j) a[j] = (int)0x80000000;
#define SEL_PAIR(IA, JA, IB, JB) do { const int ka_ = (key_of(F1(IA) + F2(JA)) & ~0xff) | ((IA) * 16 + (JA)), kb_ = (key_of(F1(IB) + F2(JB)) & ~0xff) | ((IB) * 16 + (JB)); \
      const int kk_ = half ? kb_ : ka_; TOPK_INSERT(a, kk_); } while (0)
      SEL_PAIR(0, 0, 0, 1);
      SEL_PAIR(0, 2, 0, 3);
      SEL_PAIR(0, 4, 0, 5);
      SEL_PAIR(0, 6, 0, 7);
      SEL_PAIR(0, 8, 0, 9);
      SEL_PAIR(0, 10, 0, 11);
      SEL_PAIR(0, 12, 0, 13);
      SEL_PAIR(0, 14, 0, 15);
      SEL_PAIR(1, 0, 1, 1);
      SEL_PAIR(1, 2, 1, 3);
      SEL_PAIR(1, 4, 1, 5);
      SEL_PAIR(1, 6, 1, 7);
      SEL_PAIR(2, 0, 2, 1);
      SEL_PAIR(2, 2, 2, 3);
      SEL_PAIR(2, 4, 3, 0);
      SEL_PAIR(3, 1, 3, 2);
      SEL_PAIR(3, 3, 4, 0);
      SEL_PAIR(4, 1, 4, 2);
      SEL_PAIR(5, 0, 5, 1);
      SEL_PAIR(6, 0, 6, 1);
      SEL_PAIR(7, 0, 7, 1);
      SEL_PAIR(8, 0, 9, 0);
      SEL_PAIR(10, 0, 11, 0);
      SEL_PAIR(12, 0, 13, 0);
      SEL_PAIR(14, 0, 15, 0);
#undef SEL_PAIR
#undef F1
#undef F2
#pragma unroll
    for (int j = 0; j < 16; ++j) b[j] = __shfl_xor(a[j], 32);
    merge_top16(a, b);
    volatile LAS unsigned char* my = (volatile LAS unsigned char*)(sel_lds + (m & 31) * 36);
    {
      unsigned pk4[4];
#pragma unroll
      for (int q = 0; q < 4; ++q) {
        const int s0 = half ? k0[4 * q] : kprev[4 * q], s1 = half ? k0[4 * q + 1] : kprev[4 * q + 1], s2 = half ? k0[4 * q + 2] : kprev[4 * q + 2], s3 = half ? k0[4 * q + 3] : kprev[4 * q + 3];
        pk4[q] = (unsigned)(s0 & 0x7f) | ((unsigned)(s1 & 0x7f) << 8) | ((unsigned)(s2 & 0x7f) << 16) | ((unsigned)(s3 & 0x7f) << 24);
      }
#pragma unroll
      for (int q = 0; q < 4; ++q) *(volatile LAS unsigned*)(my + half * 16 + 4 * q) = pk4[q];
    }
    asm volatile("s_waitcnt lgkmcnt(0)" ::: "memory");
    float cs[16];
    float sum = 0.f;
    const float mx = val_of(a[0] & ~0xff);
#pragma unroll
    for (int k = 0; k < 16; ++k) { cs[k] = __expf(val_of(a[k] & ~0xff) - mx); sum += cs[k]; }
    const float inv = 1.f / sum;
    const int hcol = (n0 >> 8) * 16;
    if (half == 0) {
      int eo[16];
#pragma unroll
      for (int k = 0; k < 16; ++k) { const int ij = a[k] & 0xff; eo[k] = (int)my[ij >> 4] * 128 + (int)my[16 + (ij & 15)]; }
      int4* de = (int4*)(EX + (size_t)m * 128 + hcol);
#pragma unroll
      for (int q = 0; q < 4; ++q) de[q] = make_int4(eo[4 * q], eo[4 * q + 1], eo[4 * q + 2], eo[4 * q + 3]);
    } else {
      float4* dg = (float4*)(GT + (size_t)m * 128 + hcol);
#pragma unroll
      for (int q = 0; q < 4; ++q) dg[q] = make_float4(cs[4 * q] * inv, cs[4 * q + 1] * inv, cs[4 * q + 2] * inv, cs[4 * q + 3] * inv);
    }
  }
};

struct EpiKVQ {
  const float* ss; const float *k_norm, *q_norm; const float2* rope; u16 *Kb, *Vb, *Qb; unsigned char* stage;
  DI void operator()(f32x16 (&acc)[4], int m, int n0, int half) const {
    const float rs = rstd_from_partials(ss, m);
    u16* dst; const float* gain = nullptr; int ld;
    if (n0 < 768) { dst = Kb + (size_t)m * 768 + n0; gain = k_norm; ld = 768; }
    else if (n0 < 1536) { dst = Vb + (size_t)m * 768 + (n0 - 768); ld = 768; }
    else { dst = Qb + (size_t)m * 1536 + (n0 - 1536); gain = q_norm; ld = 1536; }
#pragma unroll
    for (int n4 = 0; n4 < 4; ++n4)
#pragma unroll
      for (int r = 0; r < 16; ++r) acc[n4][r] *= rs;
    if (gain) {
      float s = 0.f;
#pragma unroll
      for (int n4 = 0; n4 < 4; ++n4)
#pragma unroll
        for (int r = 0; r < 16; ++r) s += acc[n4][r] * acc[n4][r];
      s += __shfl_xor(s, 32);
      const float rn = rsqrtf(s * (1.f / 128.f) + EPS);
#pragma unroll
      for (int n4 = 0; n4 < 4; ++n4)
#pragma unroll
        for (int g = 0; g < 4; ++g) {
          const float4 gv = *(const float4*)(gain + n4 * 32 + 8 * g + 4 * half);
          acc[n4][4 * g] *= rn * gv.x; acc[n4][4 * g + 1] *= rn * gv.y; acc[n4][4 * g + 2] *= rn * gv.z; acc[n4][4 * g + 3] *= rn * gv.w;
        }
      const int pos = m & (SEQ - 1);
#pragma unroll
      for (int r = 0; r < 8; ++r) {
        const float2 cs = rope[pos * 16 + crow(r, half)];
        const float x1 = acc[0][r], x2 = acc[0][r + 8];
        acc[0][r] = x1 * cs.x - x2 * cs.y;
        acc[0][r + 8] = x2 * cs.x + x1 * cs.y;
      }
    }
    unsigned char* st = stage + (threadIdx.x >> 6) * 4352;
    const int l31 = threadIdx.x & 31;
    const int rr = (threadIdx.x & 63) >> 3, cc = threadIdx.x & 7;
    u16* dbase = dst - (size_t)l31 * ld;
#pragma unroll
    for (int ps = 0; ps < 2; ++ps) {
#pragma unroll
      for (int n2 = 0; n2 < 2; ++n2)
#pragma unroll
        for (int g = 0; g < 4; ++g)
          *(uint2*)(st + l31 * 136 + (n2 * 32 + 8 * g + 4 * half) * 2) = make_uint2(pack2(acc[ps * 2 + n2][4 * g], acc[ps * 2 + n2][4 * g + 1]), pack2(acc[ps * 2 + n2][4 * g + 2], acc[ps * 2 + n2][4 * g + 3]));
      asm volatile("s_waitcnt lgkmcnt(0)" ::: "memory");
#pragma unroll
      for (int i = 0; i < 4; ++i) {
        const uint2 a = *(const uint2*)(st + (rr + 8 * i) * 136 + cc * 16), b = *(const uint2*)(st + (rr + 8 * i) * 136 + cc * 16 + 8);
        *(uint4*)(dbase + (size_t)(rr + 8 * i) * ld + ps * 64 + cc * 8) = make_uint4(a.x, a.y, b.x, b.y);
      }
      asm volatile("s_waitcnt lgkmcnt(0)" ::: "memory");
    }
  }
};

DI void gla_g1(const Params& p, unsigned char* lds) {
  const int tid = opaque_tid(), lane = tid & 63, w = tid >> 6, l31 = lane & 31, half = lane >> 5;
  unsigned char* ws = p.ws;
  const _Float16* LOGF = (const _Float16*)(ws + OFF_LOGF);
  const u16* Vg = (const u16*)(ws + OFF_VG);
  u16* UT = (u16*)(ws + OFF_UT);
  float* ACH = (float*)(ws + OFF_ACH);
  unsigned char* KT = lds;
  unsigned char* VT = lds + 16384;
  float* tot = (float*)(lds + 32768);
  for (int item = blockIdx.x; item < 2048; item += gridDim.x) {
    const int bh = item >> 7, c = item & 127, b = bh >> 3, h = bh & 7;
    (void)b; (void)h;
    const int dg = tid & 31, jr = tid >> 5, d0 = dg * 4;
    const size_t tb = (size_t)item * 8192 + (size_t)(dg * 64 + jr * 8) * 4;
    float lfv[8][4], bl[8][4];
    {
      typedef _Float16 h8 __attribute__((ext_vector_type(8)));
      float run[4] = {0.f, 0.f, 0.f, 0.f};
#pragma unroll
      for (int q = 0; q < 4; ++q) {
        const h8 lf = *(const h8*)(LOGF + tb + 8 * q);
#pragma unroll
        for (int i = 0; i < 8; ++i) { const int jj = 2 * q + (i >> 2), dd = i & 3; lfv[jj][dd] = (float)lf[i]; run[dd] += lfv[jj][dd]; bl[jj][dd] = run[dd]; }
      }
      *(float4*)(tot + jr * 128 + d0) = make_float4(run[0], run[1], run[2], run[3]);
    }
    __syncthreads();
    float pre[4] = {0.f, 0.f, 0.f, 0.f}, blast[4] = {0.f, 0.f, 0.f, 0.f};
#pragma unroll
    for (int r = 0; r < 8; ++r) {
      const float4 tv = *(const float4*)(tot + r * 128 + d0);
      const float m_ = (r < jr) ? 1.f : 0.f;
      pre[0] += m_ * tv.x; pre[1] += m_ * tv.y; pre[2] += m_ * tv.z; pre[3] += m_ * tv.w;
      blast[0] += tv.x; blast[1] += tv.y; blast[2] += tv.z; blast[3] += tv.w;
    }
#pragma unroll
    for (int dd = 0; dd < 4; ++dd) {
      unsigned pk[4];
#pragma unroll
      for (int i = 0; i < 4; ++i)
        pk[i] = pack2((1.f - __expf(lfv[2 * i][dd])) * __expf(blast[dd] - (bl[2 * i][dd] + pre[dd])), (1.f - __expf(lfv[2 * i + 1][dd])) * __expf(blast[dd] - (bl[2 * i + 1][dd] + pre[dd])));
      *(uint4*)(KT + off128(d0 + dd, jr)) = make_uint4(pk[0], pk[1], pk[2], pk[3]);
    }
    {
      uint4 vq[4];
#pragma unroll
      for (int q = 0; q < 4; ++q) vq[q] = *(const uint4*)(Vg + tb + 8 * q);
      *(uint4*)(VT + off128(d0 + 0, jr)) = make_uint4((vq[0].x & 0xffffu) | (vq[0].z << 16), (vq[1].x & 0xffffu) | (vq[1].z << 16), (vq[2].x & 0xffffu) | (vq[2].z << 16), (vq[3].x & 0xffffu) | (vq[3].z << 16));
      *(uint4*)(VT + off128(d0 + 1, jr)) = make_uint4((vq[0].x >> 16) | (vq[0].z & 0xffff0000u), (vq[1].x >> 16) | (vq[1].z & 0xffff0000u), (vq[2].x >> 16) | (vq[2].z & 0xffff0000u), (vq[3].x >> 16) | (vq[3].z & 0xffff0000u));
      *(uint4*)(VT + off128(d0 + 2, jr)) = make_uint4((vq[0].y & 0xffffu) | (vq[0].w << 16), (vq[1].y & 0xffffu) | (vq[1].w << 16), (vq[2].y & 0xffffu) | (vq[2].w << 16), (vq[3].y & 0xffffu) | (vq[3].w << 16));
      *(uint4*)(VT + off128(d0 + 3, jr)) = make_uint4((vq[0].y >> 16) | (vq[0].w & 0xffff0000u), (vq[1].y >> 16) | (vq[1].w & 0xffff0000u), (vq[2].y >> 16) | (vq[2].w & 0xffff0000u), (vq[3].y >> 16) | (vq[3].w & 0xffff0000u));
    }
    if (jr == 0) *(float4*)(ACH + item * 128 + d0) = make_float4(__expf(blast[0]), __expf(blast[1]), __expf(blast[2]), __expf(blast[3]));
    __syncthreads();
    f32x16 acc[4];
#pragma unroll
    for (int i = 0; i < 4; ++i)
#pragma unroll
      for (int r = 0; r < 16; ++r) acc[i][r] = 0.f;
#pragma unroll
    for (int s = 0; s < 4; ++s) {
      const bf16x8 af = *(const bf16x8*)(KT + off128(w * 32 + l31, 2 * s + half));
#pragma unroll
      for (int et = 0; et < 4; ++et) {
        const bf16x8 bfr = *(const bf16x8*)(VT + off128(et * 32 + l31, 2 * s + half));
        acc[et] = MFMA32(af, bfr, acc[et]);
      }
    }
#pragma unroll
    for (int et = 0; et < 4; ++et)
#pragma unroll
      for (int g = 0; g < 4; ++g) {
        const int e = et * 32 + l31, d0 = w * 32 + 8 * g + 4 * half;
        *(uint2*)(UT + ((size_t)item * 128 + e) * 128 + d0) = make_uint2(pack2(acc[et][4 * g], acc[et][4 * g + 1]), pack2(acc[et][4 * g + 2], acc[et][4 * g + 3]));
      }
    __syncthreads();
  }
}

DI void gla_g2(const Params& p) {
  const int tid = opaque_tid();
  unsigned char* ws = p.ws;
  u16* UT = (u16*)(ws + OFF_UT);
  const float* ACH = (const float*)(ws + OFF_ACH);
  for (int u = blockIdx.x; u < 1024; u += gridDim.x) {
    const int bh = u >> 6, e = (u & 63) * 2 + (tid >> 7), d = tid & 127;
    float S = 0.f;
    size_t idx = ((size_t)bh * 128) * 16384 + (size_t)e * 128 + d;
    size_t aidx = (size_t)bh * 128 * 128 + d;
    for (int c = 0; c < 128; c += 32) {
      float uv[32], av[32];
#pragma unroll
      for (int k = 0; k < 32; ++k) { uv[k] = bf2f(UT[idx + (size_t)k * 16384]); av[k] = ACH[aidx + (size_t)k * 128]; }
#pragma unroll
      for (int k = 0; k < 32; ++k) { UT[idx + (size_t)k * 16384] = f2bf(S); S = av[k] * S + uv[k]; }
      idx += (size_t)32 * 16384; aidx += 32 * 128;
    }
  }
}

DI void gla_g3(const Params& p, unsigned char* lds) {
  const int tid = opaque_tid(), lane = tid & 63, w = tid >> 6, l31 = lane & 31, half = lane >> 5;
  unsigned char* ws = p.ws;
  const _Float16* LOGF = (const _Float16*)(ws + OFF_LOGF);
  const u16* Qg = (const u16*)(ws + OFF_QG);
  const u16* Vg = (const u16*)(ws + OFF_VG);
  const u16* Gg = (const u16*)(ws + OFF_GG);
  const u16* ST = (const u16*)(ws + OFF_UT);
  u16* OG = (u16*)(ws + OFF_OG);
  unsigned char* QP = lds;
  unsigned char* KP = lds + 16384;
  unsigned char* VT = lds + 32768;
  unsigned char* STs = lds + 16384;
  float* tot = (float*)(lds + 49152);
  float* red = (float*)(lds + 49152 + 4096);
  for (int item = blockIdx.x; item < 2048; item += gridDim.x) {
    const int bh = item >> 7, c = item & 127, b = bh >> 3, h = bh & 7;
    const int t0 = b * SEQ + c * 64;
    u32x4 stq[8];
    {
      const u16* src = ST + (size_t)item * 16384;
#pragma unroll
      for (int j = 0; j < 8; ++j) { const int id = tid + 256 * j; stq[j] = *(const u32x4*)(src + (size_t)(id >> 4) * 128 + (id & 15) * 8); }
    }
    u32x2 ggq[2][4];
    {
      const int tq_ = t0 + (w & 1) * 32 + l31;
#pragma unroll
      for (int ee = 0; ee < 2; ++ee)
#pragma unroll
        for (int g = 0; g < 4; ++g) ggq[ee][g] = *(const u32x2*)(Gg + (size_t)item * 8192 + (size_t)(((((w >> 1) * 2 + ee) * 32 + 8 * g + 4 * half) >> 2) * 64 + (w & 1) * 32 + l31) * 4);
    }
    const int dg = tid & 31, jr = tid >> 5, d0 = dg * 4;
    const size_t tb = (size_t)item * 8192 + (size_t)(dg * 64 + jr * 8) * 4;
    float lfv[8][4], bl[8][4];
    {
      typedef _Float16 h8 __attribute__((ext_vector_type(8)));
      float run[4] = {0.f, 0.f, 0.f, 0.f};
#pragma unroll
      for (int q = 0; q < 4; ++q) {
        const h8 lf = *(const h8*)(LOGF + tb + 8 * q);
#pragma unroll
        for (int i = 0; i < 8; ++i) { const int jj = 2 * q + (i >> 2), dd = i & 3; lfv[jj][dd] = (float)lf[i]; run[dd] += lfv[jj][dd]; bl[jj][dd] = run[dd]; }
      }
      *(float4*)(tot + jr * 128 + d0) = make_float4(run[0], run[1], run[2], run[3]);
    }
    __syncthreads();
    float pre[4] = {0.f, 0.f, 0.f, 0.f}, blast[4] = {0.f, 0.f, 0.f, 0.f};
#pragma unroll
    for (int r = 0; r < 8; ++r) {
      const float4 tv = *(const float4*)(tot + r * 128 + d0);
      const float m_ = (r < jr) ? 1.f : 0.f;
      pre[0] += m_ * tv.x; pre[1] += m_ * tv.y; pre[2] += m_ * tv.z; pre[3] += m_ * tv.w;
      blast[0] += tv.x; blast[1] += tv.y; blast[2] += tv.z; blast[3] += tv.w;
    }
    {
      uint4 qq[4];
#pragma unroll
      for (int q = 0; q < 4; ++q) qq[q] = *(const uint4*)(Qg + tb + 8 * q);
#pragma unroll
      for (int jj = 0; jj < 8; ++jj) {
        const int i = jr * 8 + jj;
        const unsigned q01 = (jj & 1) ? qq[jj >> 1].z : qq[jj >> 1].x, q23 = (jj & 1) ? qq[jj >> 1].w : qq[jj >> 1].y;
        const float qf[4] = {bflo(q01), bfhi(q01), bflo(q23), bfhi(q23)};
        float qv[4], kv[4];
#pragma unroll
        for (int dd = 0; dd < 4; ++dd) { const float bv = bl[jj][dd] + pre[dd]; qv[dd] = qf[dd] * __expf(bv); kv[dd] = (1.f - __expf(lfv[jj][dd])) * __expf(-bv); }
        const int o = i * 256 + (((d0 >> 3) ^ (i & 15)) << 4) + (d0 & 7) * 2;
        *(uint2*)(QP + o) = make_uint2(pack2(qv[0], qv[1]), pack2(qv[2], qv[3]));
        *(uint2*)(KP + o) = make_uint2(pack2(kv[0], kv[1]), pack2(kv[2], kv[3]));
      }
    }
    {
      uint4 vq[4];
#pragma unroll
      for (int q = 0; q < 4; ++q) vq[q] = *(const uint4*)(Vg + tb + 8 * q);
      *(uint4*)(VT + off128(d0 + 0, jr)) = make_uint4((vq[0].x & 0xffffu) | (vq[0].z << 16), (vq[1].x & 0xffffu) | (vq[1].z << 16), (vq[2].x & 0xffffu) | (vq[2].z << 16), (vq[3].x & 0xffffu) | (vq[3].z << 16));
      *(uint4*)(VT + off128(d0 + 1, jr)) = make_uint4((vq[0].x >> 16) | (vq[0].z & 0xffff0000u), (vq[1].x >> 16) | (vq[1].z & 0xffff0000u), (vq[2].x >> 16) | (vq[2].z & 0xffff0000u), (vq[3].x >> 16) | (vq[3].z & 0xffff0000u));
      *(uint4*)(VT + off128(d0 + 2, jr)) = make_uint4((vq[0].y & 0xffffu) | (vq[0].w << 16), (vq[1].y & 0xffffu) | (vq[1].w << 16), (vq[2].y & 0xffffu) | (vq[2].w << 16), (vq[3].y & 0xffffu) | (vq[3].w << 16));
      *(uint4*)(VT + off128(d0 + 3, jr)) = make_uint4((vq[0].y >> 16) | (vq[0].w & 0xffff0000u), (vq[1].y >> 16) | (vq[1].w & 0xffff0000u), (vq[2].y >> 16) | (vq[2].w & 0xffff0000u), (vq[3].y >> 16) | (vq[3].w & 0xffff0000u));
    }
    __syncthreads();
    const int it = w & 1, eh = w >> 1;
    f32x16 pt0, pt1;
#pragma unroll
    for (int r = 0; r < 16; ++r) { pt0[r] = 0.f; pt1[r] = 0.f; }
#pragma unroll
    for (int kk = 0; kk < 8; ++kk) {
      const bf16x8 bq = *(const bf16x8*)(QP + off256(it * 32 + l31, 2 * kk + half));
      const bf16x8 a0 = *(const bf16x8*)(KP + off256(l31, 2 * kk + half));
      pt0 = MFMA32(a0, bq, pt0);
      if (it) {
        const bf16x8 a1 = *(const bf16x8*)(KP + off256(32 + l31, 2 * kk + half));
        pt1 = MFMA32(a1, bq, pt1);
      }
    }
    if (it == 0) {
#pragma unroll
      for (int r = 0; r < 16; ++r) if (crow(r, half) > l31) pt0[r] = 0.f;
    } else {
#pragma unroll
      for (int r = 0; r < 16; ++r) if (crow(r, half) > l31) pt1[r] = 0.f;
    }
    bf16x8 pf[2][2];
#pragma unroll
    for (int s = 0; s < 2; ++s) {
      uint4 u0 = make_uint4(pack2(pt0[8 * s], pt0[8 * s + 1]), pack2(pt0[8 * s + 2], pt0[8 * s + 3]), pack2(pt0[8 * s + 4], pt0[8 * s + 5]), pack2(pt0[8 * s + 6], pt0[8 * s + 7]));
      uint4 u1 = make_uint4(pack2(pt1[8 * s], pt1[8 * s + 1]), pack2(pt1[8 * s + 2], pt1[8 * s + 3]), pack2(pt1[8 * s + 4], pt1[8 * s + 5]), pack2(pt1[8 * s + 6], pt1[8 * s + 7]));
      pf[0][s] = __builtin_bit_cast(bf16x8, u0);
      pf[1][s] = __builtin_bit_cast(bf16x8, u1);
    }
    f32x16 acc[2];
#pragma unroll
    for (int i = 0; i < 2; ++i)
#pragma unroll
      for (int r = 0; r < 16; ++r) acc[i][r] = 0.f;
#pragma unroll
    for (int ee = 0; ee < 2; ++ee) {
      const int e = (eh * 2 + ee) * 32 + l31;
#pragma unroll
      for (int jt = 0; jt < 2; ++jt) {
        if (jt <= it) {
#pragma unroll
          for (int s = 0; s < 2; ++s) {
            const int cA = 4 * jt + 2 * s;
            const uint2 lo = *(const uint2*)(VT + off128(e, cA) + 8 * half);
            const uint2 hi = *(const uint2*)(VT + off128(e, cA + 1) + 8 * half);
            const bf16x8 av = __builtin_bit_cast(bf16x8, make_uint4(lo.x, lo.y, hi.x, hi.y));
            acc[ee] = MFMA32(av, pf[jt][s], acc[ee]);
          }
        }
      }
    }
    __syncthreads();
    {
#pragma unroll
      for (int j = 0; j < 8; ++j) {
        const int id = tid + 256 * j, e = id >> 4, cc = id & 15;
        *(u32x4*)(STs + off256(e, cc)) = stq[j];
      }
    }
    __syncthreads();
#pragma unroll
    for (int kk = 0; kk < 8; ++kk) {
      const bf16x8 bq = *(const bf16x8*)(QP + off256(it * 32 + l31, 2 * kk + half));
#pragma unroll
      for (int ee = 0; ee < 2; ++ee) {
        const bf16x8 as = *(const bf16x8*)(STs + off256((eh * 2 + ee) * 32 + l31, 2 * kk + half));
        acc[ee] = MFMA32(as, bq, acc[ee]);
      }
    }
    float ssq = 0.f;
#pragma unroll
    for (int ee = 0; ee < 2; ++ee)
#pragma unroll
      for (int r = 0; r < 16; ++r) ssq += acc[ee][r] * acc[ee][r];
    ssq += __shfl_xor(ssq, 32);
    if (half == 0) red[w * 32 + l31] = ssq;
    __syncthreads();
    const float rn = rsqrtf((red[w * 32 + l31] + red[(w ^ 2) * 32 + l31]) * (1.f / 128.f) + EPS);
    const int t = t0 + it * 32 + l31;
#pragma unroll
    for (int ee = 0; ee < 2; ++ee)
#pragma unroll
      for (int g = 0; g < 4; ++g) {
        const int e0 = (eh * 2 + ee) * 32 + 8 * g + 4 * half;
        const size_t o = (size_t)t * 1024 + h * 128 + e0;
        const uint2 gg = make_uint2(ggq[ee][g][0], ggq[ee][g][1]);
        const float4 og = *(const float4*)(p.hgrn_out_norm + e0);
        const float v0 = acc[ee][4 * g] * rn * og.x * bflo(gg.x), v1 = acc[ee][4 * g + 1] * rn * og.y * bfhi(gg.x);
        const float v2 = acc[ee][4 * g + 2] * rn * og.z * bflo(gg.y), v3 = acc[ee][4 * g + 3] * rn * og.w * bfhi(gg.y);
        *(uint2*)(OG + tiledA(t, h * 128 + e0, 1024)) = make_uint2(pack2(v0, v1), pack2(v2, v3));
      }
    __syncthreads();
  }
}

struct XcdSlot { int part0, pstride, rank, cnt; };
DI XcdSlot xcd_slot(const Params& p, unsigned myrank) {
  const unsigned* census = (const unsigned*)(p.ws + OFF_CENSUS);
  const unsigned myx = (unsigned)__builtin_amdgcn_s_getreg((3 << 11) | 20) & 0xFu;
  int nx = 0, ix = 0, cnt = 1;
#pragma unroll
  for (int j = 0; j < 16; ++j) {
    const unsigned c = __builtin_amdgcn_readfirstlane(census[j]);
    if (c) { if ((unsigned)j == myx) { ix = nx; cnt = (int)c; } ++nx; }
  }
  XcdSlot sl; sl.part0 = ix; sl.pstride = nx > 0 ? nx : 1; sl.rank = (int)myrank; sl.cnt = cnt;
  return sl;
}

DI void peer_s1(const Params& p, int layer, const XcdSlot sl) {
  const int tid = opaque_tid(), lane = tid & 63, w = tid >> 6;
  unsigned char* ws = p.ws;
  const int* EX = (const int*)(ws + OFF_EX);
  const unsigned char* U8 = ws + (layer ? OFF_UV1 : OFF_UV0);
  const unsigned char* HQ = ws + OFF_HQ;
  const float* HS = (const float*)(ws + OFF_HS);
  float* ZP = (float*)(ws + OFF_ZP);
  const int c8 = lane & 7, rg = lane >> 3;
  const bool b2 = (lane & 4) != 0, b1 = (lane & 2) != 0, b0 = (lane & 1) != 0;
  const int first = sl.rank * 4 + w, stride = sl.cnt * 4;
  const int nT = (T_TOK - first + stride - 1) / stride;
  const int nparts = (8 - sl.part0 + sl.pstride - 1) / sl.pstride;
  const int total = nT * nparts;
  if (total <= 0) return;
#define Z1_ITEM(IT, X, T) do { int it_ = (IT) < total ? (IT) : total - 1; const int xi_ = it_ / nT; X = sl.part0 + xi_ * sl.pstride; T = first + (it_ - xi_ * nT) * stride; } while (0)
  int ev[16];
  u32x4 qX[16], qY[16];
  u32x4 hX, hY;
  float sX, sY;
  int xC, tC, xN, tN, x2, t2;
#define Z1_LOAD_EV(T) do { _Pragma("unroll") for (int q = 0; q < 4; ++q) { const int4 e4 = *(const int4*)(EX + (size_t)(T) * 128 + rg * 16 + 4 * q); \
      ev[4 * q] = e4.x; ev[4 * q + 1] = e4.y; ev[4 * q + 2] = e4.z; ev[4 * q + 3] = e4.w; } } while (0)
#define Z1_ISSUE(Q, H, S, X, T) do { const unsigned char* ub_ = U8 + (size_t)(X) * 16384 * 128 + c8 * 16; \
      _Pragma("unroll") for (int j = 0; j < 16; ++j) Q[j] = *(const u32x4*)(ub_ + (size_t)ev[j] * 128); \
      H = *(const u32x4*)(HQ + ((size_t)(X) * T_TOK + (T)) * 128 + c8 * 16); \
      S = HS[(size_t)(X) * T_TOK + (T)]; } while (0)
  Z1_ITEM(0, xC, tC);
  Z1_LOAD_EV(tC);
  Z1_ISSUE(qX, hX, sX, xC, tC);
  Z1_ITEM(1, xN, tN);
  Z1_LOAD_EV(tN);
#define Z1_BODY(QC, HC, SC, QN, HN, SN, IT) do { \
    Z1_ISSUE(QN, HN, SN, xN, tN);               \
    Z1_ITEM((IT) + 2, x2, t2); \
    Z1_LOAD_EV(t2);                             \
    int pz[16]; \
    _Pragma("unroll") for (int j = 0; j < 16; ++j) { \
      int a_ = 0; \
      _Pragma("unroll") for (int d = 0; d < 4; ++d) a_ = __builtin_amdgcn_sdot4((int)QC[j][d], (int)HC[d], a_, false); \
      pz[j] = a_; } \
      \
    int r1[8], r2[4], r3[2]; \
    _Pragma("unroll") for (int i = 0; i < 8; ++i) { const int send = b2 ? pz[i] : pz[8 + i], mine = b2 ? pz[8 + i] : pz[i]; r1[i] = mine + __shfl_xor(send, 4); } \
    _Pragma("unroll") for (int i = 0; i < 4; ++i) { const int send = b1 ? r1[i] : r1[4 + i], mine = b1 ? r1[4 + i] : r1[i]; r2[i] = mine + __shfl_xor(send, 2); } \
    _Pragma("unroll") for (int i = 0; i < 2; ++i) { const int send = b0 ? r2[i] : r2[2 + i], mine = b0 ? r2[2 + i] : r2[i]; r3[i] = mine + __shfl_xor(send, 1); } \
    *(float2*)(ZP + ((size_t)xC * T_TOK + tC) * 128 + rg * 16 + 2 * c8) = make_float2((float)r3[0] * SC, (float)r3[1] * SC); \
    xC = xN; tC = tN; xN = x2; tN = t2; } while (0)
  for (int it = 0; it < total; it += 2) {
    Z1_BODY(qX, hX, sX, qY, hY, sY, it);
    if (it + 1 < total) Z1_BODY(qY, hY, sY, qX, hX, sX, it + 1);
  }
#undef Z1_BODY
#undef Z1_ISSUE
#undef Z1_LOAD_EV
#undef Z1_ITEM
}

DI void peer_zmerge(const Params& p, int layer, const float* ss_in) {
  unsigned char* ws = p.ws;
  const int* EX = (const int*)(ws + OFF_EX);
  const float* GT = (const float*)(ws + OFF_GT);
  const float* ZP = (const float*)(ws + OFF_ZP);
  const float2* SC = (const float2*)(ws + (layer ? OFF_SC1 : OFF_SC0));
  float* ACT = (float*)(ws + OFF_ACT);
  for (int i4 = blockIdx.x * NTHREADS + opaque_tid(); i4 < T_TOK * 32; i4 += gridDim.x * NTHREADS) {
    const int idx = i4 * 4, t = idx >> 7;
    float4 z = make_float4(0.f, 0.f, 0.f, 0.f);
#pragma unroll
    for (int x = 0; x < 8; ++x) { const float4 v = *(const float4*)(ZP + (size_t)x * T_TOK * 128 + idx); z.x += v.x; z.y += v.y; z.z += v.z; z.w += v.w; }
    const int4 e4 = *(const int4*)(EX + idx);
    const float4 g4 = *(const float4*)(GT + idx);
    const float2 s0 = SC[e4.x], s1 = SC[e4.y], s2 = SC[e4.z], s3 = SC[e4.w];
    const float rs = rstd_from_partials(ss_in, t);
    *(float4*)(ACT + idx) = make_float4(gelu_tanh(z.x * rs * s0.x) * g4.x * s0.y, gelu_tanh(z.y * rs * s1.x) * g4.y * s1.y,
                                        gelu_tanh(z.z * rs * s2.x) * g4.z * s2.y, gelu_tanh(z.w * rs * s3.x) * g4.w * s3.y);
  }
}

template <bool FINAL>
DI void peer_s2(const Params& p, int layer, float* ss_out, const XcdSlot sl) {
  const int tid = opaque_tid(), lane = tid & 63, w = tid >> 6;
  unsigned char* ws = p.ws;
  const int* EX = (const int*)(ws + OFF_EX);
  const float* ACT = (const float*)(ws + OFF_ACT);
  const unsigned char* V8 = ws + (layer ? OFF_UV1 : OFF_UV0) + 16 * MiB;
  u16* HBT = (u16*)(ws + OFF_HBT);
  float* out = p.out;
  float* ssd = ss_out ? ss_out : (float*)(ws + OFF_DUMMY);
  const int c8 = lane & 7, rg = lane >> 3;
  const bool b5 = (lane & 32) != 0, b4 = (lane & 16) != 0, b3 = (lane & 8) != 0;
  const int first = sl.rank * 4 + w, stride = sl.cnt * 4;
  const int nT = (T_TOK - first + stride - 1) / stride;
  const int nparts = (8 - sl.part0 + sl.pstride - 1) / sl.pstride;
  const int total = nT * nparts;
  if (total <= 0) return;
#define S2_ITEM(IT, X, T) do { int it_ = (IT) < total ? (IT) : total - 1; const int xi_ = it_ / nT; X = sl.part0 + xi_ * sl.pstride; T = first + (it_ - xi_ * nT) * stride; } while (0)
  int ev[16];
  float avX[16], avY[16];
  u32x4 qX[16], qY[16];
  unsigned hX, hY;
  int xC, tC, xN, tN, x2, t2;
#define S2_LOAD_EV(T) do { _Pragma("unroll") for (int q = 0; q < 4; ++q) { const int4 e4 = *(const int4*)(EX + (size_t)(T) * 128 + rg * 16 + 4 * q); \
      ev[4 * q] = e4.x; ev[4 * q + 1] = e4.y; ev[4 * q + 2] = e4.z; ev[4 * q + 3] = e4.w; } } while (0)
#define S2_ISSUE(Q, AV, H, X, T) do { const unsigned char* vb_ = V8 + (size_t)(X) * 16384 * 128 + c8 * 16; \
      _Pragma("unroll") for (int j = 0; j < 16; ++j) Q[j] = *(const u32x4*)(vb_ + (size_t)ev[j] * 128); \
      H = *(const unsigned*)(HBT + tiledA((T), (X) * 128 + c8 * 16 + 2 * rg, 1024)); \
      _Pragma("unroll") for (int q = 0; q < 4; ++q) { const float4 a4 = *(const float4*)(ACT + (size_t)(T) * 128 + rg * 16 + 4 * q); \
        AV[4 * q] = a4.x; AV[4 * q + 1] = a4.y; AV[4 * q + 2] = a4.z; AV[4 * q + 3] = a4.w; } } while (0)
  S2_ITEM(0, xC, tC);
  S2_LOAD_EV(tC);
  S2_ISSUE(qX, avX, hX, xC, tC);
  S2_ITEM(1, xN, tN);
  S2_LOAD_EV(tN);
#define S2_BODY(QC, AVC, HC, QN, AVN, HN, IT) do { \
    S2_ISSUE(QN, AVN, HN, xN, tN);              \
    S2_ITEM((IT) + 2, x2, t2); \
    S2_LOAD_EV(t2);                             \
    float acc[16]; \
    _Pragma("unroll") for (int i = 0; i < 16; ++i) acc[i] = 0.f; \
    _Pragma("unroll") for (int j = 0; j < 16; ++j) { \
      const f32x2 a2 = {AVC[j], AVC[j]}; \
      _Pragma("unroll") for (int d = 0; d < 4; ++d) { \
        const f32x2 lo = __builtin_amdgcn_cvt_pk_f32_fp8((int)QC[j][d], false), hi = __builtin_amdgcn_cvt_pk_f32_fp8((int)QC[j][d], true); \
        f32x2 c0 = {acc[4 * d], acc[4 * d + 1]}, c1 = {acc[4 * d + 2], acc[4 * d + 3]}; \
        c0 = __builtin_elementwise_fma(lo, a2, c0); c1 = __builtin_elementwise_fma(hi, a2, c1); \
        acc[4 * d] = c0[0]; acc[4 * d + 1] = c0[1]; acc[4 * d + 2] = c1[0]; acc[4 * d + 3] = c1[1]; } } \
      \
    float r1[8], r2[4], r3[2]; \
    _Pragma("unroll") for (int i = 0; i < 8; ++i) { const float send = b5 ? acc[i] : acc[8 + i], mine = b5 ? acc[8 + i] : acc[i]; r1[i] = mine + __shfl_xor(send, 32); } \
    _Pragma("unroll") for (int i = 0; i < 4; ++i) { const float send = b4 ? r1[i] : r1[4 + i], mine = b4 ? r1[4 + i] : r1[i]; r2[i] = mine + __shfl_xor(send, 16); } \
    _Pragma("unroll") for (int i = 0; i < 2; ++i) { const float send = b3 ? r2[i] : r2[2 + i], mine = b3 ? r2[2 + i] : r2[i]; r3[i] = mine + __shfl_xor(send, 8); } \
    const float n0 = bflo(HC) + r3[0], n1 = bfhi(HC) + r3[1]; \
    if (FINAL) *(float2*)(out + (size_t)tC * 1024 + xC * 128 + c8 * 16 + 2 * rg) = make_float2(n0, n1); \
    else { float ssq = n0 * n0 + n1 * n1; \
      _Pragma("unroll") for (int o = 32; o >= 1; o >>= 1) ssq += __shfl_xor(ssq, o); \
      *(unsigned*)(HBT + tiledA(tC, xC * 128 + c8 * 16 + 2 * rg, 1024)) = pack2(n0, n1); ssd[(size_t)tC * 8 + xC] = ssq; } \
    xC = xN; tC = tN; xN = x2; tN = t2; } while (0)
  for (int it = 0; it < total; it += 2) {
    S2_BODY(qX, avX, hX, qY, avY, hY, it);
    if (it + 1 < total) S2_BODY(qY, avY, hY, qX, avX, hX, it + 1);
  }
#undef S2_LOAD_EV
#undef S2_ISSUE
#undef S2_BODY
#undef S2_ITEM
}

constexpr int VT_STRIDE = 392;
DI void attn_phase(const Params& p, unsigned char* lds) {
  const int tid = opaque_tid(), lane = tid & 63, w = tid >> 6, l31 = lane & 31, half = lane >> 5;
  unsigned char* ws = p.ws;
  const u16* Kb = (const u16*)(ws + OFF_K);
  const u16* Vb = (const u16*)(ws + OFF_V);
  const u16* Qb = (const u16*)(ws + OFF_Q);
  u16* OGA = (u16*)(ws + OFF_OGA);
  float* LG = (float*)(ws + OFF_LG);
  const float Mx = ((const float*)(ws + OFF_MISC))[0];
  const float scale = 0.08838834764831845f;
  for (int item = blockIdx.x; item < 1536; item += gridDim.x) {
    const int qb = item & 127, rest = item >> 7, kvh = rest & 1, gi = (rest >> 1) % 3, b = rest / 6;
    const int dl = (gi == 0) ? 1 : (gi == 1 ? 4 : 16);
    const int bpr = (SEQ / dl) / 64;
    const int rho = qb / bpr, tau0 = (qb % bpr) * 64;
#pragma unroll 4
    for (int j = 0; j < 12; ++j) {
      const int id = tid + 256 * j, row = id >> 4, c = id & 15;
      const int tk = tau0 - 128 + row;
      const int tokk = rho + dl * (tk < 0 ? 0 : tk);
      *(uint4*)(lds + off256(row, c)) = *(const uint4*)(Kb + ((size_t)(b * SEQ + tokk)) * 768 + gi * 256 + kvh * 128 + c * 8);
    }
    const int r = w & 1, qh = w >> 1;
    const int tauq = tau0 + qh * 32 + l31;
    const int tq = b * SEQ + rho + dl * tauq;
    bf16x8 qf[8];
    {
      const u16* qsrc = Qb + (size_t)tq * 1536 + ((gi * 2 + kvh) * 2 + r) * 128;
#pragma unroll
      for (int kk = 0; kk < 8; ++kk) qf[kk] = *(const bf16x8*)(qsrc + (2 * kk + half) * 8);
    }
    __syncthreads();
    float lsum = 0.f;
    bf16x8 pf[5][2];
#pragma unroll
    for (int jl = 0; jl < 5; ++jl) {
      f32x16 pt;
#pragma unroll
      for (int rr = 0; rr < 16; ++rr) pt[rr] = 0.f;
#pragma unroll
      for (int kk = 0; kk < 8; ++kk) {
        const bf16x8 ak = *(const bf16x8*)(lds + off256((qh + jl) * 32 + l31, 2 * kk + half));
        pt = MFMA32(ak, qf[kk], pt);
      }
#pragma unroll
      for (int rr = 0; rr < 16; ++rr) {
        const int tk = tau0 - 128 + (qh + jl) * 32 + crow(rr, half);
        const bool valid = (tk >= 0) && (tk <= tauq) && (tk >= tauq - 128);
        const float pv = valid ? __expf(pt[rr] * scale - Mx) : 0.f;
        lsum += pv;
        pt[rr] = pv;
      }
#pragma unroll
      for (int s = 0; s < 2; ++s) {
        const uint4 u0 = make_uint4(pack2(pt[8 * s], pt[8 * s + 1]), pack2(pt[8 * s + 2], pt[8 * s + 3]),
                                    pack2(pt[8 * s + 4], pt[8 * s + 5]), pack2(pt[8 * s + 6], pt[8 * s + 7]));
        pf[jl][s] = __builtin_bit_cast(bf16x8, u0);
      }
    }
    lsum += __shfl_xor(lsum, 32);
    __syncthreads();
#pragma unroll 4
    for (int j = 0; j < 12; ++j) {
      const int id = tid + 256 * j, row = id >> 4, c = id & 15;
      const int tk = tau0 - 128 + row;
      const int tokk = rho + dl * (tk < 0 ? 0 : tk);
      const uint4 vv = *(const uint4*)(Vb + ((size_t)(b * SEQ + tokk)) * 768 + gi * 256 + kvh * 128 + c * 8);
      unsigned char* dstc = lds + (size_t)(c * 8) * VT_STRIDE + row * 2;
      *(u16*)(dstc + 0 * VT_STRIDE) = (u16)(vv.x & 0xffff); *(u16*)(dstc + 1 * VT_STRIDE) = (u16)(vv.x >> 16);
      *(u16*)(dstc + 2 * VT_STRIDE) = (u16)(vv.y & 0xffff); *(u16*)(dstc + 3 * VT_STRIDE) = (u16)(vv.y >> 16);
      *(u16*)(dstc + 4 * VT_STRIDE) = (u16)(vv.z & 0xffff); *(u16*)(dstc + 5 * VT_STRIDE) = (u16)(vv.z >> 16);
      *(u16*)(dstc + 6 * VT_STRIDE) = (u16)(vv.w & 0xffff); *(u16*)(dstc + 7 * VT_STRIDE) = (u16)(vv.w >> 16);
    }
    __syncthreads();
    f32x16 acc[4];
#pragma unroll
    for (int i = 0; i < 4; ++i)
#pragma unroll
      for (int rr = 0; rr < 16; ++rr) acc[i][rr] = 0.f;
#pragma unroll
    for (int et = 0; et < 4; ++et) {
      const unsigned char* vrow = lds + (size_t)(et * 32 + l31) * VT_STRIDE;
#pragma unroll
      for (int jl = 0; jl < 5; ++jl)
#pragma unroll
        for (int s = 0; s < 2; ++s) {
          const int j0 = (qh + jl) * 32 + 16 * s + 4 * half;
          const uint2 lo = *(const uint2*)(vrow + j0 * 2);
          const uint2 hi = *(const uint2*)(vrow + (j0 + 8) * 2);
          const bf16x8 av = __builtin_bit_cast(bf16x8, make_uint4(lo.x, lo.y, hi.x, hi.y));
          acc[et] = MFMA32(av, pf[jl][s], acc[et]);
        }
    }
    const int hd = kvh * 2 + r;
    const int tglob = tq;
    u16* od = OGA + ((size_t)gi * T_TOK + tglob) * 512 + hd * 128;
#pragma unroll
    for (int et = 0; et < 4; ++et)
#pragma unroll
      for (int g = 0; g < 4; ++g)
        *(uint2*)(od + et * 32 + 8 * g + 4 * half) = make_uint2(pack2(acc[et][4 * g], acc[et][4 * g + 1]), pack2(acc[et][4 * g + 2], acc[et][4 * g + 3]));
    if (half == 0) LG[((size_t)gi * T_TOK + tglob) * 4 + hd] = lsum;
    __syncthreads();
  }
}

DI void attn_combine(const Params& p) {
  unsigned char* ws = p.ws;
  const u16* OGA = (const u16*)(ws + OFF_OGA);
  const float* LG = (const float*)(ws + OFF_LG);
  u16* AO = (u16*)(ws + OFF_AO);
  const int nchunk = T_TOK * 512 / 8;
  for (int i = blockIdx.x * NTHREADS + opaque_tid(); i < nchunk; i += gridDim.x * NTHREADS) {
    const int t = i >> 6, c = i & 63, hd = c >> 4;
    float num[8];
#pragma unroll
    for (int k = 0; k < 8; ++k) num[k] = 0.f;
    float den = 0.f;
#pragma unroll
    for (int gi = 0; gi < 3; ++gi) {
      const uint4 v = *(const uint4*)(OGA + ((size_t)gi * T_TOK + t) * 512 + c * 8);
      num[0] += bflo(v.x); num[1] += bfhi(v.x); num[2] += bflo(v.y); num[3] += bfhi(v.y);
      num[4] += bflo(v.z); num[5] += bfhi(v.z); num[6] += bflo(v.w); num[7] += bfhi(v.w);
      den += LG[((size_t)gi * T_TOK + t) * 4 + hd];
    }
    const float inv = 1.f / den;
    *(uint4*)(AO + tiledA(t, c * 8, 512)) = make_uint4(pack2(num[0] * inv, num[1] * inv), pack2(num[2] * inv, num[3] * inv),
                                                        pack2(num[4] * inv, num[5] * inv), pack2(num[6] * inv, num[7] * inv));
  }
}

#define XB_TMO      128
#define XB_XCNT(j)  (256  + 64 * (j))
#define XB_XSUB(j)  (1280 + 64 * (j))
#define XB_XGEN(j)  (2304 + 64 * (j))
#define XB_TOP      3328
#define XB_TOPGEN   3392
#define XCD_BAR_WORDS 3456
#define XB_SPIN_CAP (1u << 18)

__device__ __forceinline__ unsigned xb_ld(unsigned* p)              { return __hip_atomic_load(p, __ATOMIC_RELAXED, __HIP_MEMORY_SCOPE_AGENT); }
__device__ __forceinline__ unsigned xb_add(unsigned* p, unsigned v) { return __hip_atomic_fetch_add(p, v, __ATOMIC_RELAXED, __HIP_MEMORY_SCOPE_AGENT); }
__device__ __forceinline__ unsigned xb_xcc_id() { return (unsigned)__builtin_amdgcn_s_getreg((3 << 11) | 20) & 0xFu; }
#define XB_SPIN(cond, bar) do { unsigned _sp = 0; while (cond) { __builtin_amdgcn_s_sleep(1); \
    if ((++_sp & 255u) == 0u) { if (xb_ld(&(bar)[XB_TMO])) break; if (_sp > XB_SPIN_CAP) { atomicAdd(&(bar)[XB_TMO], 1u); break; } } } } while (0)

struct XcdBarrier {
    unsigned* bar; unsigned x;
    volatile LAS unsigned* st;
};

__device__ __forceinline__ XcdBarrier xcd_barrier_post(unsigned* bar, volatile LAS unsigned* st) {
    XcdBarrier b; b.bar = bar; b.x = xb_xcc_id(); b.st = st;
    if (threadIdx.x == 0) (void)xb_add(&bar[XB_XCNT(b.x)], 1u);
    return b;
}
__device__ __forceinline__ void xcd_barrier_complete(unsigned* bar, unsigned x, unsigned& nloc, unsigned& nx) {
    const unsigned G = gridDim.x * gridDim.y * gridDim.z;
    unsigned sum, cnt, mine, sp = 0u;
    for (;;) {
        sum = 0u; cnt = 0u; mine = 0u;
#pragma unroll
        for (unsigned j = 0; j < 16; ++j) { const unsigned c = xb_ld(&bar[XB_XCNT(j)]); sum += c; cnt += (c > 0u) ? 1u : 0u; mine = (j == x) ? c : mine; }
        if (sum == G) break;
        __builtin_amdgcn_s_sleep(1);
        if ((++sp & 255u) == 0u) { if (xb_ld(&bar[XB_TMO])) break; if (sp > XB_SPIN_CAP) { atomicAdd(&bar[XB_TMO], 1u); break; } }
    }
    nloc = mine > 0u ? mine : 1u; nx = cnt > 0u ? cnt : 1u;
}

__device__ __forceinline__ void xcd_barrier(const XcdBarrier& b) {
    asm volatile("s_waitcnt vmcnt(0)" ::: "memory");
    __syncthreads();
    if (threadIdx.x == 0) {
        unsigned* bar = b.bar;
        __builtin_amdgcn_s_waitcnt(0);
        unsigned nloc = b.st[0], nx = b.st[1];
        if (nloc == 0u) { xcd_barrier_complete(bar, b.x, nloc, nx); b.st[0] = nloc; b.st[1] = nx; }
        const unsigned old = xb_add(&bar[XB_XSUB(b.x)], 1u);
        const unsigned gen = old / nloc;
        if (old + 1u == (gen + 1u) * nloc) {
            __builtin_amdgcn_fence(__ATOMIC_RELEASE, "agent");
            asm volatile("s_waitcnt vmcnt(0)" ::: "memory");
            const unsigned og = xb_add(&bar[XB_TOP], 1u);
            const unsigned tg = og / nx;
            if (og + 1u == (tg + 1u) * nx) xb_add(&bar[XB_TOPGEN], 1u);
            else XB_SPIN(xb_ld(&bar[XB_TOPGEN]) == tg, bar);
            __builtin_amdgcn_fence(__ATOMIC_ACQUIRE, "agent");
            xb_add(&bar[XB_XGEN(b.x)], 1u);
            asm volatile("s_waitcnt vmcnt(0)" ::: "memory");
        } else {
            XB_SPIN(xb_ld(&bar[XB_XGEN(b.x)]) == gen, bar);
            __builtin_amdgcn_fence(__ATOMIC_ACQUIRE, "agent");
            asm volatile("s_waitcnt vmcnt(0)" ::: "memory");
        }
    }
    __syncthreads();
}


constexpr int N_PHASES = 18;
template <int ph>
DI void run_phase(const Params& p, unsigned char* lds, unsigned myrank) {
  unsigned char* ws = p.ws;
  switch (ph) {
    case 0: p0_prep(p, lds); break;
    case 1: {
      EpiHgrnIn e{(const float*)(ws + OFF_RSTD0), (const float*)(ws + OFF_LB), (u16*)(ws + OFF_QG), (u16*)(ws + OFF_VG), (u16*)(ws + OFF_GG), (_Float16*)(ws + OFF_LOGF)};
      gemm_phase64<EpiHgrnIn, 1>(p, (const u16*)(ws + OFF_HB), 1024, (const u16*)(ws + OFF_WIN), 1024, 64, 32, 16, e, lds);
    } break;
    case 2: gla_g1(p, lds); break;
    case 3: gla_g2(p); break;
    case 4: gla_g3(p, lds); break;
    case 5: {
      EpiResidual<false> e{p.x, (u16*)(ws + OFF_HBT), (float*)(ws + OFF_SS1), ws + OFF_HQ, (float*)(ws + OFF_HS)};
      gemm_phase64(p, (const u16*)(ws + OFF_OG), 1024, (const u16*)(ws + OFF_WOUT), 1024, 64, 8, 16, e, lds);
    } break;
    case 6: {
      EpiTopk e{(const float*)(ws + OFF_SS1), (int*)(ws + OFF_EX), (float*)(ws + OFF_GT), lds + 32768 + (opaque_tid() >> 6) * 6144};
      gemm_phase<EpiTopk, 0, true>(p, (const u16*)(ws + OFF_HBT), 1024, (const u16*)(ws + OFF_WPQ0), 1024, 128, 16, 16, e, lds);
    } break;
    case 7: peer_s1(p, 0, xcd_slot(p, myrank)); break;
    case 8: peer_zmerge(p, 0, (const float*)(ws + OFF_SS1)); break;
    case 9: peer_s2<false>(p, 0, (float*)(ws + OFF_SS2), xcd_slot(p, myrank)); break;
    case 10: {
      EpiKVQ e{(const float*)(ws + OFF_SS2), p.k_norm, p.q_norm, (const float2*)(ws + OFF_ROPE), (u16*)(ws + OFF_K), (u16*)(ws + OFF_V), (u16*)(ws + OFF_Q), lds + 32768};
      gemm_phase64<EpiKVQ, 2>(p, (const u16*)(ws + OFF_HBT), 1024, (const u16*)(ws + OFF_WKVQ), 1024, 64, 24, 16, e, lds);
    } break;
    case 11: attn_phase(p, lds); break;
    case 12: attn_combine(p); break;
    case 13: {
      EpiResidual<true> e{nullptr, (u16*)(ws + OFF_HBT), (float*)(ws + OFF_SS3), ws + OFF_HQ, (float*)(ws + OFF_HS)};
      gemm_phase64(p, (const u16*)(ws + OFF_AO), 512, (const u16*)(ws + OFF_WO), 512, 64, 8, 8, e, lds);
    } break;
    case 14: {
      EpiTopk e{(const float*)(ws + OFF_SS3), (int*)(ws + OFF_EX), (float*)(ws + OFF_GT), lds + 32768 + (opaque_tid() >> 6) * 6144};
      gemm_phase<EpiTopk, 0, true>(p, (const u16*)(ws + OFF_HBT), 1024, (const u16*)(ws + OFF_WPQ1), 1024, 128, 16, 16, e, lds);
    } break;
    case 15: peer_s1(p, 1, xcd_slot(p, myrank)); break;
    case 16: peer_zmerge(p, 1, (const float*)(ws + OFF_SS3)); break;
    case 17: peer_s2<true>(p, 1, nullptr, xcd_slot(p, myrank)); break;
    default: break;
  }
}

#if MEGA
#ifndef PROBE_MASK
#define PROBE_MASK 0
#endif
__global__ void __launch_bounds__(NTHREADS, 2) yoco_mega(Params p) {
  __shared__ __attribute__((aligned(16))) unsigned char lds[LDS_BYTES];
  __shared__ uint4 xb_words;
  if (threadIdx.x == 0) {
    const unsigned myx = (unsigned)__builtin_amdgcn_s_getreg((3 << 11) | 20) & 0xFu;
    const unsigned rk = __hip_atomic_fetch_add((unsigned*)(p.ws + OFF_CENSUS) + myx, 1u, __ATOMIC_RELAXED, __HIP_MEMORY_SCOPE_AGENT);
    xb_words = make_uint4(0u, 0u, rk, 0u);
  }
  __syncthreads();
  (void)xcd_barrier_post((unsigned*)p.ws, (volatile LAS unsigned*)&xb_words);
#define GRID_BAR() do { XcdBarrier b_; b_.bar = (unsigned*)p.ws; b_.x = xb_xcc_id(); b_.st = (volatile LAS unsigned*)&xb_words; xcd_barrier(b_); } while (0)
#define MYRANK() (((volatile unsigned*)&xb_words)[2])
#define PHASE(n) do { run_phase<n>(p, lds, MYRANK()); GRID_BAR(); if (PROBE_MASK & (1 << n)) { run_phase<n>(p, lds, MYRANK()); GRID_BAR(); } } while (0)
  PHASE(0); PHASE(1); PHASE(2); PHASE(3); PHASE(4); PHASE(5); PHASE(6); PHASE(7); PHASE(8); PHASE(9);
  PHASE(10); PHASE(11); PHASE(12); PHASE(13); PHASE(14); PHASE(15); PHASE(16);
  run_phase<17>(p, lds, MYRANK());
}
#endif

extern "C" void kernel_launch(void* const* d_in, const int* in_sizes, int n_in, void* d_out, int out_size, void* d_ws, size_t ws_size,
                              hipStream_t stream) {
  if (n_in != 18 || ws_size < WS_NEED) {
    fprintf(stderr, "kernel_launch: unexpected inputs (n_in %d, ws %zu, need %zu)\n", n_in, ws_size, (size_t)WS_NEED);
    return;
  }
  Params p{};
  p.x = (const float*)d_in[0]; p.hgrn_norm = (const float*)d_in[1]; p.hgrn_w_in = (const float*)d_in[2]; p.hgrn_lb = (const float*)d_in[3];
  p.hgrn_out_norm = (const float*)d_in[4]; p.hgrn_w_out = (const float*)d_in[5]; p.kv_norm = (const float*)d_in[6]; p.w_kv = (const float*)d_in[7];
  p.k_norm = (const float*)d_in[8]; p.attn_norm = (const float*)d_in[9]; p.w_q = (const float*)d_in[10]; p.q_norm = (const float*)d_in[11];
  p.w_o = (const float*)d_in[12]; p.ffn_norm = (const float*)d_in[13]; p.peer_w_q = (const float*)d_in[14]; p.peer_sub_keys = (const float*)d_in[15];
  p.peer_u = (const float*)d_in[16]; p.peer_v = (const float*)d_in[17];
  p.out = (float*)d_out; p.ws = (unsigned char*)d_ws;
#if MEGA
  static int grid_blocks = 0;
  if (!grid_blocks) {
    int dev = 0, cus = 0, per_cu = 0;
    (void)hipGetDevice(&dev);
    (void)hipDeviceGetAttribute(&cus, hipDeviceAttributeMultiprocessorCount, dev);
    (void)hipOccupancyMaxActiveBlocksPerMultiprocessor(&per_cu, yoco_mega, NTHREADS, 0);
    if (per_cu > 2) per_cu = 2;
    if (per_cu < 1) per_cu = 1;
    grid_blocks = cus * per_cu;
  }
  if (hipMemsetAsync(d_ws, 0, 16384, stream) != hipSuccess) { fprintf(stderr, "kernel_launch: memset of barrier words failed\n"); return; }
  void* args[] = {&p};
  hipError_t e = hipLaunchCooperativeKernel((void*)yoco_mega, dim3(grid_blocks), dim3(NTHREADS), args, 0, stream);
  if (e != hipSuccess) fprintf(stderr, "cooperative launch failed: %s (grid %d)\n", hipGetErrorString(e), grid_blocks);
#endif
}
```

```cpp
#include <hip/hip_runtime.h>
#include <hip/hip_cooperative_groups.h>
#include <cstdio>
#include <cstdint>
namespace cg = cooperative_groups;

#ifndef MEGA
#define MEGA 1
#endif

#define DI __device__ __forceinline__
#define LAS __attribute__((address_space(3)))
typedef unsigned short u16;
typedef __attribute__((ext_vector_type(8))) short bf16x8;
typedef __attribute__((ext_vector_type(16))) float f32x16;
typedef __attribute__((ext_vector_type(2))) float f32x2;
typedef __attribute__((ext_vector_type(2))) __bf16 bf16x2_t;
typedef __attribute__((ext_vector_type(4))) unsigned u32x4;
typedef __attribute__((ext_vector_type(2))) unsigned u32x2;

#define MFMA32(a, b, c) __builtin_amdgcn_mfma_f32_32x32x16_bf16((a), (b), (c), 0, 0, 0)

constexpr int T_TOK = 16384;
constexpr int DM = 1024;
constexpr int SEQ = 8192;
constexpr float EPS = 1e-6f;
constexpr int NTHREADS = 256;
constexpr int LDS_BYTES = 65536;

constexpr size_t MiB = 1u << 20;
constexpr size_t OFF_LB = 64 * 1024;
constexpr size_t OFF_MISC = 68 * 1024;
constexpr size_t OFF_RSTD0 = 128 * 1024;
constexpr size_t OFF_SS1 = 29 * MiB;
constexpr size_t OFF_RSTD2 = 256 * 1024;
constexpr size_t OFF_SS3 = 30 * MiB;
constexpr size_t OFF_LG = 1 * MiB;
constexpr size_t OFF_ROPE = 2 * MiB;
constexpr size_t OFF_ACH = 3 * MiB;
constexpr size_t OFF_WIN = 4 * MiB;
constexpr size_t OFF_WOUT = 12 * MiB;
constexpr size_t OFF_WPQ0 = 14 * MiB;
constexpr size_t OFF_WKVQ = 18 * MiB;
constexpr size_t OFF_WO = 24 * MiB;
constexpr size_t OFF_WPQ1 = 25 * MiB;
constexpr size_t OFF_UV0 = 32 * MiB;
constexpr size_t OFF_UV1 = 64 * MiB;
constexpr size_t OFF_SC0 = 31 * MiB;
constexpr size_t OFF_SC1 = 31 * MiB + 256 * 1024;
constexpr size_t OFF_HB = 160 * MiB;
constexpr size_t OFF_QG = 192 * MiB;
constexpr size_t OFF_KG = 224 * MiB;
constexpr size_t OFF_LOGF = 256 * MiB;
constexpr size_t OFF_VG = 320 * MiB;
constexpr size_t OFF_GG = 352 * MiB;
constexpr size_t OFF_UT = 384 * MiB;
constexpr size_t OFF_OG = 448 * MiB;
constexpr size_t WS_NEED = 480 * MiB;
constexpr size_t OFF_K = 208 * MiB;
constexpr size_t OFF_V = 232 * MiB;
constexpr size_t OFF_Q = 256 * MiB;
constexpr size_t OFF_OGA = 304 * MiB;
constexpr size_t OFF_AO = 352 * MiB;
constexpr size_t OFF_EX = 368 * MiB;
constexpr size_t OFF_GT = 376 * MiB;
constexpr size_t OFF_ACT = 384 * MiB;
constexpr size_t OFF_SS2 = 30 * MiB + 512 * 1024;
constexpr size_t OFF_HBT = OFF_HB;
constexpr size_t OFF_HQ = 192 * MiB;
constexpr size_t OFF_HS = 31 * MiB + 512 * 1024;
constexpr size_t OFF_ZP = 392 * MiB;
constexpr size_t OFF_DUMMY = 512 * 1024;
constexpr size_t OFF_CENSUS = 15 * 1024;

struct Params {
  const float *x, *hgrn_norm, *hgrn_w_in, *hgrn_lb, *hgrn_out_norm, *hgrn_w_out, *kv_norm, *w_kv, *k_norm, *attn_norm, *w_q,
      *q_norm, *w_o, *ffn_norm, *peer_w_q, *peer_sub_keys, *peer_u, *peer_v;
  float* out;
  unsigned char* ws;
};

DI int opaque_tid() { int t = threadIdx.x; asm volatile("" : "+v"(t)); return t; }
DI int crow(int r, int h) { return (r & 3) + 8 * (r >> 2) + 4 * h; }
DI unsigned pack2(float a, float b) {
  f32x2 v = {a, b};
  return __builtin_bit_cast(unsigned, __builtin_convertvector(v, bf16x2_t));
}
DI u16 f2bf(float f) { return (u16)(pack2(f, 0.f) & 0xffffu); }
DI float bf2f(u16 h) { return __uint_as_float(((unsigned)h) << 16); }
DI float bflo(unsigned u) { return __uint_as_float(u << 16); }
DI float bfhi(unsigned u) { return __uint_as_float(u & 0xffff0000u); }
DI float sigmoidf_(float v) { return 1.f / (1.f + __expf(-v)); }
DI float siluf_(float v) { return v / (1.f + __expf(-v)); }
DI float gelu_tanh(float z) {
  const float y = 0.7978845608028654f * (z + 0.044715f * z * z * z);
  const float t = 1.f - 2.f / (1.f + __expf(2.f * y));
  return 0.5f * z * (1.f + t);
}
DI size_t tiledA(int t, int col, int K) {
  return (size_t)(t >> 5) * (32 * (size_t)K) + (size_t)((((col >> 6) * 4 + ((col >> 4) & 3)) * 64 + ((col >> 3) & 1) * 32 + (t & 31)) * 8 + (col & 7));
}
DI int off128(int row, int c) { return row * 128 + ((c ^ ((row >> 1) & 7)) << 4); }
DI int off256(int row, int c) { return row * 256 + ((c ^ (row & 15)) << 4); }
DI int key_of(float f) { int k = __float_as_int(f); k ^= (k >> 31) & 0x7fffffff; return k; }
DI float val_of(int k) { k ^= (k >> 31) & 0x7fffffff; return __int_as_float(k); }
DI unsigned pack_i8x4(float a, float b, float c, float d) {
  const float M = 12582912.f;
  const unsigned ua = __float_as_uint(a + M), ub = __float_as_uint(b + M), uc = __float_as_uint(c + M), ud = __float_as_uint(d + M);
  return __builtin_amdgcn_perm(ub, ua, 0x0c0c0400u) | __builtin_amdgcn_perm(ud, uc, 0x04000c0cu);
}
DI float rstd_from_partials(const float* ss, int m) {
  const float4 a = *(const float4*)(ss + (size_t)m * 8), b = *(const float4*)(ss + (size_t)m * 8 + 4);
  const float t = ((a.x + a.y) + (a.z + a.w)) + ((b.x + b.y) + (b.z + b.w));
  return rsqrtf(t * (1.f / 1024.f) + EPS);
}

template <int N>
DI void bitonic_sort_desc(int (&a)[N]) {
#pragma unroll
  for (int k = 2; k <= N; k <<= 1)
#pragma unroll
    for (int j = k >> 1; j > 0; j >>= 1)
#pragma unroll
      for (int i = 0; i < N; ++i) {
        const int l = i ^ j;
        if (l > i) {
          const int hi = max(a[i], a[l]), lo = min(a[i], a[l]);
          if ((i & k) == 0) { a[i] = hi; a[l] = lo; } else { a[i] = lo; a[l] = hi; }
        }
      }
}
DI void merge_top16(int (&a)[16], const int (&b)[16]) {
#pragma unroll
  for (int i = 0; i < 16; ++i) a[i] = max(a[i], b[15 - i]);
#pragma unroll
  for (int j = 8; j > 0; j >>= 1)
#pragma unroll
    for (int i = 0; i < 16; ++i) {
      const int l = i ^ j;
      if (l > i) { const int hi = max(a[i], a[l]), lo = min(a[i], a[l]); a[i] = hi; a[l] = lo; }
    }
}
#define TOPK_INSERT(a, xk) do { int _x = (xk); _Pragma("unroll") for (int _j = 0; _j < 16; ++_j) { int _t = max(a[_j], _x); _x = min(a[_j], _x); a[_j] = _t; } } while (0)

constexpr int N_TR = 1024 + 256 + 384 + 384 + 128;
constexpr int N_CP = 1024;
constexpr int N_UV = 8192;
constexpr int N_X = 512;
constexpr int N_ROPE = 512;
constexpr int N_MISC = 64;
constexpr int N_P0 = N_TR + N_CP + N_X + N_ROPE + N_MISC;

DI void p0_transpose_tile(const float* src, int N, const float* gain, u16* dst, int ld, int rowoff, int kt, int ntile, float* tile) {
  const int tid = opaque_tid();
  const int k0 = kt * 64, n0 = ntile * 64;
#pragma unroll
  for (int i = 0; i < 4; ++i) {
    const int k = i * 16 + (tid >> 4), n = (tid & 15) * 4;
    float4 v = *(const float4*)(src + (size_t)(k0 + k) * N + n0 + n);
    if (gain) { const float gk = gain[k0 + k]; v.x *= gk; v.y *= gk; v.z *= gk; v.w *= gk; }
    tile[k * 65 + n] = v.x; tile[k * 65 + n + 1] = v.y; tile[k * 65 + n + 2] = v.z; tile[k * 65 + n + 3] = v.w;
  }
  __syncthreads();
  {
    const int n = tid >> 2, kq = (tid & 3) * 16;
    unsigned pk[8];
#pragma unroll
    for (int i = 0; i < 8; ++i) pk[i] = pack2(tile[(kq + 2 * i) * 65 + n], tile[(kq + 2 * i + 1) * 65 + n]);
    uint4* d = (uint4*)(dst + (size_t)(rowoff + n0 + n) * ld + k0 + kq);
    d[0] = make_uint4(pk[0], pk[1], pk[2], pk[3]);
    d[1] = make_uint4(pk[4], pk[5], pk[6], pk[7]);
  }
  __syncthreads();
}

DI void p0_prep(const Params& p, unsigned char* lds) {
  const int tid = opaque_tid(), lane = tid & 63, w = tid >> 6;
  unsigned char* ws = p.ws;
  for (int item = blockIdx.x; item < N_P0; item += gridDim.x) {
    int it = item;
    if (it < N_TR) {
      float* tile = (float*)lds;
      if (it < 1024) p0_transpose_tile(p.hgrn_w_in, 4096, p.hgrn_norm, (u16*)(ws + OFF_WIN), 1024, 0, it / 64, it % 64, tile);
      else if (it < 1280) { it -= 1024; p0_transpose_tile(p.hgrn_w_out, 1024, nullptr, (u16*)(ws + OFF_WOUT), 1024, 0, it / 16, it % 16, tile); }
      else if (it < 1664) { it -= 1280; p0_transpose_tile(p.w_kv, 1536, p.kv_norm, (u16*)(ws + OFF_WKVQ), 1024, 0, it / 24, it % 24, tile); }
      else if (it < 2048) { it -= 1664; p0_transpose_tile(p.w_q, 1536, p.attn_norm, (u16*)(ws + OFF_WKVQ), 1024, 1536, it / 24, it % 24, tile); }
      else { it -= 2048; p0_transpose_tile(p.w_o, 1024, nullptr, (u16*)(ws + OFF_WO), 512, 0, it / 16, it % 16, tile); }
      continue;
    }
    it -= N_TR;
    if (it < N_CP) {
      const int l = it >> 9, rem = it & 511, h = rem >> 6, wsel = (rem >> 5) & 1, nh = (rem >> 4) & 1;
      const int c0 = (rem & 15) * 64;
      float* Ws = (float*)lds;
      float* Ks = (float*)(lds + 64 * 65 * 4);
      const float* keys = p.peer_sub_keys + ((size_t)(l * 2 + wsel) * 128 + nh * 64) * 128;
      const float* Wp = p.peer_w_q + (size_t)l * 1024 * 2048 + (size_t)c0 * 2048 + h * 256 + wsel * 128;
      const int ci = w & 1, ni = w >> 1, r31 = lane & 31, kh = lane >> 5;
      f32x16 acc;
#pragma unroll
      for (int r = 0; r < 16; ++r) acc[r] = 0.f;
      for (int ps = 0; ps < 2; ++ps) {
#pragma unroll 4
        for (int i = 0; i < 16; ++i) {
          const int idx = tid + 256 * i, rr = idx >> 6, d = idx & 63;
          Ws[rr * 65 + d] = Wp[(size_t)rr * 2048 + ps * 64 + d] * p.ffn_norm[l * 1024 + c0 + rr];
          Ks[rr * 65 + d] = keys[rr * 128 + ps * 64 + d];
        }
        __syncthreads();
#pragma unroll 8
        for (int s2 = 0; s2 < 32; ++s2)
          acc = __builtin_amdgcn_mfma_f32_32x32x2f32(Ws[(ci * 32 + r31) * 65 + 2 * s2 + kh], Ks[(ni * 32 + r31) * 65 + 2 * s2 + kh], acc, 0, 0, 0);
        __syncthreads();
      }
      u16* dst = (u16*)(ws + (l ? OFF_WPQ1 : OFF_WPQ0)) + (size_t)(h * 256 + wsel * 128 + nh * 64 + ni * 32 + r31) * 1024 + c0 + ci * 32;
#pragma unroll
      for (int g = 0; g < 4; ++g) *(uint2*)(dst + 8 * g + 4 * kh) = make_uint2(pack2(acc[4 * g], acc[4 * g + 1]), pack2(acc[4 * g + 2], acc[4 * g + 3]));
      continue;
    }
    it -= N_CP;
    if (it < N_X) {
      float* xt = (float*)lds;
      const int t0 = it * 32;
      u16* dst = (u16*)(ws + OFF_HB) + (size_t)it * 32768;
      float ssr[8];
#pragma unroll
      for (int i = 0; i < 8; ++i) ssr[i] = 0.f;
      typedef float v4f __attribute__((ext_vector_type(4)));
      v4f xa[8], xb[8];
#define X_LOAD(R, CH) do { _Pragma("unroll") for (int i = 0; i < 8; ++i) R[i] = *(const v4f*)(p.x + (size_t)(t0 + w + 4 * i) * 1024 + (CH) * 256 + lane * 4); } while (0)
#define X_CHUNK(R, CH) do { \
        _Pragma("unroll") for (int i = 0; i < 8; ++i) { ssr[i] += R[i][0] * R[i][0] + R[i][1] * R[i][1] + R[i][2] * R[i][2] + R[i][3] * R[i][3]; *(v4f*)(xt + (w + 4 * i) * 260 + lane * 4) = R[i]; } \
        __syncthreads(); \
        _Pragma("unroll") for (int sl = 0; sl < 4; ++sl) {     \
          const int slot = w * 4 + sl, l31 = lane & 31, hf = lane >> 5; \
          const float4 v0 = *(const float4*)(xt + l31 * 260 + slot * 16 + hf * 8), v1 = *(const float4*)(xt + l31 * 260 + slot * 16 + hf * 8 + 4); \
          *(uint4*)(dst + (size_t)(((CH) * 16 + slot) * 64 + lane) * 8) = make_uint4(pack2(v0.x, v0.y), pack2(v0.z, v0.w), pack2(v1.x, v1.y), pack2(v1.z, v1.w)); } \
        __syncthreads(); } while (0)
      X_LOAD(xa, 0);
      X_LOAD(xb, 1);
      X_CHUNK(xa, 0);
      X_LOAD(xa, 2);
      X_CHUNK(xb, 1);
      X_LOAD(xb, 3);
      X_CHUNK(xa, 2);
      X_CHUNK(xb, 3);
#undef X_LOAD
#undef X_CHUNK
#pragma unroll
      for (int i = 0; i < 8; ++i) {
        float ss = ssr[i];
#pragma unroll
        for (int o = 32; o >= 1; o >>= 1) ss += __shfl_xor(ss, o);
        if (lane == 0) ((float*)(ws + OFF_RSTD0))[t0 + w + 4 * i] = rsqrtf(ss * (1.f / 1024.f) + EPS);
      }
      continue;
    }
    it -= N_X;
    if (it < N_ROPE) {
      const int idx = it * 256 + tid; const int pos = idx >> 4, i = idx & 15;
      const float inv = powf(500000.f, -(float)i * (1.f / 16.f));
      const float ang = (float)pos * inv;
      float s, c; sincosf(ang, &s, &c);
      ((float2*)(ws + OFF_ROPE))[idx] = make_float2(c, s);
      continue;
    }
    it -= N_ROPE;
    {
      const int idx = it * 256 + tid;
      if (idx < 1024) {
        const float l0 = p.hgrn_lb[idx], l1 = p.hgrn_lb[1024 + idx];
        ((float*)(ws + OFF_LB))[idx] = 1.f / (1.f + __expf(l1 - l0));
      }
      if (idx == 0) {
        float mq = 0.f, mk = 0.f;
        for (int i = 0; i < 128; ++i) { mq = fmaxf(mq, fabsf(p.q_norm[i])); mk = fmaxf(mk, fabsf(p.k_norm[i])); }
        ((float*)(ws + OFF_MISC))[0] = 11.313708499f * mq * mk;
      }
    }
  }
}

DI void peer_tables(const Params& p, int l, int ibeg, int iend) {
  const int tid = opaque_tid(), lane = tid & 63, w = tid >> 6;
  unsigned char* ws = p.ws;
  for (int i = ibeg; i < iend; ++i) {
    const int e = (int)(blockIdx.x * 4 + w) + (int)(gridDim.x * 4) * i;
    if (e >= 16384) break;
    const float* su = p.peer_u + ((size_t)l * 16384 + e) * 1024 + lane * 4;
    const float* sv = p.peer_v + ((size_t)l * 16384 + e) * 1024 + lane * 4;
    const float* g = p.ffn_norm + l * 1024 + lane * 4;
    float uu[16], vv[16];
#pragma unroll
    for (int k = 0; k < 4; ++k) {
      const float4 a = *(const float4*)(su + 256 * k); const float4 gg = *(const float4*)(g + 256 * k); const float4 bq = *(const float4*)(sv + 256 * k);
      uu[4 * k] = a.x * gg.x; uu[4 * k + 1] = a.y * gg.y; uu[4 * k + 2] = a.z * gg.z; uu[4 * k + 3] = a.w * gg.w;
      vv[4 * k] = bq.x; vv[4 * k + 1] = bq.y; vv[4 * k + 2] = bq.z; vv[4 * k + 3] = bq.w;
    }
    float mu = 0.f, mv = 0.f;
#pragma unroll
    for (int k = 0; k < 16; ++k) { mu = fmaxf(mu, fabsf(uu[k])); mv = fmaxf(mv, fabsf(vv[k])); }
#pragma unroll
    for (int o = 32; o >= 1; o >>= 1) { mu = fmaxf(mu, __shfl_xor(mu, o)); mv = fmaxf(mv, __shfl_xor(mv, o)); }
    const float scu = mu > 0.f ? mu * (1.f / 127.f) : 1.f, scv = mv > 0.f ? mv * (1.f / 127.f) : 1.f;
    const float iu = 1.f / scu, iv = 1.f / scv;
    unsigned char* base = ws + (l ? OFF_UV1 : OFF_UV0);
#pragma unroll
    for (int k = 0; k < 4; ++k) {
      const int pk = (int)pack_i8x4(uu[4 * k] * iu, uu[4 * k + 1] * iu, uu[4 * k + 2] * iu, uu[4 * k + 3] * iu);
      const int pv = (int)pack_i8x4(vv[4 * k] * iv, vv[4 * k + 1] * iv, vv[4 * k + 2] * iv, vv[4 * k + 3] * iv);
      const size_t off = ((size_t)(2 * k + (lane >> 5)) * 16384 + e) * 128 + (lane & 31) * 4;
      *(int*)(base + off) = pk;
      *(int*)(base + 16 * MiB + off) = pv;
    }
    if (lane == 0) ((float2*)(ws + (l ? OFF_SC1 : OFF_SC0)))[e] = make_float2(scu, scv);
  }
}

template <class Epi, int SIDE = 0, bool PAIR = false>
DI void gemm_phase(const Params& p, const u16* __restrict__ A, int lda, const u16* __restrict__ Bt, int ldb, int MT, int NT, int nk, Epi& epi, unsigned char* lds) {
  const int ntl = 0;
  const int nrw = (16384 + (int)gridDim.x * 4 - 1) / ((int)gridDim.x * 4);
  int seq = 0;
  const bool side_first = SIDE && (blockIdx.x * 2 >= gridDim.x);
  if (side_first) peer_tables(p, SIDE - 1, 0, nrw);
  const int Gx = (int)gridDim.x, bxx = (int)blockIdx.x;
  const bool two = Gx >= 2;
  const int Gl = two ? (Gx + 1) >> 1 : Gx;
  const bool upper = two && bxx >= Gl;
  const int NU = PAIR ? NT / 2 : NT;
  const int NH = two ? (upper ? NU - (NU >> 1) : (NU >> 1)) : NU;
  const int ubase = upper ? (NU >> 1) : 0;
  const int ustride = upper ? Gx - Gl : Gl;
  for (int u = upper ? bxx - Gl : bxx; u < MT * NH; u += ustride)
  for (int sub = 0; sub < (PAIR ? 2 : 1); ++sub) {
    const int mt = u / NH, unit = (u - mt * NH) + ubase;
    const int tid = opaque_tid(), lane = tid & 63, w = tid >> 6, l31 = lane & 31, half = lane >> 5;
    const int goffB0 = (tid >> 3) * ldb + (tid & 7) * 8;
    const int loffB0 = off128(tid >> 3, tid & 7);
    const int goffA = w * 32 * lda + lane * 8;
    const int lrowF = l31 * 128, lxF = (half ^ ((l31 >> 1) & 7)) << 4;
    const int nt = PAIR ? 2 * unit + sub : unit;
    const int m0 = mt * 128, n0 = nt * 128;
    f32x16 acc[4];
#pragma unroll
    for (int i = 0; i < 4; ++i)
#pragma unroll
      for (int r = 0; r < 16; ++r) acc[i][r] = 0.f;
    const u16* Ab = A + (size_t)m0 * lda + goffA;
    const u16* Bb = Bt + (size_t)n0 * ldb;
    bf16x8 aR[2][4];
    u32x4 bR[4][4];
#define LOAD_A(slot, ks) do { _Pragma("unroll") for (int kk = 0; kk < 4; ++kk) aR[slot][kk] = *(const bf16x8*)(Ab + ((ks) * 4 + kk) * 512); } while (0)
#define LOAD_B(slot, ks) do { _Pragma("unroll") for (int j = 0; j < 4; ++j) bR[slot][j] = *(const u32x4*)(Bb + goffB0 + j * 32 * ldb + (ks) * 64); } while (0)
#define STORE_B(slot, buf) do { _Pragma("unroll") for (int j = 0; j < 4; ++j) *(u32x4*)(lds + (buf) * 16384 + loffB0 + j * 4096) = bR[slot][j]; } while (0)
#define GEMM_STEP(ks, sa, sb) do { \
      const unsigned char* base_ = lds + ((sa) & 1) * 16384; \
      _Pragma("unroll") for (int kk = 0; kk < 4; ++kk) { \
        _Pragma("unroll") for (int n4 = 0; n4 < 4; ++n4) { \
          const bf16x8 wf = *(const bf16x8*)(base_ + n4 * 4096 + lrowF + (lxF ^ (kk << 5))); \
          acc[n4] = MFMA32(wf, aR[(sa) & 1][kk], acc[n4]); } } \
      if ((ks) + 2 < nk) LOAD_A((sa) & 1, (ks) + 2); \
      if ((ks) + 1 < nk) STORE_B(sb, (sb) & 1); \
      if ((ks) + 5 < nk) LOAD_B(sb, (ks) + 5); \
      __syncthreads(); } while (0)
    LOAD_B(0, 0); LOAD_B(1, 1); LOAD_B(2, 2); LOAD_B(3, 3);
    LOAD_A(0, 0); LOAD_A(1, 1);
    STORE_B(0, 0);
    LOAD_B(0, 4);
    __syncthreads();
#pragma unroll 1
    for (int ks = 0; ks < nk; ks += 4) {
      GEMM_STEP(ks, 0, 1);
      GEMM_STEP(ks + 1, 1, 2);
      GEMM_STEP(ks + 2, 2, 3);
      GEMM_STEP(ks + 3, 3, 0);
    }
    epi(acc, m0 + w * 32 + l31, n0, half);
    ++seq;
  }
  if (SIDE && !side_first) peer_tables(p, SIDE - 1, 0, nrw);
  (void)ntl; (void)seq;
#undef LOAD_A
#undef LOAD_B
#undef STORE_B
#undef GEMM_STEP
}

template <class Epi, int SIDE = 0>
DI void gemm_phase64(const Params& p, const u16* __restrict__ A, int lda, const u16* __restrict__ Bt, int ldb, int MT, int NT, int nk, Epi& epi, unsigned char* lds) {
  const int nrw = (16384 + (int)gridDim.x * 4 - 1) / ((int)gridDim.x * 4);
  const bool side_first = SIDE && (blockIdx.x * 2 >= gridDim.x);
  if (side_first) peer_tables(p, SIDE - 1, 0, nrw);
  const int Gx = (int)gridDim.x, bxx = (int)blockIdx.x;
  const bool two = Gx >= 2;
  const int Gl = two ? (Gx + 1) >> 1 : Gx;
  const bool upper = two && bxx >= Gl;
  const int NH = two ? (upper ? NT - (NT >> 1) : (NT >> 1)) : NT;
  const int ubase = upper ? (NT >> 1) : 0;
  const int ustride = upper ? Gx - Gl : Gl;
  for (int u = upper ? bxx - Gl : bxx; u < MT * NH; u += ustride) {
    const int mt = u / NH, nt = (u - mt * NH) + ubase;
    const int tid = opaque_tid(), lane = tid & 63, w = tid >> 6, l31 = lane & 31, half = lane >> 5;
    const int goffB0 = (tid >> 3) * ldb + (tid & 7) * 8;
    const int loffB0 = off128(tid >> 3, tid & 7);
    const int goffA = w * 64 * lda + lane * 8;
    const int lrowF = l31 * 128, lxF = (half ^ ((l31 >> 1) & 7)) << 4;
    const int m0 = mt * 256, n0 = nt * 128;
    f32x16 acc0[4], acc1[4];
#pragma unroll
    for (int i = 0; i < 4; ++i)
#pragma unroll
      for (int r = 0; r < 16; ++r) { acc0[i][r] = 0.f; acc1[i][r] = 0.f; }
    const u16* Ab = A + (size_t)m0 * lda + goffA;
    const u16* Ab1 = Ab + 32 * lda;
    const u16* Bb = Bt + (size_t)n0 * ldb;
    bf16x8 aR0[4], aR1[4];
    u32x4 bR[2][4];
#define LOAD_B64(slot, ks) do { _Pragma("unroll") for (int j = 0; j < 4; ++j) bR[slot][j] = *(const u32x4*)(Bb + goffB0 + j * 32 * ldb + (ks) * 64); } while (0)
#define STORE_B64(slot, buf) do { _Pragma("unroll") for (int j = 0; j < 4; ++j) *(u32x4*)(lds + (buf) * 16384 + loffB0 + j * 4096) = bR[slot][j]; } while (0)
#define STEP64(ks, buf, st) do { \
      const unsigned char* base_ = lds + (buf) * 16384; \
      const int kn_ = min((ks) + 1, nk - 1), kb_ = min((ks) + 3, nk - 1); \
      _Pragma("unroll") for (int kk = 0; kk < 4; ++kk) { \
        _Pragma("unroll") for (int n4 = 0; n4 < 4; ++n4) { \
          const bf16x8 wf = *(const bf16x8*)(base_ + n4 * 4096 + lrowF + (lxF ^ (kk << 5))); \
          acc0[n4] = MFMA32(wf, aR0[kk], acc0[n4]); \
          acc1[n4] = MFMA32(wf, aR1[kk], acc1[n4]); } \
        aR0[kk] = *(const bf16x8*)(Ab + (kn_ * 4 + kk) * 512); \
        aR1[kk] = *(const bf16x8*)(Ab1 + (kn_ * 4 + kk) * 512); } \
      STORE_B64(st, (buf) ^ 1); \
      LOAD_B64(st, kb_); \
      __syncthreads(); } while (0)
    LOAD_B64(0, 0); LOAD_B64(1, 1);
#pragma unroll
    for (int kk = 0; kk < 4; ++kk) { aR0[kk] = *(const bf16x8*)(Ab + kk * 512); aR1[kk] = *(const bf16x8*)(Ab1 + kk * 512); }
    STORE_B64(0, 0);
    LOAD_B64(0, min(2, nk - 1));
    __syncthreads();
#pragma unroll 1
    for (int ks = 0; ks < nk; ks += 2) {
      STEP64(ks, 0, 1);
      STEP64(ks + 1, 1, 0);
    }
    epi(acc0, m0 + w * 64 + l31, n0, half);
    epi(acc1, m0 + w * 64 + 32 + l31, n0, half);
  }
  if (SIDE && !side_first) peer_tables(p, SIDE - 1, 0, nrw);
#undef LOAD_B64
#undef STORE_B64
#undef STEP64
}

struct EpiNull {
  DI void operator()(f32x16 (&acc)[4], int m, int n0, int half) const {
#pragma unroll
    for (int i = 0; i < 4; ++i)
#pragma unroll
      for (int r = 0; r < 16; ++r) asm volatile("" :: "v"(acc[i][r]));
  }
};
struct EpiHgrnIn {
  const float* rstd; const float* lb; u16 *Qg, *Vg, *Gg; _Float16* LOGF;
  DI void operator()(f32x16 (&acc)[4], int m, int n0, int half) const {
    const float rs = rstd[m];
    const int sec = n0 >> 10, colb = n0 & 1023;
    const int pos = m & (SEQ - 1);
    const size_t tb0 = ((size_t)(((m >> 13) * 8 + (colb >> 7)) * 128 + (pos >> 6))) * 8192 + (size_t)(pos & 63) * 4;
#pragma unroll
    for (int n4 = 0; n4 < 4; ++n4)
#pragma unroll
      for (int g = 0; g < 4; ++g) {
        const int dl = n4 * 32 + 8 * g + 4 * half;
        const size_t to = tb0 + (size_t)(dl >> 2) * 256;
        float v[4];
#pragma unroll
        for (int j = 0; j < 4; ++j) v[j] = acc[n4][4 * g + j] * rs;
        if (sec == 0) {
          *(uint2*)(Qg + to) = make_uint2(pack2(siluf_(v[0]), siluf_(v[1])), pack2(siluf_(v[2]), siluf_(v[3])));
        } else if (sec == 1) {
          const float4 lbv = *(const float4*)(lb + colb + dl);
          const float lbs[4] = {lbv.x, lbv.y, lbv.z, lbv.w};
          typedef _Float16 h4 __attribute__((ext_vector_type(4)));
          h4 lf;
#pragma unroll
          for (int j = 0; j < 4; ++j) lf[j] = (_Float16)__logf(lbs[j] + (1.f - lbs[j]) * sigmoidf_(v[j]));
          *(h4*)(LOGF + to) = lf;
        } else if (sec == 2) {
          *(uint2*)(Vg + to) = make_uint2(pack2(v[0], v[1]), pack2(v[2], v[3]));
        } else {
          *(uint2*)(Gg + to) = make_uint2(pack2(siluf_(v[0]), siluf_(v[1])), pack2(siluf_(v[2]), siluf_(v[3])));
        }
      }
  }
};

template <bool RES_TILED>
struct EpiResidual {
  const float* res; u16* hbt; float* ss; unsigned char* hq; float* hs;
  DI void operator()(f32x16 (&acc)[4], int m, int n0, int half) const {
    float s = 0.f, amax = 0.f;
#pragma unroll
    for (int n4 = 0; n4 < 4; ++n4)
#pragma unroll
      for (int g = 0; g < 4; ++g) {
        const int col = n0 + n4 * 32 + 8 * g + 4 * half;
        u16* dst = hbt + tiledA(m, col, 1024);
        float r0, r1, r2, r3;
        if (RES_TILED) { const uint2 rv = *(const uint2*)dst; r0 = bflo(rv.x); r1 = bfhi(rv.x); r2 = bflo(rv.y); r3 = bfhi(rv.y); }
        else { const float4 rv = *(const float4*)(res + (size_t)m * 1024 + col); r0 = rv.x; r1 = rv.y; r2 = rv.z; r3 = rv.w; }
        const float v0 = acc[n4][4 * g] + r0, v1 = acc[n4][4 * g + 1] + r1, v2 = acc[n4][4 * g + 2] + r2, v3 = acc[n4][4 * g + 3] + r3;
        const unsigned p01 = pack2(v0, v1), p23 = pack2(v2, v3);
        *(uint2*)dst = make_uint2(p01, p23);
        s += v0 * v0 + v1 * v1 + v2 * v2 + v3 * v3;
        acc[n4][4 * g] = bflo(p01); acc[n4][4 * g + 1] = bfhi(p01); acc[n4][4 * g + 2] = bflo(p23); acc[n4][4 * g + 3] = bfhi(p23);
        amax = fmaxf(fmaxf(amax, fmaxf(fabsf(acc[n4][4 * g]), fabsf(acc[n4][4 * g + 1]))), fmaxf(fabsf(acc[n4][4 * g + 2]), fabsf(acc[n4][4 * g + 3])));
      }
    s += __shfl_xor(s, 32);
    amax = fmaxf(amax, __shfl_xor(amax, 32));
    const float qi = amax > 0.f ? 127.f / amax : 0.f;
    unsigned char* hrow = hq + ((size_t)(n0 >> 7) * T_TOK + m) * 128 + 4 * half;
#pragma unroll
    for (int n4 = 0; n4 < 4; ++n4)
#pragma unroll
      for (int g = 0; g < 4; ++g)
        *(unsigned*)(hrow + n4 * 32 + 8 * g) = pack_i8x4(acc[n4][4 * g] * qi, acc[n4][4 * g + 1] * qi, acc[n4][4 * g + 2] * qi, acc[n4][4 * g + 3] * qi);
    if (half == 0) hs[(size_t)(n0 >> 7) * T_TOK + m] = amax * (1.f / 127.f);
    if (half == 0) ss[(size_t)m * 8 + (n0 >> 7)] = s;
  }
};

struct EpiTopk {
  const float* ss; int* EX; float* GT; unsigned char* sel_lds;
  DI void operator()(f32x16 (&acc)[4], int m, int n0, int half) {
    const float rs = rstd_from_partials(ss, m);
    int k0[16], k1[16];
#pragma unroll
    for (int r = 0; r < 16; ++r) {
      k0[r] = (key_of(acc[0][r] * rs) & ~0x7f) | (crow(r, half));
      k1[r] = (key_of(acc[1][r] * rs) & ~0x7f) | (32 + crow(r, half));
    }
    bitonic_sort_desc<16>(k0);
    __builtin_amdgcn_sched_barrier(0);
    bitonic_sort_desc<16>(k1);
    merge_top16(k0, k1);
    __builtin_amdgcn_sched_barrier(0);
#pragma unroll
    for (int r = 0; r < 16; ++r) k1[r] = (key_of(acc[2][r] * rs) & ~0x7f) | (64 + crow(r, half));
    bitonic_sort_desc<16>(k1);
    merge_top16(k0, k1);
    __builtin_amdgcn_sched_barrier(0);
#pragma unroll
    for (int r = 0; r < 16; ++r) k1[r] = (key_of(acc[3][r] * rs) & ~0x7f) | (96 + crow(r, half));
    bitonic_sort_desc<16>(k1);
    merge_top16(k0, k1);
    __builtin_amdgcn_sched_barrier(0);
    int b[16];
#pragma unroll
    for (int j = 0; j < 16; ++j) b[j] = __shfl_xor(k0[j], 32);
    merge_top16(k0, b);
    volatile LAS int* stash = (volatile LAS int*)(sel_lds + 2048 + (threadIdx.x & 63) * 64);
    if (((n0 >> 7) & 1) == 0) {
#pragma unroll
      for (int j = 0; j < 16; ++j) stash[j] = k0[j];
      return;
    }
    int kprev[16];
#pragma unroll
    for (int j = 0; j < 16; ++j) kprev[j] = stash[j];
#define F1(i) val_of(kprev[i] & ~0x7f)
#define F2(j) val_of(k0[j] & ~0x7f)
    int a[16];
#pragma unroll
    for (int j = 0; j < 16; ++j) a[j] = (int)0x80000000;
#define SEL_PAIR(IA, JA, IB, JB) do { const int ka_ = (key_of(F1(IA) + F2(JA)) & ~0xff) | ((IA) * 16 + (JA)), kb_ = (key_of(F1(IB) + F2(JB)) & ~0xff) | ((IB) * 16 + (JB)); \
      const int kk_ = half ? kb_ : ka_; TOPK_INSERT(a, kk_); } while (0)
      SEL_PAIR(0, 0, 0, 1);
      SEL_PAIR(0, 2, 0, 3);
      SEL_PAIR(0, 4, 0, 5);
      SEL_PAIR(0, 6, 0, 7);
      SEL_PAIR(0, 8, 0, 9);
      SEL_PAIR(0, 10, 0, 11);
      SEL_PAIR(0, 12, 0, 13);
      SEL_PAIR(0, 14, 0, 15);
      SEL_PAIR(1, 0, 1, 1);
      SEL_PAIR(1, 2, 1, 3);
      SEL_PAIR(1, 4, 1, 5);
      SEL_PAIR(1, 6, 1, 7);
      SEL_PAIR(2, 0, 2, 1);
      SEL_PAIR(2, 2, 2, 3);
      SEL_PAIR(2, 4, 3, 0);
      SEL_PAIR(3, 1, 3, 2);
      SEL_PAIR(3, 3, 4, 0);
      SEL_PAIR(4, 1, 4, 2);
      SEL_PAIR(5, 0, 5, 1);
      SEL_PAIR(6, 0, 6, 1);
      SEL_PAIR(7, 0, 7, 1);
      SEL_PAIR(8, 0, 9, 0);
      SEL_PAIR(10, 0, 11, 0);
      SEL_PAIR(12, 0, 13, 0);
      SEL_PAIR(14, 0, 15, 0);
#undef SEL_PAIR
#undef F1
#undef F2
#pragma unroll
    for (int j = 0; j < 16; ++j) b[j] = __shfl_xor(a[j], 32);
    merge_top16(a, b);
    volatile LAS unsigned char* my = (volatile LAS unsigned char*)(sel_lds + (m & 31) * 36);
    {
      unsigned pk4[4];
#pragma unroll
      for (int q = 0; q < 4; ++q) {
        const int s0 = half ? k0[4 * q] : kprev[4 * q], s1 = half ? k0[4 * q + 1] : kprev[4 * q + 1], s2 = half ? k0[4 * q + 2] : kprev[4 * q + 2], s3 = half ? k0[4 * q + 3] : kprev[4 * q + 3];
        pk4[q] = (unsigned)(s0 & 0x7f) | ((unsigned)(s1 & 0x7f) << 8) | ((unsigned)(s2 & 0x7f) << 16) | ((unsigned)(s3 & 0x7f) << 24);
      }
#pragma unroll
      for (int q = 0; q < 4; ++q) *(volatile LAS unsigned*)(my + half * 16 + 4 * q) = pk4[q];
    }
    asm volatile("s_waitcnt lgkmcnt(0)" ::: "memory");
    float cs[16];
    float sum = 0.f;
    const float mx = val_of(a[0] & ~0xff);
#pragma unroll
    for (int k = 0; k < 16; ++k) { cs[k] = __expf(val_of(a[k] & ~0xff) - mx); sum += cs[k]; }
    const float inv = 1.f / sum;
    const int hcol = (n0 >> 8) * 16;
    if (half == 0) {
      int eo[16];
#pragma unroll
      for (int k = 0; k < 16; ++k) { const int ij = a[k] & 0xff; eo[k] = (int)my[ij >> 4] * 128 + (int)my[16 + (ij & 15)]; }
      int4* de = (int4*)(EX + (size_t)m * 128 + hcol);
#pragma unroll
      for (int q = 0; q < 4; ++q) de[q] = make_int4(eo[4 * q], eo[4 * q + 1], eo[4 * q + 2], eo[4 * q + 3]);
    } else {
      float4* dg = (float4*)(GT + (size_t)m * 128 + hcol);
#pragma unroll
      for (int q = 0; q < 4; ++q) dg[q] = make_float4(cs[4 * q] * inv, cs[4 * q + 1] * inv, cs[4 * q + 2] * inv, cs[4 * q + 3] * inv);
    }
  }
};

struct EpiKVQ {
  const float* ss; const float *k_norm, *q_norm; const float2* rope; u16 *Kb, *Vb, *Qb; unsigned char* stage;
  DI void operator()(f32x16 (&acc)[4], int m, int n0, int half) const {
    const float rs = rstd_from_partials(ss, m);
    u16* dst; const float* gain = nullptr; int ld;
    if (n0 < 768) { dst = Kb + (size_t)m * 768 + n0; gain = k_norm; ld = 768; }
    else if (n0 < 1536) { dst = Vb + (size_t)m * 768 + (n0 - 768); ld = 768; }
    else { dst = Qb + (size_t)m * 1536 + (n0 - 1536); gain = q_norm; ld = 1536; }
#pragma unroll
    for (int n4 = 0; n4 < 4; ++n4)
#pragma unroll
      for (int r = 0; r < 16; ++r) acc[n4][r] *= rs;
    if (gain) {
      float s = 0.f;
#pragma unroll
      for (int n4 = 0; n4 < 4; ++n4)
#pragma unroll
        for (int r = 0; r < 16; ++r) s += acc[n4][r] * acc[n4][r];
      s += __shfl_xor(s, 32);
      const float rn = rsqrtf(s * (1.f / 128.f) + EPS);
#pragma unroll
      for (int n4 = 0; n4 < 4; ++n4)
#pragma unroll
        for (int g = 0; g < 4; ++g) {
          const float4 gv = *(const float4*)(gain + n4 * 32 + 8 * g + 4 * half);
          acc[n4][4 * g] *= rn * gv.x; acc[n4][4 * g + 1] *= rn * gv.y; acc[n4][4 * g + 2] *= rn * gv.z; acc[n4][4 * g + 3] *= rn * gv.w;
        }
      const int pos = m & (SEQ - 1);
#pragma unroll
      for (int r = 0; r < 8; ++r) {
        const float2 cs = rope[pos * 16 + crow(r, half)];
        const float x1 = acc[0][r], x2 = acc[0][r + 8];
        acc[0][r] = x1 * cs.x - x2 * cs.y;
        acc[0][r + 8] = x2 * cs.x + x1 * cs.y;
      }
    }
    unsigned char* st = stage + (threadIdx.x >> 6) * 4352;
    const int l31 = threadIdx.x & 31;
    const int rr = (threadIdx.x & 63) >> 3, cc = threadIdx.x & 7;
    u16* dbase = dst - (size_t)l31 * ld;
#pragma unroll
    for (int ps = 0; ps < 2; ++ps) {
#pragma unroll
      for (int n2 = 0; n2 < 2; ++n2)
#pragma unroll
        for (int g = 0; g < 4; ++g)
          *(uint2*)(st + l31 * 136 + (n2 * 32 + 8 * g + 4 * half) * 2) = make_uint2(pack2(acc[ps * 2 + n2][4 * g], acc[ps * 2 + n2][4 * g + 1]), pack2(acc[ps * 2 + n2][4 * g + 2], acc[ps * 2 + n2][4 * g + 3]));
      asm volatile("s_waitcnt lgkmcnt(0)" ::: "memory");
#pragma unroll
      for (int i = 0; i < 4; ++i) {
        const uint2 a = *(const uint2*)(st + (rr + 8 * i) * 136 + cc * 16), b = *(const uint2*)(st + (rr + 8 * i) * 136 + cc * 16 + 8);
        *(uint4*)(dbase + (size_t)(rr + 8 * i) * ld + ps * 64 + cc * 8) = make_uint4(a.x, a.y, b.x, b.y);
      }
      asm volatile("s_waitcnt lgkmcnt(0)" ::: "memory");
    }
  }
};

DI void gla_g1(const Params& p, unsigned char* lds) {
  const int tid = opaque_tid(), lane = tid & 63, w = tid >> 6, l31 = lane & 31, half = lane >> 5;
  unsigned char* ws = p.ws;
  const _Float16* LOGF = (const _Float16*)(ws + OFF_LOGF);
  const u16* Vg = (const u16*)(ws + OFF_VG);
  u16* UT = (u16*)(ws + OFF_UT);
  float* ACH = (float*)(ws + OFF_ACH);
  unsigned char* KT = lds;
  unsigned char* VT = lds + 16384;
  float* tot = (float*)(lds + 32768);
  for (int item = blockIdx.x; item < 2048; item += gridDim.x) {
    const int bh = item >> 7, c = item & 127, b = bh >> 3, h = bh & 7;
    (void)b; (void)h;
    const int dg = tid & 31, jr = tid >> 5, d0 = dg * 4;
    const size_t tb = (size_t)item * 8192 + (size_t)(dg * 64 + jr * 8) * 4;
    float lfv[8][4], bl[8][4];
    {
      typedef _Float16 h8 __attribute__((ext_vector_type(8)));
      float run[4] = {0.f, 0.f, 0.f, 0.f};
#pragma unroll
      for (int q = 0; q < 4; ++q) {
        const h8 lf = *(const h8*)(LOGF + tb + 8 * q);
#pragma unroll
        for (int i = 0; i < 8; ++i) { const int jj = 2 * q + (i >> 2), dd = i & 3; lfv[jj][dd] = (float)lf[i]; run[dd] += lfv[jj][dd]; bl[jj][dd] = run[dd]; }
      }
      *(float4*)(tot + jr * 128 + d0) = make_float4(run[0], run[1], run[2], run[3]);
    }
    __syncthreads();
    float pre[4] = {0.f, 0.f, 0.f, 0.f}, blast[4] = {0.f, 0.f, 0.f, 0.f};
#pragma unroll
    for (int r = 0; r < 8; ++r) {
      const float4 tv = *(const float4*)(tot + r * 128 + d0);
      const float m_ = (r < jr) ? 1.f : 0.f;
      pre[0] += m_ * tv.x; pre[1] += m_ * tv.y; pre[2] += m_ * tv.z; pre[3] += m_ * tv.w;
      blast[0] += tv.x; blast[1] += tv.y; blast[2] += tv.z; blast[3] += tv.w;
    }
#pragma unroll
    for (int dd = 0; dd < 4; ++dd) {
      unsigned pk[4];
#pragma unroll
      for (int i = 0; i < 4; ++i)
        pk[i] = pack2((1.f - __expf(lfv[2 * i][dd])) * __expf(blast[dd] - (bl[2 * i][dd] + pre[dd])), (1.f - __expf(lfv[2 * i + 1][dd])) * __expf(blast[dd] - (bl[2 * i + 1][dd] + pre[dd])));
      *(uint4*)(KT + off128(d0 + dd, jr)) = make_uint4(pk[0], pk[1], pk[2], pk[3]);
    }
    {
      uint4 vq[4];
#pragma unroll
      for (int q = 0; q < 4; ++q) vq[q] = *(const uint4*)(Vg + tb + 8 * q);
      *(uint4*)(VT + off128(d0 + 0, jr)) = make_uint4((vq[0].x & 0xffffu) | (vq[0].z << 16), (vq[1].x & 0xffffu) | (vq[1].z << 16), (vq[2].x & 0xffffu) | (vq[2].z << 16), (vq[3].x & 0xffffu) | (vq[3].z << 16));
      *(uint4*)(VT + off128(d0 + 1, jr)) = make_uint4((vq[0].x >> 16) | (vq[0].z & 0xffff0000u), (vq[1].x >> 16) | (vq[1].z & 0xffff0000u), (vq[2].x >> 16) | (vq[2].z & 0xffff0000u), (vq[3].x >> 16) | (vq[3].z & 0xffff0000u));
      *(uint4*)(VT + off128(d0 + 2, jr)) = make_uint4((vq[0].y & 0xffffu) | (vq[0].w << 16), (vq[1].y & 0xffffu) | (vq[1].w << 16), (vq[2].y & 0xffffu) | (vq[2].w << 16), (vq[3].y & 0xffffu) | (vq[3].w << 16));
      *(uint4*)(VT + off128(d0 + 3, jr)) = make_uint4((vq[0].y >> 16) | (vq[0].w & 0xffff0000u), (vq[1].y >> 16) | (vq[1].w & 0xffff0000u), (vq[2].y >> 16) | (vq[2].w & 0xffff0000u), (vq[3].y >> 16) | (vq[3].w & 0xffff0000u));
    }
    if (jr == 0) *(float4*)(ACH + item * 128 + d0) = make_float4(__expf(blast[0]), __expf(blast[1]), __expf(blast[2]), __expf(blast[3]));
    __syncthreads();
    f32x16 acc[4];
#pragma unroll
    for (int i = 0; i < 4; ++i)
#pragma unroll
      for (int r = 0; r < 16; ++r) acc[i][r] = 0.f;
#pragma unroll
    for (int s = 0; s < 4; ++s) {
      const bf16x8 af = *(const bf16x8*)(KT + off128(w * 32 + l31, 2 * s + half));
#pragma unroll
      for (int et = 0; et < 4; ++et) {
        const bf16x8 bfr = *(const bf16x8*)(VT + off128(et * 32 + l31, 2 * s + half));
        acc[et] = MFMA32(af, bfr, acc[et]);
      }
    }
#pragma unroll
    for (int et = 0; et < 4; ++et)
#pragma unroll
      for (int g = 0; g < 4; ++g) {
        const int e = et * 32 + l31, d0 = w * 32 + 8 * g + 4 * half;
        *(uint2*)(UT + ((size_t)item * 128 + e) * 128 + d0) = make_uint2(pack2(acc[et][4 * g], acc[et][4 * g + 1]), pack2(acc[et][4 * g + 2], acc[et][4 * g + 3]));
      }
    __syncthreads();
  }
}

DI void gla_g2(const Params& p) {
  const int tid = opaque_tid();
  unsigned char* ws = p.ws;
  u16* UT = (u16*)(ws + OFF_UT);
  const float* ACH = (const float*)(ws + OFF_ACH);
  for (int u = blockIdx.x; u < 1024; u += gridDim.x) {
    const int bh = u >> 6, e = (u & 63) * 2 + (tid >> 7), d = tid & 127;
    float S = 0.f;
    size_t idx = ((size_t)bh * 128) * 16384 + (size_t)e * 128 + d;
    size_t aidx = (size_t)bh * 128 * 128 + d;
    for (int c = 0; c < 128; c += 32) {
      float uv[32], av[32];
#pragma unroll
      for (int k = 0; k < 32; ++k) { uv[k] = bf2f(UT[idx + (size_t)k * 16384]); av[k] = ACH[aidx + (size_t)k * 128]; }
#pragma unroll
      for (int k = 0; k < 32; ++k) { UT[idx + (size_t)k * 16384] = f2bf(S); S = av[k] * S + uv[k]; }
      idx += (size_t)32 * 16384; aidx += 32 * 128;
    }
  }
}

DI void gla_g3(const Params& p, unsigned char* lds) {
  const int tid = opaque_tid(), lane = tid & 63, w = tid >> 6, l31 = lane & 31, half = lane >> 5;
  unsigned char* ws = p.ws;
  const _Float16* LOGF = (const _Float16*)(ws + OFF_LOGF);
  const u16* Qg = (const u16*)(ws + OFF_QG);
  const u16* Vg = (const u16*)(ws + OFF_VG);
  const u16* Gg = (const u16*)(ws + OFF_GG);
  const u16* ST = (const u16*)(ws + OFF_UT);
  u16* OG = (u16*)(ws + OFF_OG);
  unsigned char* QP = lds;
  unsigned char* KP = lds + 16384;
  unsigned char* VT = lds + 32768;
  unsigned char* STs = lds + 16384;
  float* tot = (float*)(lds + 49152);
  float* red = (float*)(lds + 49152 + 4096);
  for (int item = blockIdx.x; item < 2048; item += gridDim.x) {
    const int bh = item >> 7, c = item & 127, b = bh >> 3, h = bh & 7;
    const int t0 = b * SEQ + c * 64;
    u32x4 stq[8];
    {
      const u16* src = ST + (size_t)item * 16384;
#pragma unroll
      for (int j = 0; j < 8; ++j) { const int id = tid + 256 * j; stq[j] = *(const u32x4*)(src + (size_t)(id >> 4) * 128 + (id & 15) * 8); }
    }
    u32x2 ggq[2][4];
    {
      const int tq_ = t0 + (w & 1) * 32 + l31;
#pragma unroll
      for (int ee = 0; ee < 2; ++ee)
#pragma unroll
        for (int g = 0; g < 4; ++g) ggq[ee][g] = *(const u32x2*)(Gg + (size_t)item * 8192 + (size_t)(((((w >> 1) * 2 + ee) * 32 + 8 * g + 4 * half) >> 2) * 64 + (w & 1) * 32 + l31) * 4);
    }
    const int dg = tid & 31, jr = tid >> 5, d0 = dg * 4;
    const size_t tb = (size_t)item * 8192 + (size_t)(dg * 64 + jr * 8) * 4;
    float lfv[8][4], bl[8][4];
    {
      typedef _Float16 h8 __attribute__((ext_vector_type(8)));
      float run[4] = {0.f, 0.f, 0.f, 0.f};
#pragma unroll
      for (int q = 0; q < 4; ++q) {
        const h8 lf = *(const h8*)(LOGF + tb + 8 * q);
#pragma unroll
        for (int i = 0; i < 8; ++i) { const int jj = 2 * q + (i >> 2), dd = i & 3; lfv[jj][dd] = (float)lf[i]; run[dd] += lfv[jj][dd]; bl[jj][dd] = run[dd]; }
      }
      *(float4*)(tot + jr * 128 + d0) = make_float4(run[0], run[1], run[2], run[3]);
    }
    __syncthreads();
    float pre[4] = {0.f, 0.f, 0.f, 0.f}, blast[4] = {0.f, 0.f, 0.f, 0.f};
#pragma unroll
    for (int r = 0; r < 8; ++r) {
      const float4 tv = *(const float4*)(tot + r * 128 + d0);
      const float m_ = (r < jr) ? 1.f : 0.f;
      pre[0] += m_ * tv.x; pre[1] += m_ * tv.y; pre[2] += m_ * tv.z; pre[3] += m_ * tv.w;
      blast[0] += tv.x; blast[1] += tv.y; blast[2] += tv.z; blast[3] += tv.w;
    }
    {
      uint4 qq[4];
#pragma unroll
      for (int q = 0; q < 4; ++q) qq[q] = *(const uint4*)(Qg + tb + 8 * q);
#pragma unroll
      for (int jj = 0; jj < 8; ++jj) {
        const int i = jr * 8 + jj;
        const unsigned q01 = (jj & 1) ? qq[jj >> 1].z : qq[jj >> 1].x, q23 = (jj & 1) ? qq[jj >> 1].w : qq[jj >> 1].y;
        const float qf[4] = {bflo(q01), bfhi(q01), bflo(q23), bfhi(q23)};
        float qv[4], kv[4];
#pragma unroll
        for (int dd = 0; dd < 4; ++dd) { const float bv = bl[jj][dd] + pre[dd]; qv[dd] = qf[dd] * __expf(bv); kv[dd] = (1.f - __expf(lfv[jj][dd])) * __expf(-bv); }
        const int o = i * 256 + (((d0 >> 3) ^ (i & 15)) << 4) + (d0 & 7) * 2;
        *(uint2*)(QP + o) = make_uint2(pack2(qv[0], qv[1]), pack2(qv[2], qv[3]));
        *(uint2*)(KP + o) = make_uint2(pack2(kv[0], kv[1]), pack2(kv[2], kv[3]));
      }
    }
    {
      uint4 vq[4];
#pragma unroll
      for (int q = 0; q < 4; ++q) vq[q] = *(const uint4*)(Vg + tb + 8 * q);
      *(uint4*)(VT + off128(d0 + 0, jr)) = make_uint4((vq[0].x & 0xffffu) | (vq[0].z << 16), (vq[1].x & 0xffffu) | (vq[1].z << 16), (vq[2].x & 0xffffu) | (vq[2].z << 16), (vq[3].x & 0xffffu) | (vq[3].z << 16));
      *(uint4*)(VT + off128(d0 + 1, jr)) = make_uint4((vq[0].x >> 16) | (vq[0].z & 0xffff0000u), (vq[1].x >> 16) | (vq[1].z & 0xffff0000u), (vq[2].x >> 16) | (vq[2].z & 0xffff0000u), (vq[3].x >> 16) | (vq[3].z & 0xffff0000u));
      *(uint4*)(VT + off128(d0 + 2, jr)) = make_uint4((vq[0].y & 0xffffu) | (vq[0].w << 16), (vq[1].y & 0xffffu) | (vq[1].w << 16), (vq[2].y & 0xffffu) | (vq[2].w << 16), (vq[3].y & 0xffffu) | (vq[3].w << 16));
      *(uint4*)(VT + off128(d0 + 3, jr)) = make_uint4((vq[0].y >> 16) | (vq[0].w & 0xffff0000u), (vq[1].y >> 16) | (vq[1].w & 0xffff0000u), (vq[2].y >> 16) | (vq[2].w & 0xffff0000u), (vq[3].y >> 16) | (vq[3].w & 0xffff0000u));
    }
    __syncthreads();
    const int it = w & 1, eh = w >> 1;
    f32x16 pt0, pt1;
#pragma unroll
    for (int r = 0; r < 16; ++r) { pt0[r] = 0.f; pt1[r] = 0.f; }
#pragma unroll
    for (int kk = 0; kk < 8; ++kk) {
      const bf16x8 bq = *(const bf16x8*)(QP + off256(it * 32 + l31, 2 * kk + half));
      const bf16x8 a0 = *(const bf16x8*)(KP + off256(l31, 2 * kk + half));
      pt0 = MFMA32(a0, bq, pt0);
      if (it) {
        const bf16x8 a1 = *(const bf16x8*)(KP + off256(32 + l31, 2 * kk + half));
        pt1 = MFMA32(a1, bq, pt1);
      }
    }
    if (it == 0) {
#pragma unroll
      for (int r = 0; r < 16; ++r) if (crow(r, half) > l31) pt0[r] = 0.f;
    } else {
#pragma unroll
      for (int r = 0; r < 16; ++r) if (crow(r, half) > l31) pt1[r] = 0.f;
    }
    bf16x8 pf[2][2];
#pragma unroll
    for (int s = 0; s < 2; ++s) {
      uint4 u0 = make_uint4(pack2(pt0[8 * s], pt0[8 * s + 1]), pack2(pt0[8 * s + 2], pt0[8 * s + 3]), pack2(pt0[8 * s + 4], pt0[8 * s + 5]), pack2(pt0[8 * s + 6], pt0[8 * s + 7]));
      uint4 u1 = make_uint4(pack2(pt1[8 * s], pt1[8 * s + 1]), pack2(pt1[8 * s + 2], pt1[8 * s + 3]), pack2(pt1[8 * s + 4], pt1[8 * s + 5]), pack2(pt1[8 * s + 6], pt1[8 * s + 7]));
      pf[0][s] = __builtin_bit_cast(bf16x8, u0);
      pf[1][s] = __builtin_bit_cast(bf16x8, u1);
    }
    f32x16 acc[2];
#pragma unroll
    for (int i = 0; i < 2; ++i)
#pragma unroll
      for (int r = 0; r < 16; ++r) acc[i][r] = 0.f;
#pragma unroll
    for (int ee = 0; ee < 2; ++ee) {
      const int e = (eh * 2 + ee) * 32 + l31;
#pragma unroll
      for (int jt = 0; jt < 2; ++jt) {
        if (jt <= it) {
#pragma unroll
          for (int s = 0; s < 2; ++s) {
            const int cA = 4 * jt + 2 * s;
            const uint2 lo = *(const uint2*)(VT + off128(e, cA) + 8 * half);
            const uint2 hi = *(const uint2*)(VT + off128(e, cA + 1) + 8 * half);
            const bf16x8 av = __builtin_bit_cast(bf16x8, make_uint4(lo.x, lo.y, hi.x, hi.y));
            acc[ee] = MFMA32(av, pf[jt][s], acc[ee]);
          }
        }
      }
    }
    __syncthreads();
    {
#pragma unroll
      for (int j = 0; j < 8; ++j) {
        const int id = tid + 256 * j, e = id >> 4, cc = id & 15;
        *(u32x4*)(STs + off256(e, cc)) = stq[j];
      }
    }
    __syncthreads();
#pragma unroll
    for (int kk = 0; kk < 8; ++kk) {
      const bf16x8 bq = *(const bf16x8*)(QP + off256(it * 32 + l31, 2 * kk + half));
#pragma unroll
      for (int ee = 0; ee < 2; ++ee) {
        const bf16x8 as = *(const bf16x8*)(STs + off256((eh * 2 + ee) * 32 + l31, 2 * kk + half));
        acc[ee] = MFMA32(as, bq, acc[ee]);
      }
    }
    float ssq = 0.f;
#pragma unroll
    for (int ee = 0; ee < 2; ++ee)
#pragma unroll
      for (int r = 0; r < 16; ++r) ssq += acc[ee][r] * acc[ee][r];
    ssq += __shfl_xor(ssq, 32);
    if (half == 0) red[w * 32 + l31] = ssq;
    __syncthreads();
    const float rn = rsqrtf((red[w * 32 + l31] + red[(w ^ 2) * 32 + l31]) * (1.f / 128.f) + EPS);
    const int t = t0 + it * 32 + l31;
#pragma unroll
    for (int ee = 0; ee < 2; ++ee)
#pragma unroll
      for (int g = 0; g < 4; ++g) {
        const int e0 = (eh * 2 + ee) * 32 + 8 * g + 4 * half;
        const size_t o = (size_t)t * 1024 + h * 128 + e0;
        const uint2 gg = make_uint2(ggq[ee][g][0], ggq[ee][g][1]);
        const float4 og = *(const float4*)(p.hgrn_out_norm + e0);
        const float v0 = acc[ee][4 * g] * rn * og.x * bflo(gg.x), v1 = acc[ee][4 * g + 1] * rn * og.y * bfhi(gg.x);
        const float v2 = acc[ee][4 * g + 2] * rn * og.z * bflo(gg.y), v3 = acc[ee][4 * g + 3] * rn * og.w * bfhi(gg.y);
        *(uint2*)(OG + tiledA(t, h * 128 + e0, 1024)) = make_uint2(pack2(v0, v1), pack2(v2, v3));
      }
    __syncthreads();
  }
}

struct XcdSlot { int part0, pstride, rank, cnt; };
DI XcdSlot xcd_slot(const Params& p, unsigned myrank) {
  const unsigned* census = (const unsigned*)(p.ws + OFF_CENSUS);
  const unsigned myx = (unsigned)__builtin_amdgcn_s_getreg((3 << 11) | 20) & 0xFu;
  int nx = 0, ix = 0, cnt = 1;
#pragma unroll
  for (int j = 0; j < 16; ++j) {
    const unsigned c = __builtin_amdgcn_readfirstlane(census[j]);
    if (c) { if ((unsigned)j == myx) { ix = nx; cnt = (int)c; } ++nx; }
  }
  XcdSlot sl; sl.part0 = ix; sl.pstride = nx > 0 ? nx : 1; sl.rank = (int)myrank; sl.cnt = cnt;
  return sl;
}

DI void peer_s1(const Params& p, int layer, const XcdSlot sl) {
  const int tid = opaque_tid(), lane = tid & 63, w = tid >> 6;
  unsigned char* ws = p.ws;
  const int* EX = (const int*)(ws + OFF_EX);
  const unsigned char* U8 = ws + (layer ? OFF_UV1 : OFF_UV0);
  const unsigned char* HQ = ws + OFF_HQ;
  const float* HS = (const float*)(ws + OFF_HS);
  float* ZP = (float*)(ws + OFF_ZP);
  const int c8 = lane & 7, rg = lane >> 3;
  const bool b2 = (lane & 4) != 0, b1 = (lane & 2) != 0, b0 = (lane & 1) != 0;
  const int first = sl.rank * 4 + w, stride = sl.cnt * 4;
  const int nT = (T_TOK - first + stride - 1) / stride;
  const int nparts = (8 - sl.part0 + sl.pstride - 1) / sl.pstride;
  const int total = nT * nparts;
  if (total <= 0) return;
#define Z1_ITEM(IT, X, T) do { int it_ = (IT) < total ? (IT) : total - 1; const int xi_ = it_ / nT; X = sl.part0 + xi_ * sl.pstride; T = first + (it_ - xi_ * nT) * stride; } while (0)
  int ev[16];
  u32x4 qX[16], qY[16];
  u32x4 hX, hY;
  float sX, sY;
  int xC, tC, xN, tN, x2, t2;
#define Z1_LOAD_EV(T) do { _Pragma("unroll") for (int q = 0; q < 4; ++q) { const int4 e4 = *(const int4*)(EX + (size_t)(T) * 128 + rg * 16 + 4 * q); \
      ev[4 * q] = e4.x; ev[4 * q + 1] = e4.y; ev[4 * q + 2] = e4.z; ev[4 * q + 3] = e4.w; } } while (0)
#define Z1_ISSUE(Q, H, S, X, T) do { const unsigned char* ub_ = U8 + (size_t)(X) * 16384 * 128 + c8 * 16; \
      _Pragma("unroll") for (int j = 0; j < 16; ++j) Q[j] = *(const u32x4*)(ub_ + (size_t)ev[j] * 128); \
      H = *(const u32x4*)(HQ + ((size_t)(X) * T_TOK + (T)) * 128 + c8 * 16); \
      S = HS[(size_t)(X) * T_TOK + (T)]; } while (0)
  Z1_ITEM(0, xC, tC);
  Z1_LOAD_EV(tC);
  Z1_ISSUE(qX, hX, sX, xC, tC);
  Z1_ITEM(1, xN, tN);
  Z1_LOAD_EV(tN);
#define Z1_BODY(QC, HC, SC, QN, HN, SN, IT) do { \
    Z1_ISSUE(QN, HN, SN, xN, tN);               \
    Z1_ITEM((IT) + 2, x2, t2); \
    Z1_LOAD_EV(t2);                             \
    int pz[16]; \
    _Pragma("unroll") for (int j = 0; j < 16; ++j) { \
      int a_ = 0; \
      _Pragma("unroll") for (int d = 0; d < 4; ++d) a_ = __builtin_amdgcn_sdot4((int)QC[j][d], (int)HC[d], a_, false); \
      pz[j] = a_; } \
      \
    int r1[8], r2[4], r3[2]; \
    _Pragma("unroll") for (int i = 0; i < 8; ++i) { const int send = b2 ? pz[i] : pz[8 + i], mine = b2 ? pz[8 + i] : pz[i]; r1[i] = mine + __shfl_xor(send, 4); } \
    _Pragma("unroll") for (int i = 0; i < 4; ++i) { const int send = b1 ? r1[i] : r1[4 + i], mine = b1 ? r1[4 + i] : r1[i]; r2[i] = mine + __shfl_xor(send, 2); } \
    _Pragma("unroll") for (int i = 0; i < 2; ++i) { const int send = b0 ? r2[i] : r2[2 + i], mine = b0 ? r2[2 + i] : r2[i]; r3[i] = mine + __shfl_xor(send, 1); } \
    *(float2*)(ZP + ((size_t)xC * T_TOK + tC) * 128 + rg * 16 + 2 * c8) = make_float2((float)r3[0] * SC, (float)r3[1] * SC); \
    xC = xN; tC = tN; xN = x2; tN = t2; } while (0)
  for (int it = 0; it < total; it += 2) {
    Z1_BODY(qX, hX, sX, qY, hY, sY, it);
    if (it + 1 < total) Z1_BODY(qY, hY, sY, qX, hX, sX, it + 1);
  }
#undef Z1_BODY
#undef Z1_ISSUE
#undef Z1_LOAD_EV
#undef Z1_ITEM
}

DI void peer_zmerge(const Params& p, int layer, const float* ss_in) {
  unsigned char* ws = p.ws;
  const int* EX = (const int*)(ws + OFF_EX);
  const float* GT = (const float*)(ws + OFF_GT);
  const float* ZP = (const float*)(ws + OFF_ZP);
  const float2* SC = (const float2*)(ws + (layer ? OFF_SC1 : OFF_SC0));
  unsigned* ACTQ = (unsigned*)(ws + OFF_ACT);
  float* ASC = (float*)(ws + OFF_ACT + 4 * MiB);
  for (int i4 = blockIdx.x * NTHREADS + opaque_tid(); i4 < T_TOK * 32; i4 += gridDim.x * NTHREADS) {
    const int idx = i4 * 4, t = idx >> 7;
    float4 z = make_float4(0.f, 0.f, 0.f, 0.f);
#pragma unroll
    for (int x = 0; x < 8; ++x) { const float4 v = *(const float4*)(ZP + (size_t)x * T_TOK * 128 + idx); z.x += v.x; z.y += v.y; z.z += v.z; z.w += v.w; }
    const int4 e4 = *(const int4*)(EX + idx);
    const float4 g4 = *(const float4*)(GT + idx);
    const float2 s0 = SC[e4.x], s1 = SC[e4.y], s2 = SC[e4.z], s3 = SC[e4.w];
    const float rs = rstd_from_partials(ss_in, t);
    const float a0 = gelu_tanh(z.x * rs * s0.x) * g4.x * s0.y, a1 = gelu_tanh(z.y * rs * s1.x) * g4.y * s1.y;
    const float a2 = gelu_tanh(z.z * rs * s2.x) * g4.z * s2.y, a3 = gelu_tanh(z.w * rs * s3.x) * g4.w * s3.y;
    float am = fmaxf(fmaxf(fabsf(a0), fabsf(a1)), fmaxf(fabsf(a2), fabsf(a3)));
#pragma unroll
    for (int o = 16; o >= 1; o >>= 1) am = fmaxf(am, __shfl_xor(am, o));
    const float qs = am > 0.f ? 127.f / am : 0.f;
    ACTQ[i4] = pack_i8x4(a0 * qs, a1 * qs, a2 * qs, a3 * qs);
    if ((i4 & 31) == 0) ASC[t] = am * (1.f / 127.f);
  }
}

template <bool FINAL>
DI void peer_s2(const Params& p, int layer, float* ss_out, const XcdSlot sl) {
  const int tid = opaque_tid(), lane = tid & 63, w = tid >> 6;
  unsigned char* ws = p.ws;
  const int* EX = (const int*)(ws + OFF_EX);
  const unsigned char* ACTQ = ws + OFF_ACT;
  const float* ASC = (const float*)(ws + OFF_ACT + 4 * MiB);
  const unsigned char* V8 = ws + (layer ? OFF_UV1 : OFF_UV0) + 16 * MiB;
  u16* HBT = (u16*)(ws + OFF_HBT);
  float* out = p.out;
  float* ssd = ss_out ? ss_out : (float*)(ws + OFF_DUMMY);
  const int c8 = lane & 7, rg = lane >> 3;
  const bool b3 = (lane & 8) != 0;
  const int first = sl.rank * 4 + w, stride = sl.cnt * 4;
  const int nT = (T_TOK - first + stride - 1) / stride;
  const int nparts = (8 - sl.part0 + sl.pstride - 1) / sl.pstride;
  const int total = nT * nparts;
  if (total <= 0) return;
#define S2_ITEM(IT, X, T) do { int it_ = (IT) < total ? (IT) : total - 1; const int xi_ = it_ / nT; X = sl.part0 + xi_ * sl.pstride; T = first + (it_ - xi_ * nT) * stride; } while (0)
  int ev[16];
  u32x4 avX, avY;
  float scX, scY;
  u32x4 qX[16], qY[16];
  unsigned hX, hY;
  int xC, tC, xN, tN, x2, t2;
#define S2_LOAD_EV(T) do { _Pragma("unroll") for (int q = 0; q < 4; ++q) { const int4 e4 = *(const int4*)(EX + (size_t)(T) * 128 + rg * 16 + 4 * q); \
      ev[4 * q] = e4.x; ev[4 * q + 1] = e4.y; ev[4 * q + 2] = e4.z; ev[4 * q + 3] = e4.w; } } while (0)
#define S2_ISSUE(Q, AV, SCL, H, X, T) do { const unsigned char* vb_ = V8 + (size_t)(X) * 16384 * 128 + c8 * 16; \
      _Pragma("unroll") for (int j = 0; j < 16; ++j) Q[j] = *(const u32x4*)(vb_ + (size_t)ev[j] * 128); \
      H = *(const unsigned*)(HBT + tiledA((T), (X) * 128 + c8 * 16 + 2 * rg, 1024)); \
      AV = *(const u32x4*)(ACTQ + (size_t)(T) * 128 + rg * 16); \
      SCL = ASC[(T)]; } while (0)
  S2_ITEM(0, xC, tC);
  S2_LOAD_EV(tC);
  S2_ISSUE(qX, avX, scX, hX, xC, tC);
  S2_ITEM(1, xN, tN);
  S2_LOAD_EV(tN);
#define S2_BODY(QC, AVC, SCC, HC, QN, AVN, SCN, HN, IT) do { \
    S2_ISSUE(QN, AVN, SCN, HN, xN, tN);         \
    S2_ITEM((IT) + 2, x2, t2); \
    S2_LOAD_EV(t2);                             \
    int acc[16]; \
    _Pragma("unroll") for (int i = 0; i < 16; ++i) acc[i] = 0; \
    _Pragma("unroll") for (int jg = 0; jg < 4; ++jg) { \
      const int a4 = (int)AVC[jg]; \
      _Pragma("unroll") for (int d = 0; d < 4; ++d) { \
        const unsigned r0_ = QC[4 * jg][d], r1_ = QC[4 * jg + 1][d], r2_ = QC[4 * jg + 2][d], r3_ = QC[4 * jg + 3][d]; \
        const unsigned t01l = __builtin_amdgcn_perm(r1_, r0_, 0x05010400u), t01h = __builtin_amdgcn_perm(r1_, r0_, 0x07030602u); \
        const unsigned t23l = __builtin_amdgcn_perm(r3_, r2_, 0x05010400u), t23h = __builtin_amdgcn_perm(r3_, r2_, 0x07030602u); \
        acc[4 * d]     = __builtin_amdgcn_sdot4((int)__builtin_amdgcn_perm(t23l, t01l, 0x05040100u), a4, acc[4 * d], false); \
        acc[4 * d + 1] = __builtin_amdgcn_sdot4((int)__builtin_amdgcn_perm(t23l, t01l, 0x07060302u), a4, acc[4 * d + 1], false); \
        acc[4 * d + 2] = __builtin_amdgcn_sdot4((int)__builtin_amdgcn_perm(t23h, t01h, 0x05040100u), a4, acc[4 * d + 2], false); \
        acc[4 * d + 3] = __builtin_amdgcn_sdot4((int)__builtin_amdgcn_perm(t23h, t01h, 0x07060302u), a4, acc[4 * d + 3], false); } } \
      \
    int r1[8], r2[4], r3[2]; \
    _Pragma("unroll") for (int i = 0; i < 8; ++i) { const u32x2 sw = __builtin_amdgcn_permlane32_swap((unsigned)acc[i], (unsigned)acc[8 + i], false, false); r1[i] = (int)(sw[0] + sw[1]); } \
    _Pragma("unroll") for (int i = 0; i < 4; ++i) { const u32x2 sw = __builtin_amdgcn_permlane16_swap((unsigned)r1[i], (unsigned)r1[4 + i], false, false); r2[i] = (int)(sw[0] + sw[1]); } \
    _Pragma("unroll") for (int i = 0; i < 2; ++i) { \
      const int lo = r2[i] + __builtin_amdgcn_update_dpp(0, r2[i], 0x128, 0xf, 0xf, false), hi = r2[2 + i] + __builtin_amdgcn_update_dpp(0, r2[2 + i], 0x128, 0xf, 0xf, false);     \
      r3[i] = b3 ? hi : lo; } \
    const float n0 = bflo(HC) + (float)r3[0] * SCC, n1 = bfhi(HC) + (float)r3[1] * SCC; \
    if (FINAL) *(float2*)(out + (size_t)tC * 1024 + xC * 128 + c8 * 16 + 2 * rg) = make_float2(n0, n1); \
    else { float ssq = n0 * n0 + n1 * n1; \
      _Pragma("unroll") for (int o = 32; o >= 1; o >>= 1) ssq += __shfl_xor(ssq, o); \
      *(unsigned*)(HBT + tiledA(tC, xC * 128 + c8 * 16 + 2 * rg, 1024)) = pack2(n0, n1); ssd[(size_t)tC * 8 + xC] = ssq; } \
    xC = xN; tC = tN; xN = x2; tN = t2; } while (0)
  for (int it = 0; it < total; it += 2) {
    S2_BODY(qX, avX, scX, hX, qY, avY, scY, hY, it);
    if (it + 1 < total) S2_BODY(qY, avY, scY, hY, qX, avX, scX, hX, it + 1);
  }
#undef S2_LOAD_EV
#undef S2_ISSUE
#undef S2_BODY
#undef S2_ITEM
}

constexpr int VT_STRIDE = 392;
DI void attn_phase(const Params& p, unsigned char* lds) {
  const int tid = opaque_tid(), lane = tid & 63, w = tid >> 6, l31 = lane & 31, half = lane >> 5;
  unsigned char* ws = p.ws;
  const u16* Kb = (const u16*)(ws + OFF_K);
  const u16* Vb = (const u16*)(ws + OFF_V);
  const u16* Qb = (const u16*)(ws + OFF_Q);
  u16* OGA = (u16*)(ws + OFF_OGA);
  float* LG = (float*)(ws + OFF_LG);
  const float Mx = ((const float*)(ws + OFF_MISC))[0];
  const float scale = 0.08838834764831845f;
  for (int item = blockIdx.x; item < 1536; item += gridDim.x) {
    const int qb = item & 127, rest = item >> 7, kvh = rest & 1, gi = (rest >> 1) % 3, b = rest / 6;
    const int dl = (gi == 0) ? 1 : (gi == 1 ? 4 : 16);
    const int bpr = (SEQ / dl) / 64;
    const int rho = qb / bpr, tau0 = (qb % bpr) * 64;
#pragma unroll 4
    for (int j = 0; j < 12; ++j) {
      const int id = tid + 256 * j, row = id >> 4, c = id & 15;
      const int tk = tau0 - 128 + row;
      const int tokk = rho + dl * (tk < 0 ? 0 : tk);
      *(uint4*)(lds + off256(row, c)) = *(const uint4*)(Kb + ((size_t)(b * SEQ + tokk)) * 768 + gi * 256 + kvh * 128 + c * 8);
    }
    const int r = w & 1, qh = w >> 1;
    const int tauq = tau0 + qh * 32 + l31;
    const int tq = b * SEQ + rho + dl * tauq;
    bf16x8 qf[8];
    {
      const u16* qsrc = Qb + (size_t)tq * 1536 + ((gi * 2 + kvh) * 2 + r) * 128;
#pragma unroll
      for (int kk = 0; kk < 8; ++kk) qf[kk] = *(const bf16x8*)(qsrc + (2 * kk + half) * 8);
    }
    __syncthreads();
    float lsum = 0.f;
    bf16x8 pf[5][2];
#pragma unroll
    for (int jl = 0; jl < 5; ++jl) {
      f32x16 pt;
#pragma unroll
      for (int rr = 0; rr < 16; ++rr) pt[rr] = 0.f;
#pragma unroll
      for (int kk = 0; kk < 8; ++kk) {
        const bf16x8 ak = *(const bf16x8*)(lds + off256((qh + jl) * 32 + l31, 2 * kk + half));
        pt = MFMA32(ak, qf[kk], pt);
      }
#pragma unroll
      for (int rr = 0; rr < 16; ++rr) {
        const int tk = tau0 - 128 + (qh + jl) * 32 + crow(rr, half);
        const bool valid = (tk >= 0) && (tk <= tauq) && (tk >= tauq - 128);
        const float pv = valid ? __expf(pt[rr] * scale - Mx) : 0.f;
        lsum += pv;
        pt[rr] = pv;
      }
#pragma unroll
      for (int s = 0; s < 2; ++s) {
        const uint4 u0 = make_uint4(pack2(pt[8 * s], pt[8 * s + 1]), pack2(pt[8 * s + 2], pt[8 * s + 3]),
                                    pack2(pt[8 * s + 4], pt[8 * s + 5]), pack2(pt[8 * s + 6], pt[8 * s + 7]));
        pf[jl][s] = __builtin_bit_cast(bf16x8, u0);
      }
    }
    lsum += __shfl_xor(lsum, 32);
    __syncthreads();
#pragma unroll 4
    for (int j = 0; j < 12; ++j) {
      const int id = tid + 256 * j, row = id >> 4, c = id & 15;
      const int tk = tau0 - 128 + row;
      const int tokk = rho + dl * (tk < 0 ? 0 : tk);
      const uint4 vv = *(const uint4*)(Vb + ((size_t)(b * SEQ + tokk)) * 768 + gi * 256 + kvh * 128 + c * 8);
      unsigned char* dstc = lds + (size_t)(c * 8) * VT_STRIDE + row * 2;
      *(u16*)(dstc + 0 * VT_STRIDE) = (u16)(vv.x & 0xffff); *(u16*)(dstc + 1 * VT_STRIDE) = (u16)(vv.x >> 16);
      *(u16*)(dstc + 2 * VT_STRIDE) = (u16)(vv.y & 0xffff); *(u16*)(dstc + 3 * VT_STRIDE) = (u16)(vv.y >> 16);
      *(u16*)(dstc + 4 * VT_STRIDE) = (u16)(vv.z & 0xffff); *(u16*)(dstc + 5 * VT_STRIDE) = (u16)(vv.z >> 16);
      *(u16*)(dstc + 6 * VT_STRIDE) = (u16)(vv.w & 0xffff); *(u16*)(dstc + 7 * VT_STRIDE) = (u16)(vv.w >> 16);
    }
    __syncthreads();
    f32x16 acc[4];
#pragma unroll
    for (int i = 0; i < 4; ++i)
#pragma unroll
      for (int rr = 0; rr < 16; ++rr) acc[i][rr] = 0.f;
#pragma unroll
    for (int et = 0; et < 4; ++et) {
      const unsigned char* vrow = lds + (size_t)(et * 32 + l31) * VT_STRIDE;
#pragma unroll
      for (int jl = 0; jl < 5; ++jl)
#pragma unroll
        for (int s = 0; s < 2; ++s) {
          const int j0 = (qh + jl) * 32 + 16 * s + 4 * half;
          const uint2 lo = *(const uint2*)(vrow + j0 * 2);
          const uint2 hi = *(const uint2*)(vrow + (j0 + 8) * 2);
          const bf16x8 av = __builtin_bit_cast(bf16x8, make_uint4(lo.x, lo.y, hi.x, hi.y));
          acc[et] = MFMA32(av, pf[jl][s], acc[et]);
        }
    }
    const int hd = kvh * 2 + r;
    const int tglob = tq;
    u16* od = OGA + ((size_t)gi * T_TOK + tglob) * 512 + hd * 128;
#pragma unroll
    for (int et = 0; et < 4; ++et)
#pragma unroll
      for (int g = 0; g < 4; ++g)
        *(uint2*)(od + et * 32 + 8 * g + 4 * half) = make_uint2(pack2(acc[et][4 * g], acc[et][4 * g + 1]), pack2(acc[et][4 * g + 2], acc[et][4 * g + 3]));
    if (half == 0) LG[((size_t)gi * T_TOK + tglob) * 4 + hd] = lsum;
    __syncthreads();
  }
}

DI void attn_combine(const Params& p) {
  unsigned char* ws = p.ws;
  const u16* OGA = (const u16*)(ws + OFF_OGA);
  const float* LG = (const float*)(ws + OFF_LG);
  u16* AO = (u16*)(ws + OFF_AO);
  const int nchunk = T_TOK * 512 / 8;
  for (int i = blockIdx.x * NTHREADS + opaque_tid(); i < nchunk; i += gridDim.x * NTHREADS) {
    const int t = i >> 6, c = i & 63, hd = c >> 4;
    float num[8];
#pragma unroll
    for (int k = 0; k < 8; ++k) num[k] = 0.f;
    float den = 0.f;
#pragma unroll
    for (int gi = 0; gi < 3; ++gi) {
      const uint4 v = *(const uint4*)(OGA + ((size_t)gi * T_TOK + t) * 512 + c * 8);
      num[0] += bflo(v.x); num[1] += bfhi(v.x); num[2] += bflo(v.y); num[3] += bfhi(v.y);
      num[4] += bflo(v.z); num[5] += bfhi(v.z); num[6] += bflo(v.w); num[7] += bfhi(v.w);
      den += LG[((size_t)gi * T_TOK + t) * 4 + hd];
    }
    const float inv = 1.f / den;
    *(uint4*)(AO + tiledA(t, c * 8, 512)) = make_uint4(pack2(num[0] * inv, num[1] * inv), pack2(num[2] * inv, num[3] * inv),
                                                        pack2(num[4] * inv, num[5] * inv), pack2(num[6] * inv, num[7] * inv));
  }
}

#define XB_TMO      128
#define XB_XCNT(j)  (256  + 64 * (j))
#define XB_XSUB(j)  (1280 + 64 * (j))
#define XB_XGEN(j)  (2304 + 64 * (j))
#define XB_TOP      3328
#define XB_TOPGEN   3392
#define XCD_BAR_WORDS 3456
#define XB_SPIN_CAP (1u << 18)

__device__ __forceinline__ unsigned xb_ld(unsigned* p)              { return __hip_atomic_load(p, __ATOMIC_RELAXED, __HIP_MEMORY_SCOPE_AGENT); }
__device__ __forceinline__ unsigned xb_add(unsigned* p, unsigned v) { return __hip_atomic_fetch_add(p, v, __ATOMIC_RELAXED, __HIP_MEMORY_SCOPE_AGENT); }
__device__ __forceinline__ unsigned xb_xcc_id() { return (unsigned)__builtin_amdgcn_s_getreg((3 << 11) | 20) & 0xFu; }
#define XB_SPIN(cond, bar) do { unsigned _sp = 0; while (cond) { __builtin_amdgcn_s_sleep(1); \
    if ((++_sp & 255u) == 0u) { if (xb_ld(&(bar)[XB_TMO])) break; if (_sp > XB_SPIN_CAP) { atomicAdd(&(bar)[XB_TMO], 1u); break; } } } } while (0)

struct XcdBarrier {
    unsigned* bar; unsigned x;
    volatile LAS unsigned* st;
};

__device__ __forceinline__ XcdBarrier xcd_barrier_post(unsigned* bar, volatile LAS unsigned* st) {
    XcdBarrier b; b.bar = bar; b.x = xb_xcc_id(); b.st = st;
    if (threadIdx.x == 0) (void)xb_add(&bar[XB_XCNT(b.x)], 1u);
    return b;
}
__device__ __forceinline__ void xcd_barrier_complete(unsigned* bar, unsigned x, unsigned& nloc, unsigned& nx) {
    const unsigned G = gridDim.x * gridDim.y * gridDim.z;
    unsigned sum, cnt, mine, sp = 0u;
    for (;;) {
        sum = 0u; cnt = 0u; mine = 0u;
#pragma unroll
        for (unsigned j = 0; j < 16; ++j) { const unsigned c = xb_ld(&bar[XB_XCNT(j)]); sum += c; cnt += (c > 0u) ? 1u : 0u; mine = (j == x) ? c : mine; }
        if (sum == G) break;
        __builtin_amdgcn_s_sleep(1);
        if ((++sp & 255u) == 0u) { if (xb_ld(&bar[XB_TMO])) break; if (sp > XB_SPIN_CAP) { atomicAdd(&bar[XB_TMO], 1u); break; } }
    }
    nloc = mine > 0u ? mine : 1u; nx = cnt > 0u ? cnt : 1u;
}

__device__ __forceinline__ void xcd_barrier(const XcdBarrier& b) {
    asm volatile("s_waitcnt vmcnt(0)" ::: "memory");
    __syncthreads();
    if (threadIdx.x == 0) {
        unsigned* bar = b.bar;
        __builtin_amdgcn_s_waitcnt(0);
        unsigned nloc = b.st[0], nx = b.st[1];
        if (nloc == 0u) { xcd_barrier_complete(bar, b.x, nloc, nx); b.st[0] = nloc; b.st[1] = nx; }
        const unsigned old = xb_add(&bar[XB_XSUB(b.x)], 1u);
        const unsigned gen = old / nloc;
        if (old + 1u == (gen + 1u) * nloc) {
            __builtin_amdgcn_fence(__ATOMIC_RELEASE, "agent");
            asm volatile("s_waitcnt vmcnt(0)" ::: "memory");
            const unsigned og = xb_add(&bar[XB_TOP], 1u);
            const unsigned tg = og / nx;
            if (og + 1u == (tg + 1u) * nx) xb_add(&bar[XB_TOPGEN], 1u);
            else XB_SPIN(xb_ld(&bar[XB_TOPGEN]) == tg, bar);
            __builtin_amdgcn_fence(__ATOMIC_ACQUIRE, "agent");
            xb_add(&bar[XB_XGEN(b.x)], 1u);
            asm volatile("s_waitcnt vmcnt(0)" ::: "memory");
        } else {
            XB_SPIN(xb_ld(&bar[XB_XGEN(b.x)]) == gen, bar);
            __builtin_amdgcn_fence(__ATOMIC_ACQUIRE, "agent");
            asm volatile("s_waitcnt vmcnt(0)" ::: "memory");
        }
    }
    __syncthreads();
}


constexpr int N_PHASES = 18;
template <int ph>
DI void run_phase(const Params& p, unsigned char* lds, unsigned myrank) {
  unsigned char* ws = p.ws;
  switch (ph) {
    case 0: p0_prep(p, lds); break;
    case 1: {
      EpiHgrnIn e{(const float*)(ws + OFF_RSTD0), (const float*)(ws + OFF_LB), (u16*)(ws + OFF_QG), (u16*)(ws + OFF_VG), (u16*)(ws + OFF_GG), (_Float16*)(ws + OFF_LOGF)};
      gemm_phase64<EpiHgrnIn, 1>(p, (const u16*)(ws + OFF_HB), 1024, (const u16*)(ws + OFF_WIN), 1024, 64, 32, 16, e, lds);
    } break;
    case 2: gla_g1(p, lds); break;
    case 3: gla_g2(p); break;
    case 4: gla_g3(p, lds); break;
    case 5: {
      EpiResidual<false> e{p.x, (u16*)(ws + OFF_HBT), (float*)(ws + OFF_SS1), ws + OFF_HQ, (float*)(ws + OFF_HS)};
      gemm_phase64(p, (const u16*)(ws + OFF_OG), 1024, (const u16*)(ws + OFF_WOUT), 1024, 64, 8, 16, e, lds);
    } break;
    case 6: {
      EpiTopk e{(const float*)(ws + OFF_SS1), (int*)(ws + OFF_EX), (float*)(ws + OFF_GT), lds + 32768 + (opaque_tid() >> 6) * 6144};
      gemm_phase<EpiTopk, 0, true>(p, (const u16*)(ws + OFF_HBT), 1024, (const u16*)(ws + OFF_WPQ0), 1024, 128, 16, 16, e, lds);
    } break;
    case 7: peer_s1(p, 0, xcd_slot(p, myrank)); break;
    case 8: peer_zmerge(p, 0, (const float*)(ws + OFF_SS1)); break;
    case 9: peer_s2<false>(p, 0, (float*)(ws + OFF_SS2), xcd_slot(p, myrank)); break;
    case 10: {
      EpiKVQ e{(const float*)(ws + OFF_SS2), p.k_norm, p.q_norm, (const float2*)(ws + OFF_ROPE), (u16*)(ws + OFF_K), (u16*)(ws + OFF_V), (u16*)(ws + OFF_Q), lds + 32768};
      gemm_phase64<EpiKVQ, 2>(p, (const u16*)(ws + OFF_HBT), 1024, (const u16*)(ws + OFF_WKVQ), 1024, 64, 24, 16, e, lds);
    } break;
    case 11: attn_phase(p, lds); break;
    case 12: attn_combine(p); break;
    case 13: {
      EpiResidual<true> e{nullptr, (u16*)(ws + OFF_HBT), (float*)(ws + OFF_SS3), ws + OFF_HQ, (float*)(ws + OFF_HS)};
      gemm_phase64(p, (const u16*)(ws + OFF_AO), 512, (const u16*)(ws + OFF_WO), 512, 64, 8, 8, e, lds);
    } break;
    case 14: {
      EpiTopk e{(const float*)(ws + OFF_SS3), (int*)(ws + OFF_EX), (float*)(ws + OFF_GT), lds + 32768 + (opaque_tid() >> 6) * 6144};
      gemm_phase<EpiTopk, 0, true>(p, (const u16*)(ws + OFF_HBT), 1024, (const u16*)(ws + OFF_WPQ1), 1024, 128, 16, 16, e, lds);
    } break;
    case 15: peer_s1(p, 1, xcd_slot(p, myrank)); break;
    case 16: peer_zmerge(p, 1, (const float*)(ws + OFF_SS3)); break;
    case 17: peer_s2<true>(p, 1, nullptr, xcd_slot(p, myrank)); break;
    default: break;
  }
}

#if MEGA
#ifndef PROBE_MASK
#define PROBE_MASK 0
#endif
__global__ void __launch_bounds__(NTHREADS, 2) yoco_mega(Params p) {
  __shared__ __attribute__((aligned(16))) unsigned char lds[LDS_BYTES];
  __shared__ uint4 xb_words;
  if (threadIdx.x == 0) {
    const unsigned myx = (unsigned)__builtin_amdgcn_s_getreg((3 << 11) | 20) & 0xFu;
    const unsigned rk = __hip_atomic_fetch_add((unsigned*)(p.ws + OFF_CENSUS) + myx, 1u, __ATOMIC_RELAXED, __HIP_MEMORY_SCOPE_AGENT);
    xb_words = make_uint4(0u, 0u, rk, 0u);
  }
  __syncthreads();
  (void)xcd_barrier_post((unsigned*)p.ws, (volatile LAS unsigned*)&xb_words);
#define GRID_BAR() do { XcdBarrier b_; b_.bar = (unsigned*)p.ws; b_.x = xb_xcc_id(); b_.st = (volatile LAS unsigned*)&xb_words; xcd_barrier(b_); } while (0)
#define MYRANK() (((volatile unsigned*)&xb_words)[2])
#define PHASE(n) do { run_phase<n>(p, lds, MYRANK()); GRID_BAR(); if (PROBE_MASK & (1 << n)) { run_phase<n>(p, lds, MYRANK()); GRID_BAR(); } } while (0)
  PHASE(0); PHASE(1); PHASE(2); PHASE(3); PHASE(4); PHASE(5); PHASE(6); PHASE(7); PHASE(8); PHASE(9);
  PHASE(10); PHASE(11); PHASE(12); PHASE(13); PHASE(14); PHASE(15); PHASE(16);
  run_phase<17>(p, lds, MYRANK());
}
#endif

extern "C" void kernel_launch(void* const* d_in, const int* in_sizes, int n_in, void* d_out, int out_size, void* d_ws, size_t ws_size,
                              hipStream_t stream) {
  if (n_in != 18 || ws_size < WS_NEED) {
    fprintf(stderr, "kernel_launch: unexpected inputs (n_in %d, ws %zu, need %zu)\n", n_in, ws_size, (size_t)WS_NEED);
    return;
  }
  Params p{};
  p.x = (const float*)d_in[0]; p.hgrn_norm = (const float*)d_in[1]; p.hgrn_w_in = (const float*)d_in[2]; p.hgrn_lb = (const float*)d_in[3];
  p.hgrn_out_norm = (const float*)d_in[4]; p.hgrn_w_out = (const float*)d_in[5]; p.kv_norm = (const float*)d_in[6]; p.w_kv = (const float*)d_in[7];
  p.k_norm = (const float*)d_in[8]; p.attn_norm = (const float*)d_in[9]; p.w_q = (const float*)d_in[10]; p.q_norm = (const float*)d_in[11];
  p.w_o = (const float*)d_in[12]; p.ffn_norm = (const float*)d_in[13]; p.peer_w_q = (const float*)d_in[14]; p.peer_sub_keys = (const float*)d_in[15];
  p.peer_u = (const float*)d_in[16]; p.peer_v = (const float*)d_in[17];
  p.out = (float*)d_out; p.ws = (unsigned char*)d_ws;
#if MEGA
  static int grid_blocks = 0;
  if (!grid_blocks) {
    int dev = 0, cus = 0, per_cu = 0;
    (void)hipGetDevice(&dev);
    (void)hipDeviceGetAttribute(&cus, hipDeviceAttributeMultiprocessorCount, dev);
    (void)hipOccupancyMaxActiveBlocksPerMultiprocessor(&per_cu, yoco_mega, NTHREADS, 0);
    if (per_cu > 2) per_cu = 2;
    if (per_cu < 1) per_cu = 1;
    grid_blocks = cus * per_cu;
  }
  if (hipMemsetAsync(d_ws, 0, 16384, stream) != hipSuccess) { fprintf(stderr, "kernel_launch: memset of barrier words failed\n"); return; }
  void* args[] = {&p};
  hipError_t e = hipLaunchCooperativeKernel((void*)yoco_mega, dim3(grid_blocks), dim3(NTHREADS), args, 0, stream);
  if (e != hipSuccess) fprintf(stderr, "cooperative launch failed: %s (grid %d)\n", hipGetErrorString(e), grid_blocks);
#endif
}
```
